# Optimizing an MI355X kernel written in HIP

```python
import jax
import jax.numpy as jnp
from jax import lax
import numpy as np

D_MODEL = 2048
BATCH = 2
SEQ = 8192
DEPTH = 1

CTX_LEN = 256
GRID_W = 64
NORM_EPS = 1e-6

MLA_HEADS = 8
QK_NOPE_DIM = 128
QK_ROPE_DIM = 64
V_HEAD_DIM = 128
Q_LORA_RANK = 512
KV_LORA_RANK = 256
MLA_WIDTH = MLA_HEADS * V_HEAD_DIM
MLA_SCALE = (QK_NOPE_DIM + QK_ROPE_DIM) ** -0.5
ROPE_THETA = 10000.0
ROPE_AXIS_DIM = QK_ROPE_DIM // 2
Q_BLOCK = 128

RWKV_HEAD_DIM = 64
RWKV_WIDTH = D_MODEL - MLA_WIDTH
RWKV_HEADS = RWKV_WIDTH // RWKV_HEAD_DIM
DECAY_LORA = 64
ICLR_LORA = 64
GATE_LORA = 160
LNX_EPS = 64e-5

N_GROUPS = 4
EXPERTS_PER_GROUP = 8
N_EXPERTS = N_GROUPS * EXPERTS_PER_GROUP
TOP_K = 2
D_EXPERT = 512
MOE_BLOCK = 128

MLA_COLS = (Q_LORA_RANK, KV_LORA_RANK, QK_ROPE_DIM)
RWKV_COLS = (RWKV_WIDTH, RWKV_WIDTH, RWKV_WIDTH, DECAY_LORA, ICLR_LORA, GATE_LORA)
MLA_IN = sum(MLA_COLS)
RWKV_IN = sum(RWKV_COLS)
IN_COLS = MLA_IN + RWKV_IN

kernel_name = 'hybrid_mla_rwkv7_hmoe_dit_block'


def rms_norm(x, g):
    xf = x.astype(jnp.float32)
    y = xf * lax.rsqrt(jnp.mean(xf * xf, axis=-1, keepdims=True) + NORM_EPS)
    return (y * g).astype(x.dtype)


def modulate(x, g, shift, scale):
    return rms_norm(x, g) * (1 + scale) + shift


def split_cols(t, sizes):
    cuts = [int(i) for i in np.cumsum(sizes)[:-1]]
    return jnp.split(t, cuts, axis=-1)


def centred_shift(p, mu):
    zero = jnp.zeros_like(p[:, :1])
    prev = jnp.concatenate([zero, p[:, :-1]], axis=1)
    nxt = jnp.concatenate([p[:, 1:], zero], axis=1)
    return p + mu[0] * (prev - p) + mu[1] * (nxt - p)


def project_in(h, w_in, mu):
    p = h @ w_in
    p_mla, p_rwkv = p[..., :MLA_IN], p[..., MLA_IN:]
    return split_cols(p_mla, MLA_COLS) + split_cols(centred_shift(p_rwkv, mu), RWKV_COLS)


def axial_rope_tables(T):
    rows = T // GRID_W
    row, col = jnp.meshgrid(jnp.arange(rows), jnp.arange(GRID_W), indexing='ij')
    inv_freq = ROPE_THETA ** (-jnp.arange(0, ROPE_AXIS_DIM, 2, dtype=jnp.float32) / ROPE_AXIS_DIM)
    ang_r = row.reshape(-1)[:, None].astype(jnp.float32) * inv_freq
    ang_c = col.reshape(-1)[:, None].astype(jnp.float32) * inv_freq
    return (jnp.cos(ang_r), jnp.sin(ang_r), jnp.cos(ang_c), jnp.sin(ang_c))


def rotate_pair(x, cos, sin):
    x1, x2 = jnp.split(x, 2, axis=-1)
    return jnp.concatenate([x1 * cos - x2 * sin, x1 * sin + x2 * cos], axis=-1)


def rope_2d(x, tables):
    cr, sr, cc, sc = tables
    xr, xc = jnp.split(x, 2, axis=-1)
    return jnp.concatenate([rotate_pair(xr, cr, sr), rotate_pair(xc, cc, sc)], axis=-1).astype(x.dtype)


def mla_queries(c_q, q_norm_g, w_uq):
    B, T = c_q.shape[:2]
    q = (rms_norm(c_q, q_norm_g) @ w_uq).reshape(B, T, MLA_HEADS, QK_NOPE_DIM + QK_ROPE_DIM)
    return q[..., :QK_NOPE_DIM], q[..., QK_NOPE_DIM:]


def mla_keys_values(c_kv, kv_norm_g, w_ukv):
    B, T = c_kv.shape[:2]
    kv = (rms_norm(c_kv, kv_norm_g) @ w_ukv).reshape(B, T, MLA_HEADS, QK_NOPE_DIM + V_HEAD_DIM)
    return kv[..., :QK_NOPE_DIM], kv[..., QK_NOPE_DIM:]


def mla_attend(q_nope, q_rope, k_nope, k_rope, v):
    s = (jnp.einsum('bqhd,bkhd->bhqk', q_nope, k_nope, preferred_element_type=jnp.float32)
         + jnp.einsum('bqhd,bkd->bhqk', q_rope, k_rope, preferred_element_type=jnp.float32))
    p = jax.nn.softmax(s * MLA_SCALE, axis=-1)
    o = jnp.einsum('bhqk,bkhd->bqhd', p.astype(v.dtype), v)
    return o.reshape(o.shape[0], o.shape[1], MLA_WIDTH)


def mla_latent_attention(q_nope, q_rope, k_nope, k_rope, v):
    B, T = q_nope.shape[:2]
    nb = T // Q_BLOCK

    def blockify(t):
        return jnp.moveaxis(t.reshape(B, nb, Q_BLOCK, *t.shape[2:]), 1, 0)

    out = lax.map(lambda qs: mla_attend(qs[0], qs[1], k_nope, k_rope, v),
                  (blockify(q_nope), blockify(q_rope)))
    return jnp.moveaxis(out, 0, 1).reshape(B, T, MLA_WIDTH)


def heads(t):
    return t.reshape(*t.shape[:2], RWKV_HEADS, RWKV_HEAD_DIM)


def rwkv_direction(k, wl, al, w0, w_up, a0, a_up, key_a):
    w_raw = (w0 + jnp.tanh(wl) @ w_up).astype(jnp.float32)
    decay = jnp.exp(-jnp.exp(-jax.nn.softplus(-w_raw) - 0.5))
    a = jax.nn.sigmoid((a0 + al @ a_up).astype(jnp.float32))
    k_mod = k.astype(jnp.float32) * (1 + (a - 1) * key_a)
    return decay, a, k_mod


def rwkv_step(S, inp):
    r, w, k, v, kk, a = inp
    sa = jnp.einsum('bhvk,bhk->bhv', S, -kk)
    S = S * w[:, :, None, :] + sa[..., None] * (kk * a)[:, :, None, :] + v[..., None] * k[:, :, None, :]
    return S, jnp.einsum('bhvk,bhk->bhv', S, r)


def rwkv_scan(S0, r, w, k, v, kk, a, reverse):
    xs = tuple(jnp.moveaxis(heads(t), 1, 0) for t in (r, w, k, v, kk, a))
    S, ys = lax.scan(rwkv_step, S0, xs, reverse=reverse)
    return S, jnp.moveaxis(ys, 0, 1)


def rwkv_bidirectional(r, k, v, wl, al, S0_f, S0_b, params):
    w0, w_up, a0, a_up, key_k, key_a = params
    r32 = r.astype(jnp.float32)
    v32 = v.astype(jnp.float32)
    kk = heads(k.astype(jnp.float32) * key_k)
    kk = (kk * lax.rsqrt(jnp.sum(kk * kk, axis=-1, keepdims=True) + 1e-12)).reshape(k.shape)
    outs = []
    for d, (S0, rev) in enumerate(((S0_f, False), (S0_b, True))):
        decay, a, k_d = rwkv_direction(k, wl, al, w0[d], w_up[d], a0[d], a_up[d], key_a)
        S, y = rwkv_scan(S0, r32, decay, k_d, v32, kk, a, rev)
        outs.append((S, y, k_d))
    (s_f, y_f, k_f), (s_b, y_b, k_b) = outs
    return y_f + y_b, k_f + k_b, s_f, s_b


def rwkv_readout(y, r, k_sum, v, gl, gate_up, r_k, lnx_g, lnx_b):
    B, T = r.shape[:2]
    mu = jnp.mean(y, axis=-1, keepdims=True)
    var = jnp.mean(jnp.square(y - mu), axis=-1, keepdims=True)
    yn = ((y - mu) * lax.rsqrt(var + LNX_EPS)).reshape(B, T, RWKV_WIDTH) * lnx_g + lnx_b
    bonus = jnp.sum(heads(r.astype(jnp.float32)) * heads(k_sum) * r_k, axis=-1, keepdims=True) * heads(v.astype(jnp.float32))
    g = jax.nn.sigmoid(gl) @ gate_up
    return ((yn + bonus.reshape(B, T, RWKV_WIDTH)) * g).astype(r.dtype)


def hierarchical_route(x, w_grp, b_grp, w_exp, b_exp):
    N = x.shape[0]
    grp_prob = jax.nn.softmax((x @ w_grp + b_grp).astype(jnp.float32), axis=-1)
    g_val, g_idx = lax.top_k(grp_prob, 1)
    exp_logits = (x @ w_exp + b_exp).astype(jnp.float32).reshape(N, N_GROUPS, EXPERTS_PER_GROUP)
    within = exp_logits[jnp.arange(N), g_idx[:, 0]]
    e_val, e_idx = lax.top_k(jax.nn.softmax(within, axis=-1), TOP_K)
    gates = g_val * e_val / jnp.sum(e_val, axis=-1, keepdims=True)
    return g_idx * EXPERTS_PER_GROUP + e_idx, gates


def moe_ffn(h, w_grp, b_grp, w_exp, b_exp, w1, w3, w2):
    B, T, D = h.shape
    x = h.reshape(B * T, D)
    N = x.shape[0]
    expert_idx, gates = hierarchical_route(x, w_grp, b_grp, w_exp, b_exp)
    A = N * TOP_K
    n_blocks = (A + N_EXPERTS * (MOE_BLOCK - 1) + MOE_BLOCK - 1) // MOE_BLOCK
    P = n_blocks * MOE_BLOCK
    flat_e = expert_idx.reshape(-1)
    flat_tok = jnp.repeat(jnp.arange(N, dtype=jnp.int32), TOP_K)
    flat_gate = gates.reshape(-1)
    order = jnp.argsort(flat_e)
    sorted_e = flat_e[order]
    counts = jnp.bincount(flat_e, length=N_EXPERTS)
    padded = (counts + MOE_BLOCK - 1) // MOE_BLOCK * MOE_BLOCK
    start = jnp.cumsum(counts) - counts
    pad_end = jnp.cumsum(padded)
    pad_start = pad_end - padded
    dest = pad_start[sorted_e] + jnp.arange(A) - start[sorted_e]
    slot_tok = jnp.full((P,), N, jnp.int32).at[dest].set(flat_tok[order])
    slot_gate = jnp.zeros((P,), jnp.float32).at[dest].set(flat_gate[order])
    block_expert = jnp.minimum(
        jnp.searchsorted(pad_end, jnp.arange(n_blocks) * MOE_BLOCK, side='right'), N_EXPERTS - 1)
    x_pad = jnp.concatenate([x, jnp.zeros((1, D), x.dtype)], axis=0)

    def expert_block(args):
        tok, gate, e = args
        xb = x_pad[tok]
        yb = (jax.nn.silu(xb @ w1[e]) * (xb @ w3[e])) @ w2[e]
        return (yb * gate[:, None]).astype(x.dtype)

    y = lax.map(expert_block, (slot_tok.reshape(n_blocks, MOE_BLOCK),
                               slot_gate.reshape(n_blocks, MOE_BLOCK), block_expert))
    out = jnp.zeros((N + 1, D), x.dtype).at[slot_tok].add(y.reshape(P, D))[:N]
    return out.reshape(B, T, D)


def setup_inputs(seed: int = 0) -> dict:
    key = jax.random.key(seed)
    ks = iter(jax.random.split(key, 40))
    L, D = DEPTH, D_MODEL

    def nrm(shape, scale):
        return scale * jax.random.normal(next(ks), shape, jnp.float32)

    def uni(shape, lo, hi):
        return jax.random.uniform(next(ks), shape, jnp.float32, lo, hi)

    return {
        'x': nrm((BATCH, SEQ, D), 1.0),
        'c': nrm((BATCH, D), 1.0),
        'ctx': nrm((BATCH, CTX_LEN, D), 1.0),
        'c_ctx': nrm((D,), 1.0),
        'w_mod': nrm((L, D, 6 * D), 0.5 * D ** -0.5),
        'b_mod': nrm((L, 6 * D), 0.02),
        'norm_attn_g': 1.0 + nrm((L, D), 0.05),
        'norm_ffn_g': 1.0 + nrm((L, D), 0.05),
        'w_in': nrm((L, D, IN_COLS), D ** -0.5),
        'shift_mu': uni((L, 2, RWKV_IN), 0.0, 0.5),
        'q_norm_g': 1.0 + nrm((L, Q_LORA_RANK), 0.05),
        'w_uq': nrm((L, Q_LORA_RANK, MLA_HEADS * (QK_NOPE_DIM + QK_ROPE_DIM)), Q_LORA_RANK ** -0.5),
        'kv_norm_g': 1.0 + nrm((L, KV_LORA_RANK), 0.05),
        'w_ukv': nrm((L, KV_LORA_RANK, MLA_HEADS * (QK_NOPE_DIM + V_HEAD_DIM)), KV_LORA_RANK ** -0.5),
        'decay_w0': nrm((L, 2, RWKV_WIDTH), 0.5),
        'decay_up': nrm((L, 2, DECAY_LORA, RWKV_WIDTH), 0.5 * DECAY_LORA ** -0.5),
        'iclr_a0': nrm((L, 2, RWKV_WIDTH), 0.5),
        'iclr_up': nrm((L, 2, ICLR_LORA, RWKV_WIDTH), 0.5 * ICLR_LORA ** -0.5),
        'gate_up': nrm((L, GATE_LORA, RWKV_WIDTH), GATE_LORA ** -0.5),
        'key_k': 0.85 + nrm((L, RWKV_WIDTH), 0.05),
        'key_a': 1.0 + nrm((L, RWKV_WIDTH), 0.05),
        'bonus_r_k': nrm((L, RWKV_HEADS, RWKV_HEAD_DIM), 0.1),
        'lnx_g': 1.0 + nrm((L, RWKV_WIDTH), 0.05),
        'lnx_b': nrm((L, RWKV_WIDTH), 0.02),
        'w_out': nrm((L, D, D), D ** -0.5),
        'w_grp': nrm((L, D, N_GROUPS), D ** -0.5),
        'b_grp': nrm((L, N_GROUPS), 0.01),
        'w_exp': nrm((L, D, N_EXPERTS), D ** -0.5),
        'b_exp': nrm((L, N_EXPERTS), 0.01),
        'w1': nrm((L, N_EXPERTS, D, D_EXPERT), D ** -0.5),
        'w3': nrm((L, N_EXPERTS, D, D_EXPERT), D ** -0.5),
        'w2': nrm((L, N_EXPERTS, D_EXPERT, D), D_EXPERT ** -0.5),
        'final_norm_g': 1.0 + nrm((D,), 0.05),
    }


def reference(x, c, ctx, c_ctx, w_mod, b_mod, norm_attn_g, norm_ffn_g, w_in, shift_mu,
              q_norm_g, w_uq, kv_norm_g, w_ukv, decay_w0, decay_up, iclr_a0, iclr_up,
              gate_up, key_k, key_a, bonus_r_k, lnx_g, lnx_b, w_out,
              w_grp, b_grp, w_exp, b_exp, w1, w3, w2, final_norm_g):
    B, T, _ = x.shape
    rope_k = axial_rope_tables(T)
    rope_q = tuple(t[:, None, :] for t in rope_k)
    for l in range(DEPTH):
        mod = (jax.nn.silu(c) @ w_mod[l] + b_mod[l])[:, None, :]
        mod_c = jax.nn.silu(c_ctx) @ w_mod[l] + b_mod[l]
        sh1, sc1, g1, sh2, sc2, g2 = jnp.split(mod, 6, axis=-1)
        csh1, csc1, cg1, csh2, csc2, cg2 = jnp.split(mod_c, 6, axis=-1)

        h = modulate(x, norm_attn_g[l], sh1, sc1)
        hc = modulate(ctx, norm_attn_g[l], csh1, csc1)
        cq, ckv, kr, r, k, v, wl, al, gl = project_in(h, w_in[l], shift_mu[l])
        ccq, cckv, ckr, cr, ck, cv, cwl, cal, cgl = project_in(hc, w_in[l], shift_mu[l])

        qn, qr = mla_queries(cq, q_norm_g[l], w_uq[l])
        kn, vh = mla_keys_values(ckv, kv_norm_g[l], w_ukv[l])
        ckn, cvh = mla_keys_values(cckv, kv_norm_g[l], w_ukv[l])
        keys_nope = jnp.concatenate([kn, ckn], axis=1)
        keys_rope = jnp.concatenate([rope_2d(kr, rope_k), ckr], axis=1)
        values = jnp.concatenate([vh, cvh], axis=1)
        attn = mla_latent_attention(qn, rope_2d(qr, rope_q), keys_nope, keys_rope, values)

        rw = (decay_w0[l], decay_up[l], iclr_a0[l], iclr_up[l], key_k[l], key_a[l])
        zero = jnp.zeros((B, RWKV_HEADS, RWKV_HEAD_DIM, RWKV_HEAD_DIM), jnp.float32)
        cy, ck_sum, s_f, s_b = rwkv_bidirectional(cr, ck, cv, cwl, cal, zero, zero, rw)
        y, k_sum, _, _ = rwkv_bidirectional(r, k, v, wl, al, s_f, s_b, rw)
        rwkv = rwkv_readout(y, r, k_sum, v, gl, gate_up[l], bonus_r_k[l], lnx_g[l], lnx_b[l])

        x = x + g1 * (jnp.concatenate([attn, rwkv], axis=-1) @ w_out[l])
        x = x + g2 * moe_ffn(modulate(x, norm_ffn_g[l], sh2, sc2),
                             w_grp[l], b_grp[l], w_exp[l], b_exp[l], w1[l], w3[l], w2[l])

        if l < DEPTH - 1:
            cqn, cqr = mla_queries(ccq, q_norm_g[l], w_uq[l])
            cattn = mla_attend(cqn, cqr, ckn, ckr, cvh)
            crwkv = rwkv_readout(cy, cr, ck_sum, cv, cgl, gate_up[l], bonus_r_k[l], lnx_g[l], lnx_b[l])
            ctx = ctx + cg1 * (jnp.concatenate([cattn, crwkv], axis=-1) @ w_out[l])
            ctx = ctx + cg2 * moe_ffn(modulate(ctx, norm_ffn_g[l], csh2, csc2),
                                      w_grp[l], b_grp[l], w_exp[l], b_exp[l], w1[l], w3[l], w2[l])
    return rms_norm(x, final_norm_g)
```

```cpp
#include <hip/hip_runtime.h>
#include <cstdio>
#include <cstdint>

#define GAS __attribute__((address_space(1)))
#define LAS __attribute__((address_space(3)))
typedef unsigned short bf16;
typedef unsigned v4u __attribute__((ext_vector_type(4)));
typedef unsigned v2u __attribute__((ext_vector_type(2)));
typedef float f32x2 __attribute__((ext_vector_type(2)));
typedef float f32x16 __attribute__((ext_vector_type(16)));
typedef short s16x4 __attribute__((ext_vector_type(4)));

constexpr int DM = 2048, NB = 2, T = 8192, TC = 256, MROWS = NB * T;
constexpr int MALL = MROWS + NB * TC;
constexpr int NIN = 4192, NINP = 4352;
constexpr int C_CQ = 0, C_CKV = 512, C_KR = 768, C_R = 832, C_K = 1856, C_V = 2880, C_WL = 3904, C_AL = 3968, C_GL = 4032;
constexpr int NKEY = T + TC;
constexpr int RH = 16, RN = 64, RW = 1024;
constexpr int NEXP = 32, DEXP = 512, MAXTILES = 160;

namespace pg8 {
#define PG8_LAS __attribute__((address_space(3)))
typedef unsigned short bf16_t;
typedef short bf16x8 __attribute__((ext_vector_type(8)));
typedef float f32x4 __attribute__((ext_vector_type(4)));
typedef unsigned u32x4 __attribute__((ext_vector_type(4)));
constexpr int BM = 256, BK = 64, HALF = 128, HTB = HALF * BK * 2  , STAGE_BYTES = 8 * HTB, NXCD = 8, WGM = 8;

__host__ __device__ __forceinline__ int lds_byte(int r, int c) { const int st = (r >> 4) * 2 + (c >> 5), rr = r & 15, cc = c & 31, ob = rr * 64 + cc * 2; return st * 1024 + (ob ^ (((ob >> 9) & 1) << 5)); }
__host__ __device__ __forceinline__ void stage_rc(int b, int& R, int& C) { const int st = b / 1024, sb = b % 1024, swz = sb ^ (((sb >> 9) & 1) << 5); R = (st >> 1) * 16 + swz / 64; C = (st & 1) * 32 + (swz % 64) / 2; }
__host__ __device__ __forceinline__ int perm32(int rho) { const int n = rho >> 4, i = rho & 15; return 8 * (i >> 2) + 4 * n + (i & 3); }

struct Unit { int pm, pn; };
struct Gemm { const bf16_t* A; const bf16_t* Bt; int M, N, K, lda; };

struct StaticOrder {
    int nM, nN, nwg, G, c;
    __host__ __device__ void init(int M, int N, int G_, int c_) { nM = M / BM; nN = N / BM; nwg = nM * nN; G = G_; c = c_; }
    __host__ __device__ bool next(int i, Unit& u) const {
        const long L = (long)i * G + c; if (L >= nwg) return false;
        int wgid = (int)L; { const int q = nwg / NXCD, r = nwg % NXCD, xcd = wgid % NXCD, off = wgid / NXCD; wgid = (xcd < r ? xcd * (q + 1) : r * (q + 1) + (xcd - r) * q) + off; }
        const int nig = WGM * nN, gid = wgid / nig, fm = gid * WGM, gsz = (nM - fm) < WGM ? (nM - fm) : WGM;
        u.pm = fm + ((wgid % nig) % gsz); u.pn = (wgid % nig) / gsz; return true;
    }
    __device__ __forceinline__ void a_ready(const Unit&) const {}
    __device__ __forceinline__ void done(const Unit&) const {}
};


__device__ __forceinline__ unsigned cvt_pk_bf16(float lo, float hi) { unsigned r; asm volatile("v_cvt_pk_bf16_f32 %0, %1, %2" : "=v"(r) : "v"(lo), "v"(hi)); return r; }
typedef unsigned u32x2 __attribute__((ext_vector_type(2)));
__device__ __forceinline__ u32x4 pack8(const f32x4 a, const f32x4 b) { u32x4 w; w.x = cvt_pk_bf16(a[0], a[1]); w.y = cvt_pk_bf16(a[2], a[3]); w.z = cvt_pk_bf16(b[0], b[1]); w.w = cvt_pk_bf16(b[2], b[3]); return w; }
__device__ __forceinline__ float dot4(const f32x4 a) { return (a[0] * a[0] + a[1] * a[1]) + (a[2] * a[2] + a[3] * a[3]); }

struct EpiP {
    static constexpr bool PERM = true, AFTER_DRAIN = false;
    bf16_t* O; int ldc; float* rss;
    __device__ __forceinline__ void operator()(const f32x4 (&acc)[2][2][4][2], const Unit& u, int wr, int wc, int fr, int fq) const {
        const int row0 = u.pm * BM + wr * 64 + fr, col0 = u.pn * BM + wc * 32 + 8 * fq;
#pragma unroll
        for (int ai = 0; ai < 2; ++ai)
#pragma unroll
            for (int m = 0; m < 4; ++m) { const int row = row0 + ai * HALF + m * 16; bf16_t* rowp = O + (size_t)row * ldc + col0; float ss = 0.f;
#pragma unroll
                for (int bj = 0; bj < 2; ++bj) { const f32x4 v0 = acc[ai][bj][m][0], v1 = acc[ai][bj][m][1]; ss += dot4(v0) + dot4(v1); *(u32x4*)(rowp + bj * HALF) = pack8(v0, v1); }
                if (u.pn < 3) { ss += __shfl_xor(ss, 16); ss += __shfl_xor(ss, 32); if (fq == 0) rss[(size_t)row * 12 + u.pn * 4 + wc] = ss; } }
    }
};
struct EpiQ {
    static constexpr bool PERM = false, AFTER_DRAIN = false;
    bf16_t* Q; const float* rss;
    __device__ __forceinline__ void operator()(const f32x4 (&acc)[2][2][4][2], const Unit& u, int wr, int wc, int fr, int fq) const {
        const int row0 = u.pm * BM + wr * 64 + fr;
        float rev[4];
#pragma unroll
        for (int e = 0; e < 4; ++e) rev[e] = __builtin_amdgcn_exp2f(-(float)(4 * fq + e) * 0.83048202372184059f) * 0.15915494309189535f;
#pragma unroll
        for (int ai = 0; ai < 2; ++ai)
#pragma unroll
            for (int m = 0; m < 4; ++m) { const int row = row0 + ai * HALF + m * 16;
                const f32x4 s0 = *(const f32x4*)(rss + (size_t)row * 12), s1 = *(const f32x4*)(rss + (size_t)row * 12 + 4);
                const float ss = ((s0[0] + s0[1]) + (s0[2] + s0[3])) + ((s1[0] + s1[1]) + (s1[2] + s1[3]));
                const float rstd = __builtin_amdgcn_rsqf(ss * (1.0f / 512.0f) + 1e-6f);
                const int t = row & (T - 1); const float pr = (float)(t >> 6), pc = (float)(t & 63);
#pragma unroll
                for (int bj = 0; bj < 2; ++bj) { const int g32 = 8 * u.pn + 4 * bj + wc, gi = g32 % 6; const int col = 256 * u.pn + 128 * bj + 32 * wc + 4 * fq;
                    f32x4 v0 = acc[ai][bj][m][0] * rstd, v1 = acc[ai][bj][m][1] * rstd;
                    if (gi >= 4) { const float pos = gi == 4 ? pr : pc;
#pragma unroll
                        for (int e = 0; e < 4; ++e) { float r = pos * rev[e]; r = r - __builtin_floorf(r); const float sn = __builtin_amdgcn_sinf(r), cs = __builtin_amdgcn_cosf(r);
                            const float x1 = v0[e], x2 = v1[e]; v0[e] = x1 * cs - x2 * sn; v1[e] = x1 * sn + x2 * cs; } }
                    u32x2 w0, w1; w0.x = cvt_pk_bf16(v0[0], v0[1]); w0.y = cvt_pk_bf16(v0[2], v0[3]); w1.x = cvt_pk_bf16(v1[0], v1[1]); w1.y = cvt_pk_bf16(v1[2], v1[3]);
                    bf16_t* p = Q + (size_t)row * 1536 + col; *(u32x2*)p = w0; *(u32x2*)(p + 16) = w1; } }
    }
};
struct EpiKV {
    static constexpr bool PERM = true, AFTER_DRAIN = false;
    bf16_t* KN; bf16_t* V; const float* rss;
    __device__ __forceinline__ void operator()(const f32x4 (&acc)[2][2][4][2], const Unit& u, int wr, int wc, int fr, int fq) const {
        const int row0 = u.pm * BM + wr * 64 + fr;
#pragma unroll
        for (int ai = 0; ai < 2; ++ai)
#pragma unroll
            for (int m = 0; m < 4; ++m) { const int row = row0 + ai * HALF + m * 16;
                const f32x4 s0 = *(const f32x4*)(rss + (size_t)row * 12 + 8);
                const float rstd = __builtin_amdgcn_rsqf(((s0[0] + s0[1]) + (s0[2] + s0[3])) * (1.0f / 256.0f) + 1e-6f);
                int b, key; if (row < MROWS) { b = row >> 13; key = row & (T - 1); } else { const int r2 = row - MROWS; b = r2 >> 8; key = T + (r2 & 255); }
                const size_t off = ((size_t)(b * 8 + u.pn) * NKEY + key) * 128 + wc * 32 + 8 * fq;
                *(u32x4*)(KN + off) = pack8(acc[ai][0][m][0] * rstd, acc[ai][0][m][1] * rstd);
                *(u32x4*)(V + off) = pack8(acc[ai][1][m][0] * rstd, acc[ai][1][m][1] * rstd); }
    }
};
struct EpiOut {
    static constexpr bool PERM = false, AFTER_DRAIN = false;
    const float* x; float* X1; const float* g1;
    __device__ __forceinline__ void operator()(const f32x4 (&acc)[2][2][4][2], const Unit& u, int wr, int wc, int fr, int fq) const {
        const int row0 = u.pm * BM + wr * 64 + fr, col0 = u.pn * BM + wc * 32 + 4 * fq; const int b = (u.pm * BM) >> 13;
        f32x4 gv[2][2];
#pragma unroll
        for (int bj = 0; bj < 2; ++bj)
#pragma unroll
            for (int n = 0; n < 2; ++n) gv[bj][n] = *(const f32x4*)(g1 + (size_t)b * 6 * DM + col0 + bj * HALF + n * 16);
#pragma unroll
        for (int ai = 0; ai < 2; ++ai)
#pragma unroll
            for (int m = 0; m < 4; ++m) { const size_t off = (size_t)(row0 + ai * HALF + m * 16) * DM + col0;
#pragma unroll
                for (int bj = 0; bj < 2; ++bj)
#pragma unroll
                    for (int n = 0; n < 2; ++n) { const f32x4 xv = *(const f32x4*)(x + off + bj * HALF + n * 16); *(f32x4*)(X1 + off + bj * HALF + n * 16) = xv + gv[bj][n] * acc[ai][bj][m][n]; }
                if (m & 1) asm volatile("" ::: "memory"); }
    }
};
struct EpiMoe1 {
    static constexpr bool PERM = true, AFTER_DRAIN = false;
    bf16_t* HM;
    __device__ __forceinline__ void operator()(const f32x4 (&acc)[2][2][4][2], const Unit& u, int wr, int wc, int fr, int fq) const {
        const int row0 = u.pm * BM + wr * 64 + fr, col0 = (u.pn & 3) * 128 + wc * 32 + 8 * fq;
#pragma unroll
        for (int ai = 0; ai < 2; ++ai)
#pragma unroll
            for (int m = 0; m < 4; ++m) { f32x4 h[2];
#pragma unroll
                for (int n = 0; n < 2; ++n)
#pragma unroll
                    for (int e = 0; e < 4; ++e) { const float a = acc[ai][0][m][n][e], b = acc[ai][1][m][n][e]; h[n][e] = a * __builtin_amdgcn_rcpf(1.0f + __expf(-a)) * b; }
                *(u32x4*)(HM + (size_t)(row0 + ai * HALF + m * 16) * DEXP + col0) = pack8(h[0], h[1]); }
    }
};
struct EpiMoe2 {
    static constexpr bool PERM = true, AFTER_DRAIN = false;
    bf16_t* Y; const float* rowgate;
    __device__ __forceinline__ void operator()(const f32x4 (&acc)[2][2][4][2], const Unit& u, int wr, int wc, int fr, int fq) const {
        const int row0 = u.pm * BM + wr * 64 + fr, col0 = (u.pn & 7) * 256 + wc * 32 + 8 * fq;
#pragma unroll
        for (int ai = 0; ai < 2; ++ai)
#pragma unroll
            for (int m = 0; m < 4; ++m) { const int row = row0 + ai * HALF + m * 16; const float gt = rowgate[row];
#pragma unroll
                for (int bj = 0; bj < 2; ++bj) *(u32x4*)(Y + (size_t)row * DM + col0 + bj * HALF) = pack8(acc[ai][bj][m][0] * gt, acc[ai][bj][m][1] * gt); }
    }
};
struct MoeOrder {
    const PG8_LAS int* tile_e; int ntiles, NJ, G, c;
    __device__ __forceinline__ bool next(int i, Unit& u) const { const int L = i * G + c; if (L >= ntiles * NJ) return false; const int rt = L / NJ, j = L - rt * NJ; u.pm = rt; u.pn = tile_e[rt] * NJ + j; return true; }
    __device__ __forceinline__ void a_ready(const Unit&) const {}
    __device__ __forceinline__ void done(const Unit&) const {}
};

template <class Epi, class Sched, bool ALIGN_EPI = false, bool SP2 = false>
__device__ __forceinline__ void gemm_phase(PG8_LAS unsigned char* lds, const Gemm g, const Sched& S, const Epi& E) {
    const int tid = threadIdx.x, wid = __builtin_amdgcn_readfirstlane(tid >> 6), lane = tid & 63, wr = wid >> 2, wc = wid & 3, fr = lane & 15, fq = lane >> 4;
    const int K = g.K, nt = K / BK;
    unsigned voffA[2], voffB[2];
#pragma unroll
    for (int i = 0; i < 2; ++i) { int R, C; stage_rc(tid * 16 + i * 8192, R, C); const int Rb = Epi::PERM ? ((R & ~31) + perm32(R & 31)) : R;
        voffA[i] = (unsigned)(R * g.lda + C) * 2u; voffB[i] = (unsigned)(Rb * K + C) * 2u; }
    const size_t kstep = (size_t)(BK * 2);
    const size_t hstepA = (size_t)HALF * g.lda * 2, hstepB = (size_t)HALF * K * 2;
    const size_t tstepA = 2 * hstepA, tstepB = 2 * hstepB;
    const unsigned ldsw = (unsigned)wid * 1024u;
    const int aoff = lds_byte(wr * 64 + fr, fq * 8), boff = lds_byte(wc * 32 + fr, fq * 8);
#define PG8_SA(b, h) (((b) * 2 + (h)) * HTB)
#define PG8_SB(b, h) ((4 + (b) * 2 + (h)) * HTB)
#define PG8_STAGE(bufoff, gbase, voff) do { _Pragma("unroll") for (int _i = 0; _i < 2; ++_i) \
        __builtin_amdgcn_global_load_lds((const unsigned*)((const char*)(gbase) + (voff)[_i]), (PG8_LAS unsigned*)(lds + (bufoff) + ldsw + _i * 8192), 16, 0, 0); } while (0)
#define PG8_LDA(dst, b, h) do { _Pragma("unroll") for (int m = 0; m < 4; ++m) _Pragma("unroll") for (int k = 0; k < 2; ++k) dst[m][k] = *(const PG8_LAS bf16x8*)(lds + PG8_SA(b, h) + aoff + m * 2048 + k * 1024); } while (0)
#define PG8_LDB(dst, b, h) do { _Pragma("unroll") for (int n = 0; n < 2; ++n) _Pragma("unroll") for (int k = 0; k < 2; ++k) dst[n][k] = *(const PG8_LAS bf16x8*)(lds + PG8_SB(b, h) + boff + n * 2048 + k * 1024); } while (0)
#define PG8_MMA(ai, bj, At, Bt) do { __builtin_amdgcn_s_setprio(1); _Pragma("unroll") for (int m = 0; m < 4; ++m) _Pragma("unroll") for (int n = 0; n < 2; ++n) _Pragma("unroll") for (int k = 0; k < 2; ++k) \
        acc[ai][bj][m][n] = __builtin_amdgcn_mfma_f32_16x16x32_bf16(Bt[n][k], At[m][k], acc[ai][bj][m][n], 0, 0, 0); __builtin_amdgcn_s_setprio(0); } while (0)
#define PG8_WAIT_V(n) asm volatile("s_waitcnt vmcnt(" #n ")" ::: "memory")
#define PG8_WAIT_L(n) asm volatile("s_waitcnt lgkmcnt(" #n ")" ::: "memory")
#define PG8_BAR __builtin_amdgcn_s_barrier()
#define PG8_SCHED __builtin_amdgcn_sched_barrier(0)
    Unit cur, nxt; int ui = 0;
    if (!S.next(0, cur)) return;
    f32x4 acc[2][2][4][2];
#pragma unroll
    for (int a = 0; a < 2; ++a)
#pragma unroll
        for (int b = 0; b < 2; ++b)
#pragma unroll
            for (int m = 0; m < 4; ++m)
#pragma unroll
                for (int n = 0; n < 2; ++n) acc[a][b][m][n] = (f32x4){0.f, 0.f, 0.f, 0.f};
    bf16x8 At[4][2], B0[2][2], B1[2][2];
    const char* cA = (const char*)g.A + (size_t)cur.pm * tstepA; const char* cB = (const char*)g.Bt + (size_t)cur.pn * tstepB;
    S.a_ready(cur);
    if constexpr (SP2) {
        PG8_STAGE(PG8_SB(0, 0), cB, voffB); PG8_STAGE(PG8_SB(0, 1), cB + hstepB, voffB); PG8_STAGE(PG8_SA(0, 0), cA, voffA); PG8_STAGE(PG8_SA(0, 1), cA + hstepA, voffA);
        if (wr == 1) PG8_BAR;
        PG8_WAIT_V(2); PG8_BAR;
        PG8_STAGE(PG8_SB(1, 0), cB + kstep, voffB); PG8_STAGE(PG8_SA(1, 0), cA + kstep, voffA); PG8_STAGE(PG8_SB(1, 1), cB + hstepB + kstep, voffB);
        PG8_WAIT_V(6); PG8_BAR;
    } else {
        PG8_STAGE(PG8_SB(0, 0), cB, voffB); PG8_STAGE(PG8_SA(0, 0), cA, voffA); PG8_STAGE(PG8_SB(0, 1), cB + hstepB, voffB); PG8_STAGE(PG8_SA(0, 1), cA + hstepA, voffA);
        if (wr == 1) PG8_BAR;
        PG8_WAIT_V(4); PG8_BAR;
        PG8_STAGE(PG8_SB(1, 0), cB + kstep, voffB); PG8_STAGE(PG8_SA(1, 0), cA + kstep, voffA); PG8_STAGE(PG8_SB(1, 1), cB + hstepB + kstep, voffB);
        PG8_WAIT_V(6); PG8_BAR;
    }
    for (;;) {
        const bool has_next = S.next(ui + 1, nxt);
        const char* nA = has_next ? (const char*)g.A + (size_t)nxt.pm * tstepA : cA; const char* nB = has_next ? (const char*)g.Bt + (size_t)nxt.pn * tstepB : cB;
        for (int t = 0; t < nt; t += 2) {
            const bool last = (t == nt - 2);
            const char* a1 = cA + (size_t)(t + 1) * kstep;
            const char* a2 = last ? nA : cA + (size_t)(t + 2) * kstep; const char* b2 = last ? nB : cB + (size_t)(t + 2) * kstep;
            const char* a3 = a2 + kstep; const char* b3 = b2 + kstep;
            if (last && has_next) S.a_ready(nxt);
            if constexpr (SP2) {
            PG8_LDB(B0, 0, 0); PG8_LDB(B1, 0, 1); PG8_SCHED; PG8_LDA(At, 0, 0); PG8_STAGE(PG8_SA(1, 1), a1 + hstepA, voffA);
            PG8_WAIT_V(8); PG8_WAIT_L(0); PG8_BAR; PG8_MMA(0, 0, At, B0); PG8_MMA(0, 1, At, B1); PG8_BAR; PG8_SCHED;
            PG8_LDA(At, 0, 1); PG8_STAGE(PG8_SB(0, 0), b2, voffB); PG8_STAGE(PG8_SB(0, 1), b2 + hstepB, voffB); PG8_STAGE(PG8_SA(0, 0), a2, voffA);
            PG8_WAIT_V(8); PG8_WAIT_L(0); PG8_BAR; PG8_MMA(1, 0, At, B0); PG8_MMA(1, 1, At, B1); PG8_BAR; PG8_SCHED;
            PG8_LDB(B0, 1, 0); PG8_LDB(B1, 1, 1); PG8_SCHED; PG8_LDA(At, 1, 0); PG8_STAGE(PG8_SA(0, 1), a2 + hstepA, voffA);
            PG8_WAIT_V(8); PG8_WAIT_L(0); PG8_BAR; PG8_MMA(0, 0, At, B0); PG8_MMA(0, 1, At, B1); PG8_BAR; PG8_SCHED;
            PG8_LDA(At, 1, 1); PG8_STAGE(PG8_SB(1, 0), b3, voffB); PG8_STAGE(PG8_SB(1, 1), b3 + hstepB, voffB); PG8_STAGE(PG8_SA(1, 0), a3, voffA);
            PG8_WAIT_V(8); PG8_WAIT_L(0); PG8_BAR; PG8_MMA(1, 0, At, B0); PG8_MMA(1, 1, At, B1); PG8_BAR; PG8_SCHED;
            } else {
            PG8_LDB(B0, 0, 0); PG8_SCHED; PG8_LDA(At, 0, 0); PG8_STAGE(PG8_SA(1, 1), a1 + hstepA, voffA);
            PG8_WAIT_L(8); PG8_BAR; PG8_WAIT_L(0); PG8_MMA(0, 0, At, B0); PG8_BAR; PG8_SCHED;
            PG8_LDB(B1, 0, 1); PG8_STAGE(PG8_SB(0, 0), b2, voffB);
            PG8_BAR; PG8_WAIT_L(0); PG8_MMA(0, 1, At, B1); PG8_BAR;
            PG8_LDA(At, 0, 1); PG8_STAGE(PG8_SA(0, 0), a2, voffA);
            PG8_BAR; PG8_WAIT_L(0); PG8_MMA(1, 0, At, B0); PG8_BAR; PG8_SCHED;
            PG8_STAGE(PG8_SB(0, 1), b2 + hstepB, voffB);
            PG8_WAIT_V(6); PG8_BAR; PG8_MMA(1, 1, At, B1); PG8_BAR;
            PG8_LDB(B0, 1, 0); PG8_SCHED; PG8_LDA(At, 1, 0); PG8_STAGE(PG8_SA(0, 1), a2 + hstepA, voffA);
            PG8_WAIT_L(8); PG8_BAR; PG8_WAIT_L(0); PG8_MMA(0, 0, At, B0); PG8_BAR; PG8_SCHED;
            PG8_LDB(B1, 1, 1); PG8_STAGE(PG8_SB(1, 0), b3, voffB);
            PG8_BAR; PG8_WAIT_L(0); PG8_MMA(0, 1, At, B1); PG8_BAR;
            PG8_LDA(At, 1, 1); PG8_STAGE(PG8_SA(1, 0), a3, voffA);
            PG8_BAR; PG8_WAIT_L(0); PG8_MMA(1, 0, At, B0); PG8_BAR; PG8_SCHED;
            PG8_STAGE(PG8_SB(1, 1), b3 + hstepB, voffB);
            PG8_WAIT_V(6); PG8_BAR; PG8_MMA(1, 1, At, B1); PG8_BAR;
            }
        }
        if constexpr (ALIGN_EPI) { if (wr == 0) PG8_BAR; }
        if constexpr (!Epi::AFTER_DRAIN) { E(acc, cur, wr, wc, fr, fq); S.done(cur); }
        if (!has_next) break;
#pragma unroll
        for (int a = 0; a < 2; ++a)
#pragma unroll
            for (int b = 0; b < 2; ++b)
#pragma unroll
                for (int m = 0; m < 4; ++m)
#pragma unroll
                    for (int n = 0; n < 2; ++n) acc[a][b][m][n] = (f32x4){0.f, 0.f, 0.f, 0.f};
        cur = nxt; cA = nA; cB = nB; ++ui;
        if constexpr (ALIGN_EPI) { if (wr == 1) PG8_BAR; }
    }
    PG8_WAIT_V(0);
    if constexpr (!ALIGN_EPI) { if (wr == 0) PG8_BAR; }
    PG8_BAR;
    if constexpr (Epi::AFTER_DRAIN) { E.fused(acc, cur, wr, wc, fr, fq, lds, wid, lane); S.done(cur); }
#undef PG8_SA
#undef PG8_SB
#undef PG8_STAGE
#undef PG8_LDA
#undef PG8_LDB
#undef PG8_MMA
#undef PG8_WAIT_V
#undef PG8_WAIT_L
#undef PG8_BAR
#undef PG8_SCHED
}
}

namespace att {
using bf16x8 = __attribute__((ext_vector_type(8))) short;
using u32x4 = __attribute__((ext_vector_type(4))) unsigned;
constexpr int D = 128, DR = 64, NW = 8, QBLK = 32, KVBLK = 64;
constexpr float SCALE = 0.07216878364870322f;
constexpr float THR = 8.f;
#ifndef ATT_SDEPTH
#define ATT_SDEPTH 1
#endif
#ifndef ATT_QROPE_LDS
#define ATT_QROPE_LDS 1
#endif
constexpr int SDEPTH = ATT_SDEPTH; constexpr bool QROPE_LDS = ATT_QROPE_LDS;
constexpr int LDQ = 1536, LDK = 128, LDR = 64, LDO = 2048;
constexpr int SHM_V = KVBLK * D * 2, SHM_K = KVBLK * D * 2, SHM_R = KVBLK * DR * 2;
constexpr int OFF_V = 0, OFF_K = 2 * SHM_V, OFF_R = OFF_K + 2 * SHM_K, OFF_WS = OFF_R + 2 * SHM_R, OFF_QR = OFF_WS + NW * 64 * 4, SHM_ATTN = OFF_QR + 256 * DR * 2;
#define KSWZ(row, colB) ((row) * 256 + ((colB) ^ (((row) & 7) << 4)))
#define RSWZ(row, colB) ((row) * 128 + ((colB) ^ ((((row) >> 1) & 7) << 4)))
#define SBAR() __builtin_amdgcn_sched_barrier(0)
__device__ __forceinline__ int crow(int r, int hi) { return (r & 3) + 8 * (r >> 2) + 4 * hi; }
__device__ __forceinline__ unsigned cvtpk(float lo, float hi) { unsigned r; asm volatile("v_cvt_pk_bf16_f32 %0, %1, %2" : "=v"(r) : "v"(lo), "v"(hi)); return r; }
__device__ __forceinline__ void partialSM(f32x16& p0, f32x16& p1, float& m_reg, float& mn, float& alpha) {
  constexpr float C = SCALE * 1.4426950408889634f;
  float pmax = p0[0]; for (int r = 1; r < 16; ++r) pmax = fmaxf(pmax, p0[r]); for (int r = 0; r < 16; ++r) pmax = fmaxf(pmax, p1[r]);
  { auto rr = __builtin_amdgcn_permlane32_swap(__float_as_uint(pmax), __float_as_uint(pmax), false, false);
    pmax = fmaxf(__uint_as_float(rr[0]), __uint_as_float(rr[1])); }
  if (__builtin_expect(__all(pmax - m_reg <= THR / SCALE), 1)) { mn = m_reg; alpha = 1.f; }
  else { mn = fmaxf(m_reg, pmax); alpha = __builtin_amdgcn_exp2f((m_reg - mn) * C); m_reg = mn; }
  float mnC = -mn * C;
  for (int r = 0; r < 16; ++r) p0[r] = fmaf(p0[r], C, mnC); for (int r = 0; r < 16; ++r) p1[r] = fmaf(p1[r], C, mnC);
  for (int r = 0; r < 16; ++r) p0[r] = __builtin_amdgcn_exp2f(p0[r]);
}
__device__ __forceinline__ void finishSM(f32x16& p0, f32x16& p1, float alpha, float& l_reg, bf16x8& pa0, bf16x8& pa1, bf16x8& pa2, bf16x8& pa3) {
  for (int r = 0; r < 16; ++r) p1[r] = __builtin_amdgcn_exp2f(p1[r]);
  float ps = 0; for (int r = 0; r < 16; ++r) ps += p0[r]; for (int r = 0; r < 16; ++r) ps += p1[r];
  { auto rr = __builtin_amdgcn_permlane32_swap(__float_as_uint(ps), __float_as_uint(ps), false, false);
    ps = __uint_as_float(rr[0]) + __uint_as_float(rr[1]); }
  l_reg = l_reg * alpha + ps;
#define PK4(P, BASE, OUT) do { unsigned a0 = cvtpk(P[BASE + 0], P[BASE + 1]), a1 = cvtpk(P[BASE + 2], P[BASE + 3]);   \
    unsigned b0 = cvtpk(P[BASE + 4], P[BASE + 5]), b1 = cvtpk(P[BASE + 6], P[BASE + 7]);                              \
    auto r0 = __builtin_amdgcn_permlane32_swap(a0, b0, false, false); auto r1 = __builtin_amdgcn_permlane32_swap(a1, b1, false, false); \
    u32x4 w = {r0[0], r1[0], r0[1], r1[1]}; OUT = *reinterpret_cast<bf16x8*>(&w); } while (0)
  PK4(p0, 0, pa0); PK4(p0, 8, pa1); PK4(p1, 0, pa2); PK4(p1, 8, pa3);
#undef PK4
}
__device__ __forceinline__ void qkt(f32x16& p0, f32x16& p1, const char* Ks, const char* Rs, const bf16x8* qr, int r32, int hi, const char* Qrs) {
  p0 = f32x16{}; p1 = f32x16{};
#pragma unroll
  for (int d0 = 0; d0 < 8; ++d0) { int cb = (d0 * 16 + hi * 8) * 2;
    bf16x8 b0 = *reinterpret_cast<const bf16x8*>(Ks + KSWZ(r32, cb));
    bf16x8 b1 = *reinterpret_cast<const bf16x8*>(Ks + KSWZ(32 + r32, cb));
    p0 = __builtin_amdgcn_mfma_f32_32x32x16_bf16(b0, qr[d0], p0, 0, 0, 0);
    p1 = __builtin_amdgcn_mfma_f32_32x32x16_bf16(b1, qr[d0], p1, 0, 0, 0);
#ifdef ATT_QK_SBAR
    if (d0 == 3 || d0 == 7) SBAR();
#endif
  }
#pragma unroll
  for (int d0 = 0; d0 < 4; ++d0) { int cb = (d0 * 16 + hi * 8) * 2;
    bf16x8 b0 = *reinterpret_cast<const bf16x8*>(Rs + d0 * 2048 + r32 * 32 + hi * 16);
    bf16x8 b1 = *reinterpret_cast<const bf16x8*>(Rs + d0 * 2048 + 1024 + r32 * 32 + hi * 16);
    bf16x8 qf; if constexpr (QROPE_LDS) qf = *reinterpret_cast<const bf16x8*>(Qrs + d0 * 8192); else qf = qr[8 + d0];
    p0 = __builtin_amdgcn_mfma_f32_32x32x16_bf16(b0, qf, p0, 0, 0, 0);
    p1 = __builtin_amdgcn_mfma_f32_32x32x16_bf16(b1, qf, p1, 0, 0, 0); }
}
__device__ __forceinline__ int v_st(int k, int c) { const int kk = (k & ~0xC) | ((k & 4) << 1) | ((k & 8) >> 1); return ((kk >> 3) * 4 + (c >> 5)) * 512 + ((kk & 7) * 32 + (c & 31)) * 2; }
__device__ __forceinline__ int v_rd_base(int lane) { return ((lane & 3) << 3) | (((lane >> 2) & 3) << 6) | (((lane >> 4) & 1) << 5) | (((lane >> 5) & 1) << 8); }
constexpr int v_rd_off(int d0, int ks, int half) { return d0 * 512 + ks * 4096 + half * 2048; }
template <int OFF> __device__ __forceinline__ s16x4 tr_read(int vb) {
  s16x4 r; asm volatile("ds_read_b64_tr_b16 %0, %1 offset:%2" : "=&v"(r) : "v"(vb), "i"(OFF) : "memory"); return r;
}
template <int D0> __device__ __forceinline__ void pv_one(f32x16& od, int vb, bf16x8 pa0, bf16x8 pa1, bf16x8 pa2, bf16x8 pa3) {
  const s16x4 l0 = tr_read<v_rd_off(D0, 0, 0)>(vb), h0 = tr_read<v_rd_off(D0, 0, 1)>(vb), l1 = tr_read<v_rd_off(D0, 1, 0)>(vb), h1 = tr_read<v_rd_off(D0, 1, 1)>(vb);
  const s16x4 l2 = tr_read<v_rd_off(D0, 2, 0)>(vb), h2 = tr_read<v_rd_off(D0, 2, 1)>(vb), l3 = tr_read<v_rd_off(D0, 3, 0)>(vb), h3 = tr_read<v_rd_off(D0, 3, 1)>(vb);
  asm volatile("s_waitcnt lgkmcnt(0)" ::: "memory"); SBAR();
#define PK(L, H) (bf16x8){L[0], L[1], L[2], L[3], H[0], H[1], H[2], H[3]}
  od = __builtin_amdgcn_mfma_f32_32x32x16_bf16(pa0, PK(l0, h0), od, 0, 0, 0);
  od = __builtin_amdgcn_mfma_f32_32x32x16_bf16(pa1, PK(l1, h1), od, 0, 0, 0);
  od = __builtin_amdgcn_mfma_f32_32x32x16_bf16(pa2, PK(l2, h2), od, 0, 0, 0);
  od = __builtin_amdgcn_mfma_f32_32x32x16_bf16(pa3, PK(l3, h3), od, 0, 0, 0);
#undef PK
}
__device__ __forceinline__ void pv_d0(f32x16* o, int vb, bf16x8 pa0, bf16x8 pa1, bf16x8 pa2, bf16x8 pa3) {
  pv_one<0>(o[0], vb, pa0, pa1, pa2, pa3); pv_one<1>(o[1], vb, pa0, pa1, pa2, pa3); pv_one<2>(o[2], vb, pa0, pa1, pa2, pa3); pv_one<3>(o[3], vb, pa0, pa1, pa2, pa3);
}
__device__ __forceinline__ void attn_dense_body(const bf16* __restrict__ Qb, const bf16* __restrict__ Kh, const bf16* __restrict__ Vh, const bf16* __restrict__ Rh,
                                                bf16* __restrict__ Ob, int seq, char* lds) {
  const int tid = threadIdx.x, wid = tid >> 6, lane = tid & 63, r32 = lane & 31, hi = lane >> 5;
  char* V_lds = lds + OFF_V; char* K_lds = lds + OFF_K; char* R_lds = lds + OFF_R;
  float* ws = (float*)(lds + OFF_WS) + wid * 64; float* li_l = ws; float* al_l = ws + 32;
  float m_reg = -1e30f, l_reg = 0; f32x16 o[4] = {}; bf16x8 qr[QROPE_LDS ? 8 : 12];
  int tq_ = threadIdx.x; asm volatile("" : "+v"(tq_));
  const bf16* Qw = (const bf16*)((const char*)Qb + (unsigned)((((tq_ >> 6) * QBLK + (tq_ & 31)) * LDQ + ((tq_ >> 5) & 1) * 8) * 2));
  const char* Qrs = lds + OFF_QR + (wid * QBLK + r32) * 32 + hi * 16;
#pragma unroll
  for (int d0 = 0; d0 < (QROPE_LDS ? 8 : 12); ++d0) qr[d0] = *reinterpret_cast<const bf16x8*>(Qw + d0 * 16);
  if constexpr (QROPE_LDS) {
#pragma unroll
    for (int d0 = 0; d0 < 4; ++d0) { const bf16x8 t = *reinterpret_cast<const bf16x8*>(Qw + 128 + d0 * 16); *(bf16x8*)(lds + OFF_QR + d0 * 8192 + (wid * QBLK + r32) * 32 + hi * 16) = t; }
    asm volatile("s_waitcnt lgkmcnt(0)" ::: "memory");
  }
  const int sr = tid >> 4, sc = (tid & 15) * 8, vst0 = v_st(sr, sc), vst1 = v_st(32 + sr, sc);
  const int rr_ = tid >> 3, rc_ = (tid & 7) * 8, rst_ = (rc_ >> 4) * 2048 + rr_ * 32 + (rc_ & 8) * 2;
  const int vb0 = (int)(uintptr_t)(V_lds) + v_rd_base(lane);
  struct { bf16x8 vs0, vs1, ks0, ks1, rs0; } sr_[SDEPTH];
  const unsigned kvo_ = (unsigned)((sr * LDK + sc) * 2), ro_ = (unsigned)((rr_ * LDR + rc_) * 2);
#define SLOAD(i, k0) do { const char* vb_ = (const char*)Vh + (size_t)(k0) * (LDK * 2); const char* kb_ = (const char*)Kh + (size_t)(k0) * (LDK * 2); const char* rb_ = (const char*)Rh + (size_t)(k0) * (LDR * 2); \
    sr_[i].vs0 = *(const bf16x8*)(vb_ + kvo_); sr_[i].vs1 = *(const bf16x8*)(vb_ + 32 * LDK * 2 + kvo_); \
    sr_[i].ks0 = *(const bf16x8*)(kb_ + kvo_); sr_[i].ks1 = *(const bf16x8*)(kb_ + 32 * LDK * 2 + kvo_); \
    sr_[i].rs0 = *(const bf16x8*)(rb_ + ro_); } while (0)
#define SWRITE(b, i) do { *(bf16x8*)(V_lds + (b) * SHM_V + vst0) = sr_[i].vs0;          \
    *(bf16x8*)(V_lds + (b) * SHM_V + vst1) = sr_[i].vs1; int kc = sc * 2;               \
    *(bf16x8*)(K_lds + (b) * SHM_K + KSWZ(sr, kc)) = sr_[i].ks0;                       \
    *(bf16x8*)(K_lds + (b) * SHM_K + KSWZ(32 + sr, kc)) = sr_[i].ks1;                  \
    *(bf16x8*)(R_lds + (b) * SHM_R + rst_) = sr_[i].rs0; } while (0)
#define SWAIT() do { if constexpr (SDEPTH == 2) asm volatile("s_waitcnt vmcnt(5)" ::: "memory"); else asm volatile("s_waitcnt vmcnt(0)" ::: "memory"); } while (0)
#define RESC(a) do { if (__any((a) < 1.f)) { if (hi == 0) al_l[r32] = (a); asm volatile("s_waitcnt lgkmcnt(0)" ::: "memory"); \
    for (int d = 0; d < 4; ++d) for (int r = 0; r < 16; ++r) o[d][r] *= al_l[crow(r, hi)]; } } while (0)
  f32x16 pA0, pA1, pB0, pB1; float mnA, mnB, alA, alB; bf16x8 pa0, pa1, pa2, pa3; const int NT = seq / KVBLK;
  constexpr int SE = 0, SO = SDEPTH - 1;
  SLOAD(SE, 0); asm volatile("s_waitcnt vmcnt(0)" ::: "memory"); SWRITE(0, SE); __syncthreads();
  qkt(pA0, pA1, K_lds, R_lds, qr, r32, hi, Qrs); partialSM(pA0, pA1, m_reg, mnA, alA);
  SLOAD(SO, KVBLK); if constexpr (SDEPTH == 2) { if (2 < NT) SLOAD(SE, 2 * KVBLK); }
  SWAIT(); SWRITE(1, SO); __syncthreads();
  for (int j = 1; j + 1 < NT; j += 2) {
    SBAR(); qkt(pB0, pB1, K_lds + SHM_K, R_lds + SHM_R, qr, r32, hi, Qrs);
    finishSM(pA0, pA1, alA, l_reg, pa0, pa1, pa2, pa3); SBAR();
    SLOAD(SO, (j + SDEPTH) * KVBLK); SBAR();
    pv_d0(o, vb0, pa0, pa1, pa2, pa3); partialSM(pB0, pB1, m_reg, mnB, alB);
    __syncthreads(); SWAIT(); SWRITE(0, SE);
    RESC(alB); __syncthreads();
    SBAR(); qkt(pA0, pA1, K_lds, R_lds, qr, r32, hi, Qrs);
    finishSM(pB0, pB1, alB, l_reg, pa0, pa1, pa2, pa3); SBAR();
    if (SDEPTH == 1 || j + 3 < NT) SLOAD(SE, (j + 1 + SDEPTH) * KVBLK); SBAR();
    pv_d0(o, vb0 + SHM_V, pa0, pa1, pa2, pa3); partialSM(pA0, pA1, m_reg, mnA, alA);
    __syncthreads(); SWAIT(); SWRITE(1, SO);
    RESC(alA); __syncthreads();
  }
  SBAR(); qkt(pB0, pB1, K_lds + SHM_K, R_lds + SHM_R, qr, r32, hi, Qrs);
  finishSM(pA0, pA1, alA, l_reg, pa0, pa1, pa2, pa3); SBAR();
  pv_d0(o, vb0, pa0, pa1, pa2, pa3); partialSM(pB0, pB1, m_reg, mnB, alB);
  __syncthreads(); RESC(alB);
  finishSM(pB0, pB1, alB, l_reg, pa0, pa1, pa2, pa3); SBAR();
  pv_d0(o, vb0 + SHM_V, pa0, pa1, pa2, pa3);
  if (hi == 0) li_l[r32] = l_reg; asm volatile("s_waitcnt lgkmcnt(0)" ::: "memory");
  float rli[16];
#pragma unroll
  for (int r = 0; r < 16; ++r) rli[r] = __builtin_amdgcn_rcpf(li_l[crow(r, hi)]);
  int tl_ = threadIdx.x; asm volatile("" : "+v"(tl_));
  const unsigned oo_ = (unsigned)((((tl_ >> 6) * QBLK + 4 * ((tl_ >> 5) & 1)) * LDO + (tl_ & 31)) * 2);
#pragma unroll
  for (int r = 0; r < 16; ++r) { const char* ob_ = (const char*)Ob + (size_t)(((r & 3) + 8 * (r >> 2)) * LDO * 2);
#pragma unroll
    for (int d0 = 0; d0 < 4; ++d0) { const unsigned w = cvtpk(o[d0][r] * rli[r], 0.f); *(bf16*)(ob_ + d0 * 64 + oo_) = (bf16)(w & 0xffffu); } }
  __syncthreads();
#undef SLOAD
#undef SWRITE
#undef SWAIT
#undef RESC
}
}


constexpr int NWAVES = 8, NTHR = 512;
constexpr int N_PHASES = 13;
#ifndef MK_N_LAUNCHES
#define MK_N_LAUNCHES 13
#endif
constexpr int N_LAUNCHES = MK_N_LAUNCHES;

constexpr size_t MiB = 1u << 20;
constexpr size_t WS_CTL = 0, CTL_ZERO_BYTES = 1 * MiB;
constexpr size_t WS_MODP = 1 * MiB, WS_MODF = 4 * MiB, WS_RSS = 5 * MiB, WS_ROUTE = 6 * MiB, WS_WRT = 8 * MiB, WS_LORA = 9 * MiB;
constexpr size_t WS_WTUQ = 10 * MiB, WS_WTUKV = 12 * MiB, WS_WTOUT = 13 * MiB, WS_WTIN = 21 * MiB;
constexpr size_t WS_SCAN = 40 * MiB, SCAN_ARR = (size_t)NB * RH * NKEY * RN * 2;
constexpr size_t WS_H = 40 * MiB;
constexpr size_t WS_G = 337 * MiB;
constexpr size_t WS_P = 369 * MiB;
constexpr size_t WS_Q = 510 * MiB, WS_KN = 558 * MiB, WS_V = 591 * MiB, WS_KR = 624 * MiB;
constexpr size_t WS_MIX = 369 * MiB;
constexpr size_t WS_W13T = 433 * MiB, WS_W2T = 561 * MiB;
constexpr size_t WS_H2 = 40 * MiB, WS_XG = 104 * MiB, WS_HM = 264 * MiB, WS_Y = 104 * MiB;
constexpr size_t WS_END = 627 * MiB;
static_assert(WS_SCAN + 9 * SCAN_ARR <= WS_G && WS_G + (size_t)MROWS * RW * 2 <= WS_P && WS_P + (size_t)MALL * NINP * 2 <= WS_Q, "ws map 1");
static_assert(WS_Q + (size_t)MROWS * 1536 * 2 <= WS_KN && WS_KN + (size_t)NB * 8 * NKEY * 128 * 2 <= WS_V && WS_V + (size_t)NB * 8 * NKEY * 128 * 2 <= WS_KR && WS_KR + (size_t)NB * NKEY * 64 * 2 <= WS_END, "ws map 2");
static_assert(WS_MIX + (size_t)MROWS * DM * 2 <= WS_W13T && WS_W13T + (size_t)NEXP * 1024 * DM * 2 <= WS_W2T && WS_W2T + (size_t)NEXP * DM * DEXP * 2 <= WS_END, "ws map 3");
static_assert(WS_H2 + (size_t)MROWS * DM * 2 <= WS_XG && WS_XG + (size_t)MAXTILES * 256 * DM * 2 <= WS_HM && WS_HM + (size_t)MAXTILES * 256 * DEXP * 2 <= WS_G, "ws map 4");
static_assert(WS_WTIN + (size_t)NINP * DM * 2 <= WS_SCAN && WS_H + (size_t)MALL * DM * 2 <= WS_G, "ws map 5");
constexpr int CW_CNT = 64;
constexpr int CW_BAR = 4096;
constexpr size_t RT_E = 0, RT_POS = 131072, RT_GATE = 262144, RT_ROW = 393216, RT_RGATE = 524288;

constexpr int RING_BYTES = 131072, MISC_OFF = 131072, EXTRA_OFF = 131584, LDS_BYTES = 155648;

#define LDS_WAIT() asm volatile("s_waitcnt lgkmcnt(0)" ::: "memory")
#define VM_WAIT() asm volatile("s_waitcnt vmcnt(0)" ::: "memory")
__device__ __forceinline__ unsigned f2bf(float f) { unsigned u = __builtin_bit_cast(unsigned, f); return (u + 0x7fffu + ((u >> 16) & 1u)) >> 16; }
__device__ __forceinline__ unsigned pk2(float lo, float hi) { return pg8::cvt_pk_bf16(lo, hi); }
__device__ __forceinline__ float bflo(unsigned w) { return __builtin_bit_cast(float, w << 16); }
__device__ __forceinline__ float bfhi(unsigned w) { return __builtin_bit_cast(float, w & 0xffff0000u); }
__device__ __forceinline__ float bf1(bf16 h) { return __builtin_bit_cast(float, (unsigned)h << 16); }
__device__ __forceinline__ void unpack8(const v4u w, float (&f)[8]) { f[0] = bflo(w.x); f[1] = bfhi(w.x); f[2] = bflo(w.y); f[3] = bfhi(w.y); f[4] = bflo(w.z); f[5] = bfhi(w.z); f[6] = bflo(w.w); f[7] = bfhi(w.w); }
__device__ __forceinline__ v4u pack8f(const float (&f)[8]) { v4u w; w.x = pk2(f[0], f[1]); w.y = pk2(f[2], f[3]); w.z = pk2(f[4], f[5]); w.w = pk2(f[6], f[7]); return w; }
__device__ __forceinline__ float wave_sum(float v) {
#pragma unroll
    for (int o = 1; o < 64; o <<= 1) v += __shfl_xor(v, o);
    return v;
}
__device__ __forceinline__ float sigmoidf_(float x) { return __builtin_amdgcn_rcpf(1.0f + __expf(-x)); }

#define XB_TMO      128
#define XB_XCNT(j)  (256  + 64 * (j))
#define XB_XSUB(j)  (1280 + 64 * (j))
#define XB_XGEN(j)  (2304 + 64 * (j))
#define XB_TOP      3328
#define XB_TOPGEN   3392
#define XCD_BAR_WORDS 3456
#define XB_SPIN_CAP (1u << 18)

__device__ __forceinline__ unsigned xb_ld(unsigned* p)              { return __hip_atomic_load(p, __ATOMIC_RELAXED, __HIP_MEMORY_SCOPE_AGENT); }
__device__ __forceinline__ unsigned xb_add(unsigned* p, unsigned v) { return __hip_atomic_fetch_add(p, v, __ATOMIC_RELAXED, __HIP_MEMORY_SCOPE_AGENT); }
__device__ __forceinline__ unsigned xb_xcc_id() { return (unsigned)__builtin_amdgcn_s_getreg((3 << 11) | 20) & 0xFu; }
#define XB_SPIN(cond, bar) do { unsigned _sp = 0; while (cond) { __builtin_amdgcn_s_sleep(1); \
    if ((++_sp & 255u) == 0u) { if (xb_ld(&(bar)[XB_TMO])) break; if (_sp > XB_SPIN_CAP) { atomicAdd(&(bar)[XB_TMO], 1u); break; } } } } while (0)

struct XcdBarrier {
    unsigned* bar; unsigned x;
    volatile LAS unsigned* st;
};

__device__ __forceinline__ XcdBarrier xcd_barrier_post(unsigned* bar, volatile LAS unsigned* st) {
    XcdBarrier b; b.bar = bar; b.x = xb_xcc_id(); b.st = st;
    if (threadIdx.x == 0) (void)xb_add(&bar[XB_XCNT(b.x)], 1u);
    return b;
}
__device__ __forceinline__ void xcd_barrier_complete(unsigned* bar, unsigned x, unsigned& nloc, unsigned& nx) {
    const unsigned G = gridDim.x * gridDim.y * gridDim.z;
    unsigned sum, cnt, mine, sp = 0u;
    for (;;) {
        sum = 0u; cnt = 0u; mine = 0u;
#pragma unroll
        for (unsigned j = 0; j < 16; ++j) { const unsigned c = xb_ld(&bar[XB_XCNT(j)]); sum += c; cnt += (c > 0u) ? 1u : 0u; mine = (j == x) ? c : mine; }
        if (sum == G) break;
        __builtin_amdgcn_s_sleep(1);
        if ((++sp & 255u) == 0u) { if (xb_ld(&bar[XB_TMO])) break; if (sp > XB_SPIN_CAP) { atomicAdd(&bar[XB_TMO], 1u); break; } }
    }
    nloc = mine > 0u ? mine : 1u; nx = cnt > 0u ? cnt : 1u;
}

__device__ __forceinline__ void xcd_barrier(const XcdBarrier& b) {
    asm volatile("s_waitcnt vmcnt(0)" ::: "memory");
    __syncthreads();
    if (threadIdx.x == 0) {
        unsigned* bar = b.bar;
        __builtin_amdgcn_s_waitcnt(0);
        unsigned nloc = b.st[0], nx = b.st[1];
        if (nloc == 0u) { xcd_barrier_complete(bar, b.x, nloc, nx); b.st[0] = nloc; b.st[1] = nx; }
        const unsigned old = xb_add(&bar[XB_XSUB(b.x)], 1u);
        const unsigned gen = old / nloc;
        if (old + 1u == (gen + 1u) * nloc) {
            __builtin_amdgcn_fence(__ATOMIC_RELEASE, "agent");
            asm volatile("s_waitcnt vmcnt(0)" ::: "memory");
            const unsigned og = xb_add(&bar[XB_TOP], 1u);
            const unsigned tg = og / nx;
            if (og + 1u == (tg + 1u) * nx) xb_add(&bar[XB_TOPGEN], 1u);
            else XB_SPIN(xb_ld(&bar[XB_TOPGEN]) == tg, bar);
            __builtin_amdgcn_fence(__ATOMIC_ACQUIRE, "agent");
            xb_add(&bar[XB_XGEN(b.x)], 1u);
            asm volatile("s_waitcnt vmcnt(0)" ::: "memory");
        } else {
            XB_SPIN(xb_ld(&bar[XB_XGEN(b.x)]) == gen, bar);
            __builtin_amdgcn_fence(__ATOMIC_ACQUIRE, "agent");
            asm volatile("s_waitcnt vmcnt(0)" ::: "memory");
        }
    }
    __syncthreads();
}

#ifndef PROBE_DW
#define PROBE_DW 0
#endif
struct Frame {
    char* lds;
    volatile LAS unsigned* MISC;
    unsigned* ctl;
    unsigned char* ws;
    int tid, lane, wave, G, bid;
    const float* const __attribute__((address_space(4)))* in;
    float* out;
};

__device__ __forceinline__ void transpose_item(const float* W, int K, int N, bf16* WT, int row_off, const float* kscale, float* scr, int item, int lane) {
    const int nblk = N / 32, kb = item / nblk, nb = item % nblk, k0 = 64 * kb, n0 = 32 * nb;
#pragma unroll 8
    for (int i = 0; i < 32; ++i) { const int kk = 2 * i + (lane >> 5); float v = W[(size_t)(k0 + kk) * N + n0 + (lane & 31)]; if (kscale) v *= kscale[k0 + kk]; scr[kk * 33 + (lane & 31)] = v; }
    LDS_WAIT(); asm volatile("" ::: "memory");
    const int c = lane & 7;
#pragma unroll
    for (int j = 0; j < 4; ++j) { const int n = (lane >> 3) + 8 * j; const float* s = scr + (8 * c) * 33 + n;
        v4u o; o.x = pk2(s[0 * 33], s[1 * 33]); o.y = pk2(s[2 * 33], s[3 * 33]); o.z = pk2(s[4 * 33], s[5 * 33]); o.w = pk2(s[6 * 33], s[7 * 33]);
        *(v4u*)(WT + (size_t)(row_off + n0 + n) * K + k0 + 8 * c) = o; }
    LDS_WAIT(); asm volatile("" ::: "memory");
}

__device__ __forceinline__ void small_conversions(Frame& F, const int gt, const int NGT) {
    { bf16* wr = (bf16*)(F.ws + WS_WRT);
      for (int i = gt; i < 48 * DM; i += NGT) { const int n = i / DM, k = i - n * DM; float v = 0.f; if (n < 4) v = F.in[25][k * 4 + n]; else if (n < 36) v = F.in[27][k * 32 + (n - 4)]; wr[i] = (bf16)f2bf(v); } }
    { bf16* lw = (bf16*)(F.ws + WS_LORA);
      for (int i = gt; i < 2 * RW * 64; i += NGT) { const int d = i / (RW * 64), r = i - d * RW * 64, ch = r >> 6, k = r & 63;
          lw[i] = (bf16)f2bf(F.in[PROBE_DW == 5 ? 17 : 15][(size_t)(d * 64 + k) * RW + ch]); lw[2 * RW * 64 + i] = (bf16)f2bf(F.in[17][(size_t)(d * 64 + k) * RW + ch]); }
      for (int i = gt; i < RW * 160; i += NGT) { const int ch = i / 160, k = i - ch * 160; lw[4 * RW * 64 + i] = (bf16)f2bf(F.in[18][(size_t)k * RW + ch]); } }
}

__device__ __forceinline__ void phase0(Frame& F) {
    float* st = (float*)F.lds;
    for (int i = F.tid; i < 3 * DM; i += NTHR) { const int j = i / DM, k = i - j * DM; const float v = j < 2 ? F.in[1][j * DM + k] : F.in[3][k]; st[i] = v * sigmoidf_(v); }
    __syncthreads();
    const int gw = F.bid * NWAVES + F.wave, NGW = F.G * NWAVES;
    const float* wmod = F.in[4]; float* modp = (float*)(F.ws + WS_MODP);
    for (int it = gw; it < 768; it += NGW) {
        const int cc = it % 48, ks = it / 48, n0 = cc * 256 + F.lane * 4;
        pg8::f32x4 a0 = {0.f, 0.f, 0.f, 0.f}, a1 = a0, a2 = a0;
        const float* wp = wmod + (size_t)(ks * 128) * (6 * DM) + n0;
#pragma unroll 8
        for (int k = 0; k < 128; ++k) { const pg8::f32x4 w = *(const pg8::f32x4*)(wp + (size_t)k * (6 * DM)); const int kk = ks * 128 + k;
            a0 += w * st[kk]; a1 += w * st[DM + kk]; a2 += w * st[2 * DM + kk]; }
        *(pg8::f32x4*)(modp + (size_t)(ks * 3 + 0) * (6 * DM) + n0) = a0; *(pg8::f32x4*)(modp + (size_t)(ks * 3 + 1) * (6 * DM) + n0) = a1; *(pg8::f32x4*)(modp + (size_t)(ks * 3 + 2) * (6 * DM) + n0) = a2;
    }
    __syncthreads();
    float* scr = (float*)(F.lds + F.wave * 8448);
    constexpr int I_IN = (DM / 64) * (NIN / 32), I_UQ = (512 / 64) * (1536 / 32), I_UKV = (256 / 64) * (2048 / 32), I_OUT = (DM / 64) * (DM / 32);
    for (int it = gw; it < I_IN + I_UQ + I_UKV + I_OUT; it += NGW) {
        int r = it;
        if (r < I_IN) { transpose_item(F.in[8], DM, NIN, (bf16*)(F.ws + WS_WTIN), 0, nullptr, scr, r, F.lane); continue; } r -= I_IN;
        if (r < I_UQ) { transpose_item(F.in[11], 512, 1536, (bf16*)(F.ws + WS_WTUQ), 0, F.in[10], scr, r, F.lane); continue; } r -= I_UQ;
        if (r < I_UKV) { transpose_item(F.in[13], 256, 2048, (bf16*)(F.ws + WS_WTUKV), 0, F.in[12], scr, r, F.lane); continue; } r -= I_UKV;
        transpose_item(F.in[24], DM, DM, (bf16*)(F.ws + WS_WTOUT), 0, nullptr, scr, r, F.lane);
    }
    const int gt = F.bid * NTHR + F.tid, NGT = F.G * NTHR;
    { v4u* z = (v4u*)((bf16*)(F.ws + WS_WTIN) + (size_t)NIN * DM); const v4u zero = {0u, 0u, 0u, 0u};
      for (int i = gt; i < (NINP - NIN) * DM / 8; i += NGT) z[i] = zero; }
#ifndef PROBE_SMALL_IN_P1
    small_conversions(F, gt, NGT);
#endif
}

__device__ __forceinline__ void phase1(Frame& F) {
    float* sft = (float*)F.lds; float* scl = sft + 3 * DM;
    const float* modp = (const float*)(F.ws + WS_MODP); const float* bmod = F.in[5]; const float* gat = F.in[6];
    for (int i = F.tid; i < 3 * 2 * DM; i += NTHR) { const int j = i / (2 * DM), n = i - j * 2 * DM; float s = bmod[n];
        for (int ks = 0; ks < 16; ++ks) s += modp[(size_t)(ks * 3 + j) * (6 * DM) + n];
        if (n < DM) sft[j * DM + n] = s; else scl[j * DM + n - DM] = gat[n - DM] * (1.0f + s); }
    if (F.bid < 144 && F.tid < 256) { const int j = F.bid / 48, n = (F.bid % 48) * 256 + F.tid; float s = bmod[n];
        for (int ks = 0; ks < 16; ++ks) s += modp[(size_t)(ks * 3 + j) * (6 * DM) + n];
        ((float*)(F.ws + WS_MODF))[j * 6 * DM + n] = s; }
    __syncthreads();
    const int gw = F.bid * NWAVES + F.wave, NGW = F.G * NWAVES;
    bf16* H = (bf16*)(F.ws + WS_H);
    for (int m = gw; m < MALL; m += NGW) {
        const int j = m < T ? 0 : (m < MROWS ? 1 : 2);
        const float* xr = m < MROWS ? F.in[0] + (size_t)m * DM : F.in[2] + (size_t)(m - MROWS) * DM;
        pg8::f32x4 v[8]; float s = 0.f;
#pragma unroll
        for (int q = 0; q < 8; ++q) { v[q] = *(const pg8::f32x4*)(xr + q * 256 + F.lane * 4); s += pg8::dot4(v[q]); }
        const float rstd = __builtin_amdgcn_rsqf(wave_sum(s) * (1.0f / DM) + 1e-6f);
#pragma unroll
        for (int q = 0; q < 8; ++q) { const int c = q * 256 + F.lane * 4; const pg8::f32x4 sc = *(const pg8::f32x4*)(scl + j * DM + c), sh = *(const pg8::f32x4*)(sft + j * DM + c);
            const pg8::f32x4 o = v[q] * rstd * sc + sh; v2u w; w.x = pk2(o[0], o[1]); w.y = pk2(o[2], o[3]); *(v2u*)(H + (size_t)m * DM + c) = w; }
    }
#ifdef PROBE_SMALL_IN_P1
    small_conversions(F, F.bid * NTHR + F.tid, F.G * NTHR);
#endif
}

__device__ __forceinline__ void rwkv_prep_tile(Frame& F, int tile) {
    const bf16* P = (const bf16*)(F.ws + WS_P); const float* mu = F.in[9];
    const int m0 = tile * 64;
    const bool isctx = m0 >= MROWS; const int seqlen = isctx ? TC : T;
    const int b = isctx ? (m0 - MROWS) >> 8 : m0 >> 13, t0 = isctx ? (m0 - MROWS) & 255 : m0 & (T - 1), pos0 = isctx ? T + t0 : t0;
    bf16* XW = (bf16*)F.lds; bf16* XA = XW + 64 * 72; bf16* XGt = XA + 64 * 72; float* KS = (float*)(XGt + 64 * 168); float* KKS = KS + 64 * 64;
    for (int i = F.tid; i < 64 * 44; i += NTHR) {
        const int tk = i / 44, gq = i - tk * 44; const int t = t0 + tk; const size_t row = (size_t)(m0 + tk);
        if (gq < 36) {
            const int col = C_WL + gq * 8;
            float c[8], p[8], n[8], o[8];
            unpack8(*(const v4u*)(P + row * NINP + col), c);
            if (t > 0) unpack8(*(const v4u*)(P + (row - 1) * NINP + col), p); else { for (int e = 0; e < 8; ++e) p[e] = 0.f; }
            if (t < seqlen - 1) unpack8(*(const v4u*)(P + (row + 1) * NINP + col), n); else { for (int e = 0; e < 8; ++e) n[e] = 0.f; }
#pragma unroll
            for (int e = 0; e < 8; ++e) { const int rc = col - C_R + e; const float s = c[e] + mu[rc] * (p[e] - c[e]) + mu[3360 + rc] * (n[e] - c[e]);
                o[e] = gq < 8 ? 1.0f - 2.0f * __builtin_amdgcn_rcpf(1.0f + __expf(2.0f * s)) : (gq < 16 ? s : sigmoidf_(s)); }
            bf16* dst = gq < 8 ? XW + tk * 72 + gq * 8 : (gq < 16 ? XA + tk * 72 + (gq - 8) * 8 : XGt + tk * 168 + (gq - 16) * 8);
            *(v4u*)dst = pack8f(o);
        } else {
            const int g8 = gq - 36, half = g8 >> 2, j0 = (g8 & 3) * 8;
            float x[8], y[8], o[8];
            unpack8(*(const v4u*)(P + row * NINP + C_KR + half * 32 + j0), x);
            unpack8(*(const v4u*)(P + row * NINP + C_KR + half * 32 + (j0 ^ 16)), y);
            if (isctx) { for (int e = 0; e < 8; ++e) o[e] = x[e]; }
            else { const float pos = half == 0 ? (float)(t >> 6) : (float)(t & 63);
#pragma unroll
                for (int e = 0; e < 8; ++e) { const int jf = (j0 & 15) + e; float r = pos * (__builtin_amdgcn_exp2f(-(float)jf * 0.83048202372184059f) * 0.15915494309189535f); r = r - __builtin_floorf(r);
                    const float sn = __builtin_amdgcn_sinf(r), cs = __builtin_amdgcn_cosf(r);
                    o[e] = j0 < 16 ? x[e] * cs - y[e] * sn : y[e] * sn + x[e] * cs; } }
            *(v4u*)((bf16*)(F.ws + WS_KR) + ((size_t)b * NKEY + pos0 + tk) * 64 + half * 32 + j0) = pack8f(o);
        }
    }
    __syncthreads();
    const float* w0 = F.in[14]; const float* a0 = F.in[16]; const float* keyk = F.in[19]; const float* keya = F.in[20];
    const bf16* LW = (const bf16*)(F.ws + WS_LORA); const bf16* LA = LW + 2 * RW * 64; const bf16* LG = LW + 4 * RW * 64;
    const int fr = F.lane & 15, fq = F.lane >> 4;
    for (int h = 0; h < RH; ++h) {
        const size_t hb = ((size_t)(b * RH + h) * NKEY + pos0) * RN;
        {
            const int tk = F.tid >> 3, c8 = (F.tid & 7) * 8; const int t = t0 + tk; const size_t row = (size_t)(m0 + tk);
            float sh[3][8];
#pragma unroll
            for (int a = 0; a < 3; ++a) { const int col = (a == 0 ? C_R : (a == 1 ? C_K : C_V)) + h * 64 + c8; float c[8], p[8], n[8];
                unpack8(*(const v4u*)(P + row * NINP + col), c);
                if (t > 0) unpack8(*(const v4u*)(P + (row - 1) * NINP + col), p); else { for (int e = 0; e < 8; ++e) p[e] = 0.f; }
                if (t < seqlen - 1) unpack8(*(const v4u*)(P + (row + 1) * NINP + col), n); else { for (int e = 0; e < 8; ++e) n[e] = 0.f; }
#pragma unroll
                for (int e = 0; e < 8; ++e) { const int rc = col - C_R + e; sh[a][e] = c[e] + mu[rc] * (p[e] - c[e]) + mu[3360 + rc] * (n[e] - c[e]); } }
            *(v4u*)((bf16*)(F.ws + WS_SCAN + 0 * SCAN_ARR) + hb + tk * 64 + c8) = pack8f(sh[0]);
            *(v4u*)((bf16*)(F.ws + WS_SCAN + 1 * SCAN_ARR) + hb + tk * 64 + c8) = pack8f(sh[2]);
            float kk[8], ss = 0.f;
#pragma unroll
            for (int e = 0; e < 8; ++e) { kk[e] = sh[1][e] * keyk[h * 64 + c8 + e]; ss += kk[e] * kk[e]; }
            ss += __shfl_xor(ss, 1); ss += __shfl_xor(ss, 2); ss += __shfl_xor(ss, 4);
            const float rn = __builtin_amdgcn_rsqf(ss + 1e-12f);
#pragma unroll
            for (int e = 0; e < 8; ++e) { kk[e] *= rn; KS[tk * 64 + c8 + e] = sh[1][e]; KKS[tk * 64 + c8 + e] = kk[e]; }
            *(v4u*)((bf16*)(F.ws + WS_SCAN + 2 * SCAN_ARR) + hb + tk * 64 + c8) = pack8f(kk);
        }
        __syncthreads();
        {
            const int tb = F.wave & 3, cbp = F.wave >> 2;
            pg8::bf16x8 xw[2], xa[2], xg[5];
#pragma unroll
            for (int kb = 0; kb < 2; ++kb) { xw[kb] = *(const pg8::bf16x8*)(XW + (tb * 16 + fr) * 72 + kb * 32 + fq * 8); xa[kb] = *(const pg8::bf16x8*)(XA + (tb * 16 + fr) * 72 + kb * 32 + fq * 8); }
#pragma unroll
            for (int kb = 0; kb < 5; ++kb) xg[kb] = *(const pg8::bf16x8*)(XGt + (tb * 16 + fr) * 168 + kb * 32 + fq * 8);
#pragma unroll
            for (int cbi = 0; cbi < 2; ++cbi) {
                const int cb = cbp * 2 + cbi, chl = cb * 16 + fr, chg = h * 64 + chl;
                pg8::f32x4 dw[2], da[2], dg = {0.f, 0.f, 0.f, 0.f};
#pragma unroll
                for (int d = 0; d < 2; ++d) { dw[d] = (pg8::f32x4){0.f, 0.f, 0.f, 0.f}; da[d] = dw[d];
#pragma unroll
                    for (int kb = 0; kb < 2; ++kb) {
                        const pg8::bf16x8 fw = *(const pg8::bf16x8*)(LW + ((size_t)(d * RW + chg)) * 64 + kb * 32 + fq * 8);
                        const pg8::bf16x8 fa = *(const pg8::bf16x8*)(LA + ((size_t)(d * RW + chg)) * 64 + kb * 32 + fq * 8);
#if PROBE_DW == 3
                        dw[d] = __builtin_amdgcn_mfma_f32_16x16x32_bf16(fw, xa[kb], dw[d], 0, 0, 0);
#elif PROBE_DW == 4
                        dw[d] = __builtin_amdgcn_mfma_f32_16x16x32_bf16(fa, xw[kb], dw[d], 0, 0, 0);
#else
                        dw[d] = __builtin_amdgcn_mfma_f32_16x16x32_bf16(fw, xw[kb], dw[d], 0, 0, 0);
#endif
                        da[d] = __builtin_amdgcn_mfma_f32_16x16x32_bf16(fa, xa[kb], da[d], 0, 0, 0); } }
#pragma unroll
                for (int kb = 0; kb < 5; ++kb) { const pg8::bf16x8 fg = *(const pg8::bf16x8*)(LG + (size_t)chg * 160 + kb * 32 + fq * 8); dg = __builtin_amdgcn_mfma_f32_16x16x32_bf16(fg, xg[kb], dg, 0, 0, 0); }
                asm volatile("s_nop 15\n\ts_nop 15" : "+v"(dw[0]), "+v"(dw[1]), "+v"(da[0]), "+v"(da[1]), "+v"(dg));
                const int tk = tb * 16 + fr, c4 = cb * 16 + 4 * fq, cg = h * 64 + c4;
                const pg8::f32x4 ks = *(const pg8::f32x4*)(KS + tk * 64 + c4), kk = *(const pg8::f32x4*)(KKS + tk * 64 + c4);
                const pg8::f32x4 ka = *(const pg8::f32x4*)(keya + cg);
#pragma unroll
                for (int d = 0; d < 2; ++d) { const pg8::f32x4 w0v = *(const pg8::f32x4*)(w0 + d * RW + cg), a0v = *(const pg8::f32x4*)(a0 + d * RW + cg);
                    float dec[4], kd[4], bd[4];
#pragma unroll
                                        for (int j = 0; j < 4; ++j) { const float wr = PROBE_DW == 1 ? w0v[j] : (PROBE_DW == 2 ? dw[d][j] : w0v[j] + dw[d][j]); dec[j] = __expf(-0.60653065971263342f * sigmoidf_(wr));
                        const float eta = sigmoidf_(a0v[j] + da[d][j]); kd[j] = ks[j] * (1.0f + (eta - 1.0f) * ka[j]); bd[j] = kk[j] * eta; }
                    v2u w; w.x = pk2(dec[0], dec[1]); w.y = pk2(dec[2], dec[3]); *(v2u*)((bf16*)(F.ws + WS_SCAN + (3 + d) * SCAN_ARR) + hb + tk * 64 + c4) = w;
                    w.x = pk2(kd[0], kd[1]); w.y = pk2(kd[2], kd[3]); *(v2u*)((bf16*)(F.ws + WS_SCAN + (5 + d) * SCAN_ARR) + hb + tk * 64 + c4) = w;
                    w.x = pk2(bd[0], bd[1]); w.y = pk2(bd[2], bd[3]); *(v2u*)((bf16*)(F.ws + WS_SCAN + (7 + d) * SCAN_ARR) + hb + tk * 64 + c4) = w; }
                if (!isctx) { v2u w; w.x = pk2(dg[0], dg[1]); w.y = pk2(dg[2], dg[3]); *(v2u*)((bf16*)(F.ws + WS_G) + ((size_t)(b * RH + h) * T + t0 + tk) * RN + c4) = w; }
            }
        }
        __syncthreads();
    }
}

template <int CTRL> __device__ __forceinline__ float dpp_add(float x) { return x + __builtin_bit_cast(float, __builtin_amdgcn_update_dpp(0, __builtin_bit_cast(int, x), CTRL, 0xf, 0xf, false)); }
__device__ __forceinline__ float red16(float x) { x = dpp_add<0xB1>(x); x = dpp_add<0x4E>(x); x = dpp_add<0x141>(x); x = dpp_add<0x140>(x); return x; }

__device__ __forceinline__ void scan_unit(Frame& F, int sc) {
    const int dir = sc & 1, bh = sc >> 1; const bool fwd = dir == 0;
    const size_t hb = (size_t)bh * NKEY * RN;
    const bf16* src0 = (const bf16*)(F.ws + WS_SCAN) + hb;
#ifdef PROBE_YWS
    float* Yg = (float*)(F.ws + WS_W13T) + (size_t)dir * MROWS * RW + (size_t)bh * T * RN;
#else
    float* Yg = F.out + (size_t)dir * MROWS * RW + (size_t)bh * T * RN;
#endif
    float* buf = (float*)F.lds;
    float* ybuf = buf + 2 * 6 * 2048;
    constexpr int NCH = (TC + T) / 32;
    auto chunk_pos = [&](int c) { if (c < 8) { const int cn = fwd ? c : 7 - c; return T + 32 * cn; } const int cl = c - 8, cn = fwd ? cl : 255 - cl; return 32 * cn; };
    auto load_chunk = [&](int c, int nthreads, int t0) {
        const int pos = chunk_pos(c); float* dst = buf + (c & 1) * 6 * 2048;
        for (int i = F.tid - t0; i < 6 * 256; i += nthreads) { const int a = i >> 8, e8 = (i & 255) * 8; float f[8]; const int ai = a < 3 ? a : 3 + 2 * (a - 3) + dir; unpack8(*(const v4u*)(src0 + (size_t)ai * (SCAN_ARR / 2) + (size_t)pos * RN + e8), f);
            *(pg8::f32x4*)(dst + a * 2048 + e8) = (pg8::f32x4){f[0], f[1], f[2], f[3]}; *(pg8::f32x4*)(dst + a * 2048 + e8 + 4) = (pg8::f32x4){f[4], f[5], f[6], f[7]}; }
    };
#ifdef PROBE_NOCTX
    constexpr int C0 = 8;
#else
    constexpr int C0 = 0;
#endif
    load_chunk(C0, NTHR, 0);
    __syncthreads();
    const int vg = F.lane >> 4, kl = F.lane & 15, vrow = 16 * F.wave + 4 * vg;
    float S[4][4];
#pragma unroll
    for (int i = 0; i < 4; ++i)
#pragma unroll
        for (int j = 0; j < 4; ++j) S[i][j] = 0.f;
    for (int c = C0; c < NCH; ++c) {
        const bool latent = c >= 8;
        if (F.wave >= 4) { if (c + 1 < NCH) load_chunk(c + 1, 256, 256); }
        else {
            const float* cb = buf + (c & 1) * 6 * 2048;
            for (int s = 0; s < 32; ++s) {
                const int sn = fwd ? s : 31 - s;
                const pg8::f32x4 rv = *(const pg8::f32x4*)(cb + 0 * 2048 + sn * 64 + 4 * kl), vv = *(const pg8::f32x4*)(cb + 1 * 2048 + sn * 64 + vrow);
                const pg8::f32x4 kk = *(const pg8::f32x4*)(cb + 2 * 2048 + sn * 64 + 4 * kl), w = *(const pg8::f32x4*)(cb + 3 * 2048 + sn * 64 + 4 * kl);
                const pg8::f32x4 kv = *(const pg8::f32x4*)(cb + 4 * 2048 + sn * 64 + 4 * kl), bt = *(const pg8::f32x4*)(cb + 5 * 2048 + sn * 64 + 4 * kl);
                float sa[4];
#pragma unroll
                for (int i = 0; i < 4; ++i) sa[i] = -red16((S[i][0] * kk[0] + S[i][1] * kk[1]) + (S[i][2] * kk[2] + S[i][3] * kk[3]));
#pragma unroll
                for (int i = 0; i < 4; ++i)
#pragma unroll
                    for (int j = 0; j < 4; ++j) S[i][j] = S[i][j] * w[j] + sa[i] * bt[j] + vv[i] * kv[j];
                if (latent) {
                    float y[4];
#pragma unroll
                    for (int i = 0; i < 4; ++i) y[i] = red16((S[i][0] * rv[0] + S[i][1] * rv[1]) + (S[i][2] * rv[2] + S[i][3] * rv[3]));
                    if (kl == 0) *(pg8::f32x4*)(ybuf + sn * 64 + vrow) = (pg8::f32x4){y[0], y[1], y[2], y[3]};
                }
            }
        }
        __syncthreads();
        if (latent) { const int pos = chunk_pos(c); *(pg8::f32x4*)(Yg + (size_t)pos * RN + F.tid * 4) = *(const pg8::f32x4*)(ybuf + F.tid * 4); }
        __syncthreads();
    }
}
__device__ __forceinline__ void phase_scan(Frame& F) {
    if (F.bid < 64) { scan_unit(F, F.bid); return; }
#ifdef PROBE_YWS
    return;
#endif
    float* scr = (float*)(F.lds + F.wave * 8448);
    const int gw = (F.bid - 64) * NWAVES + F.wave, NGW = (F.G - 64) * NWAVES;
    constexpr int I13 = (DM / 64) * (DEXP / 32), I2 = (DEXP / 64) * (DM / 32);
    for (int it = gw; it < NEXP * (2 * I13 + I2); it += NGW) {
        const int e = it / (2 * I13 + I2); int r = it - e * (2 * I13 + I2);
        if (r < 2 * I13) { const int is3 = r >= I13; if (is3) r -= I13; const int n0 = 32 * (r % (DEXP / 32));
            transpose_item(F.in[is3 ? 30 : 29] + (size_t)e * DM * DEXP, DM, DEXP, (bf16*)(F.ws + WS_W13T), e * 1024 + (n0 / 128) * 128 + 128 * is3, nullptr, scr, r, F.lane); }
        else transpose_item(F.in[31] + (size_t)e * DEXP * DM, DEXP, DM, (bf16*)(F.ws + WS_W2T), e * DM, nullptr, scr, r - 2 * I13, F.lane);
    }
}

__device__ __forceinline__ void phase_readout(Frame& F) {
    const float* rk = F.in[21]; const float* lg = F.in[22]; const float* lb = F.in[23];
    bf16* MIX = (bf16*)(F.ws + WS_MIX);
    const int tk = F.tid >> 3, c8 = (F.tid & 7) * 8;
    for (int it = F.bid; it < NB * RH * (T / 64); it += F.G) {
        const int bh = it >> 7, tt = (it & 127) * 64 + tk, b = bh >> 4, h = bh & 15;
        const size_t ys = ((size_t)bh * T + tt) * RN + c8, ss = ((size_t)bh * NKEY + tt) * RN + c8;
#ifdef PROBE_YWS
        const float* Ysrc = (const float*)(F.ws + WS_W13T);
#else
        const float* Ysrc = F.out;
#endif
        const pg8::f32x4 f0 = *(const pg8::f32x4*)(Ysrc + ys), f1 = *(const pg8::f32x4*)(Ysrc + ys + 4);
        const pg8::f32x4 b0 = *(const pg8::f32x4*)(Ysrc + (size_t)MROWS * RW + ys), b1 = *(const pg8::f32x4*)(Ysrc + (size_t)MROWS * RW + ys + 4);
        float y[8] = {f0[0] + b0[0], f0[1] + b0[1], f0[2] + b0[2], f0[3] + b0[3], f1[0] + b1[0], f1[1] + b1[1], f1[2] + b1[2], f1[3] + b1[3]};
#ifdef PROBE_NOSCAN
        for (int e = 0; e < 8; ++e) y[e] = 0.f;
#endif
#ifdef PROBE_SCANIN
        { float t0[8], t1[8], t2[8], t3[8], t4[8];
          unpack8(*(const v4u*)((const bf16*)(F.ws + WS_SCAN + 2 * SCAN_ARR) + ss), t0); unpack8(*(const v4u*)((const bf16*)(F.ws + WS_SCAN + 3 * SCAN_ARR) + ss), t1);
          unpack8(*(const v4u*)((const bf16*)(F.ws + WS_SCAN + 4 * SCAN_ARR) + ss), t2); unpack8(*(const v4u*)((const bf16*)(F.ws + WS_SCAN + 7 * SCAN_ARR) + ss), t3);
          unpack8(*(const v4u*)((const bf16*)(F.ws + WS_SCAN + 8 * SCAN_ARR) + ss), t4);
#ifndef PROBE_SEL
#define PROBE_SEL 31
#endif
          for (int e = 0; e < 8; ++e) y[e] = ((PROBE_SEL & 1) ? t0[e] : 0.f) + ((PROBE_SEL & 2) ? t1[e] * (1.0f + e) : 0.f) + ((PROBE_SEL & 4) ? t2[e] * (2.0f - e) : 0.f) + ((PROBE_SEL & 8) ? t3[e] * 3.0f : 0.f) + ((PROBE_SEL & 16) ? t4[e] * (e - 3.5f) : 0.f); }
#endif
        float r[8], v[8], k0[8], k1[8], g[8];
        unpack8(*(const v4u*)((const bf16*)(F.ws + WS_SCAN + 0 * SCAN_ARR) + ss), r); unpack8(*(const v4u*)((const bf16*)(F.ws + WS_SCAN + 1 * SCAN_ARR) + ss), v);
        unpack8(*(const v4u*)((const bf16*)(F.ws + WS_SCAN + 5 * SCAN_ARR) + ss), k0); unpack8(*(const v4u*)((const bf16*)(F.ws + WS_SCAN + 6 * SCAN_ARR) + ss), k1);
        unpack8(*(const v4u*)((const bf16*)(F.ws + WS_G) + ys), g);
        float s = 0.f, bon = 0.f;
#pragma unroll
        for (int e = 0; e < 8; ++e) { s += y[e]; bon += r[e] * (k0[e] + k1[e]) * rk[h * 64 + c8 + e]; }
        s += __shfl_xor(s, 1); s += __shfl_xor(s, 2); s += __shfl_xor(s, 4); bon += __shfl_xor(bon, 1); bon += __shfl_xor(bon, 2); bon += __shfl_xor(bon, 4);
        const float mean = s * (1.0f / 64.0f); float q = 0.f;
#pragma unroll
        for (int e = 0; e < 8; ++e) { y[e] -= mean; q += y[e] * y[e]; }
        q += __shfl_xor(q, 1); q += __shfl_xor(q, 2); q += __shfl_xor(q, 4);
        const float rstd = __builtin_amdgcn_rsqf(q * (1.0f / 64.0f) + 64e-5f);
        float o[8];
#pragma unroll
        for (int e = 0; e < 8; ++e) { const int ch = h * 64 + c8 + e; o[e] = (y[e] * rstd * lg[ch] + lb[ch] + bon * v[e]) * g[e]; }
        *(v4u*)(MIX + ((size_t)b * T + tt) * DM + RW + h * 64 + c8) = pack8f(o);
    }
}

__device__ __forceinline__ void phase_route(Frame& F) {
    const float* X1 = F.out; const float* modf = (const float*)(F.ws + WS_MODF); const float* gf = F.in[7];
    const bf16* WR = (const bf16*)(F.ws + WS_WRT); bf16* H2 = (bf16*)(F.ws + WS_H2);
    int* rte = (int*)(F.ws + WS_ROUTE + RT_E); int* rtp = (int*)(F.ws + WS_ROUTE + RT_POS); float* rtg = (float*)(F.ws + WS_ROUTE + RT_GATE);
    float* lg = (float*)(F.lds) + F.wave * (16 * 48);
    const int fr = F.lane & 15, fq = F.lane >> 4;
    const int gw = F.bid * NWAVES + F.wave, NGW = F.G * NWAVES;
    for (int it = gw; it < MROWS / 16; it += NGW) {
        const int row = it * 16 + fr, b = row >> 13; const float* xr = X1 + (size_t)row * DM + fq * 8;
        float ss = 0.f;
#pragma unroll 8
        for (int k = 0; k < 64; ++k) { const pg8::f32x4 a = *(const pg8::f32x4*)(xr + k * 32), c = *(const pg8::f32x4*)(xr + k * 32 + 4); ss += pg8::dot4(a) + pg8::dot4(c); }
        ss += __shfl_xor(ss, 16); ss += __shfl_xor(ss, 32);
        const float rstd = __builtin_amdgcn_rsqf(ss * (1.0f / DM) + 1e-6f);
        const float* sh2 = modf + (size_t)b * 6 * DM + 3 * DM + fq * 8; const float* sc2 = modf + (size_t)b * 6 * DM + 4 * DM + fq * 8;
        pg8::f32x4 acc[3] = {{0.f, 0.f, 0.f, 0.f}, {0.f, 0.f, 0.f, 0.f}, {0.f, 0.f, 0.f, 0.f}};
#pragma unroll 4
        for (int k = 0; k < 64; ++k) {
            const pg8::f32x4 a = *(const pg8::f32x4*)(xr + k * 32), c = *(const pg8::f32x4*)(xr + k * 32 + 4);
            const pg8::f32x4 g0 = *(const pg8::f32x4*)(gf + fq * 8 + k * 32), g1 = *(const pg8::f32x4*)(gf + fq * 8 + k * 32 + 4);
            const pg8::f32x4 s0 = *(const pg8::f32x4*)(sc2 + k * 32), s1 = *(const pg8::f32x4*)(sc2 + k * 32 + 4), h0 = *(const pg8::f32x4*)(sh2 + k * 32), h1 = *(const pg8::f32x4*)(sh2 + k * 32 + 4);
            const pg8::f32x4 o0 = a * rstd * g0 * (s0 + 1.0f) + h0, o1 = c * rstd * g1 * (s1 + 1.0f) + h1;
            const pg8::u32x4 w = pg8::pack8(o0, o1);
            *(pg8::u32x4*)(H2 + (size_t)row * DM + fq * 8 + k * 32) = w;
            const pg8::bf16x8 xb = __builtin_bit_cast(pg8::bf16x8, w);
#pragma unroll
            for (int nb = 0; nb < 3; ++nb) { const pg8::bf16x8 wf = *(const pg8::bf16x8*)(WR + (size_t)(nb * 16 + fr) * DM + k * 32 + fq * 8); acc[nb] = __builtin_amdgcn_mfma_f32_16x16x32_bf16(wf, xb, acc[nb], 0, 0, 0); }
        }
        asm volatile("s_nop 15\n\ts_nop 15" : "+v"(acc[0]), "+v"(acc[1]), "+v"(acc[2]));
#pragma unroll
        for (int nb = 0; nb < 3; ++nb)
#pragma unroll
            for (int j = 0; j < 4; ++j) lg[fr * 48 + nb * 16 + 4 * fq + j] = acc[nb][j];
        LDS_WAIT(); asm volatile("" ::: "memory");
        if (F.lane < 16) {
            const float* l = lg + F.lane * 48; const float* bg = F.in[26]; const float* be = F.in[28];
            int g = 0; float gm = l[0] + bg[0]; float gl[4]; gl[0] = gm;
#pragma unroll
            for (int i = 1; i < 4; ++i) { gl[i] = l[i] + bg[i]; if (gl[i] > gm) { gm = gl[i]; g = i; } }
            float gs = 0.f;
#pragma unroll
            for (int i = 0; i < 4; ++i) gs += __expf(gl[i] - gm);
            const float gval = 1.0f / gs;
            float w8[8]; int i1 = 0; float m1 = -3.0e38f;
#pragma unroll
            for (int i = 0; i < 8; ++i) { w8[i] = l[4 + 8 * g + i] + be[8 * g + i]; if (w8[i] > m1) { m1 = w8[i]; i1 = i; } }
            int i2 = 0; float m2 = -3.0e38f;
#pragma unroll
            for (int i = 0; i < 8; ++i) { if (i != i1 && w8[i] > m2) { m2 = w8[i]; i2 = i; } }
            const float e2 = __expf(m2 - m1), inv = 1.0f / (1.0f + e2);
            const int ea = 8 * g + i1, eb = 8 * g + i2; const int t = it * 16 + F.lane;
            const int pa = (int)atomicAdd(F.ctl + CW_CNT + ea, 1u), pb = (int)atomicAdd(F.ctl + CW_CNT + eb, 1u);
            rte[2 * t] = ea; rte[2 * t + 1] = eb; rtp[2 * t] = pa; rtp[2 * t + 1] = pb; rtg[2 * t] = gval * inv; rtg[2 * t + 1] = gval * e2 * inv;
        }
        LDS_WAIT(); asm volatile("" ::: "memory");
    }
}

__device__ __forceinline__ void build_tiles(Frame& F) {
    int* tab = (int*)(F.lds + EXTRA_OFF);
    if (F.tid == 0) { int tb = 0;
        for (int e = 0; e < NEXP; ++e) { const int c = (int)__hip_atomic_load(F.ctl + CW_CNT + e, __ATOMIC_RELAXED, __HIP_MEMORY_SCOPE_AGENT); const int nt = (c + 255) >> 8; tab[e] = tb * 256;
            for (int i = 0; i < nt && tb + i < MAXTILES; ++i) tab[64 + tb + i] = e; tb += nt; }
        tab[32] = tb < MAXTILES ? tb : MAXTILES; }
    __syncthreads();
}
__device__ __forceinline__ void phase_gather(Frame& F) {
    build_tiles(F);
    const int* tab = (const int*)(F.lds + EXTRA_OFF);
    const int* rte = (const int*)(F.ws + WS_ROUTE + RT_E); const int* rtp = (const int*)(F.ws + WS_ROUTE + RT_POS); const float* rtg = (const float*)(F.ws + WS_ROUTE + RT_GATE);
    int* rtr = (int*)(F.ws + WS_ROUTE + RT_ROW); float* rgate = (float*)(F.ws + WS_ROUTE + RT_RGATE);
    const bf16* H2 = (const bf16*)(F.ws + WS_H2); bf16* XG = (bf16*)(F.ws + WS_XG);
    const int gw = F.bid * NWAVES + F.wave, NGW = F.G * NWAVES;
    for (int p = gw; p < 2 * MROWS; p += NGW) {
        const int t = p >> 1; const int row = tab[rte[p]] + rtp[p];
        const v4u* s = (const v4u*)(H2 + (size_t)t * DM) + F.lane; v4u* d = (v4u*)(XG + (size_t)row * DM) + F.lane;
#pragma unroll
        for (int q = 0; q < 4; ++q) d[64 * q] = s[64 * q];
        if (F.lane == 0) { rtr[p] = row; rgate[row] = rtg[p]; }
    }
}
__device__ __forceinline__ void phase_final(Frame& F) {
    const float* modf = (const float*)(F.ws + WS_MODF); const float* fg = F.in[32]; const bf16* Y = (const bf16*)(F.ws + WS_Y); const int* rtr = (const int*)(F.ws + WS_ROUTE + RT_ROW);
    const int gw = F.bid * NWAVES + F.wave, NGW = F.G * NWAVES;
    for (int m = gw; m < MROWS; m += NGW) {
#ifdef PROBE_NOMOE
        const int b = m >> 13, ra = 0, rb = 0; const float* g2 = modf + (size_t)b * 6 * DM + 5 * DM;
#else
        const int b = m >> 13, ra = rtr[2 * m], rb = rtr[2 * m + 1]; const float* g2 = modf + (size_t)b * 6 * DM + 5 * DM;
#endif
        float* xr = F.out + (size_t)m * DM; pg8::f32x4 v[8]; float s = 0.f;
#pragma unroll
        for (int q = 0; q < 8; ++q) { const int c = q * 256 + F.lane * 4; const pg8::f32x4 x = *(const pg8::f32x4*)(xr + c), g = *(const pg8::f32x4*)(g2 + c);
            const v2u ya = *(const v2u*)(Y + (size_t)ra * DM + c), yb = *(const v2u*)(Y + (size_t)rb * DM + c);
            const pg8::f32x4 ys = {bflo(ya.x) + bflo(yb.x), bfhi(ya.x) + bfhi(yb.x), bflo(ya.y) + bflo(yb.y), bfhi(ya.y) + bfhi(yb.y)};
#ifdef PROBE_NOMOE
            v[q] = x + g * 0.0f; s += pg8::dot4(v[q]); (void)ys; }
#else
            v[q] = x + g * ys; s += pg8::dot4(v[q]); }
#endif
        const float rstd = __builtin_amdgcn_rsqf(wave_sum(s) * (1.0f / DM) + 1e-6f);
#pragma unroll
        for (int q = 0; q < 8; ++q) { const int c = q * 256 + F.lane * 4; *(pg8::f32x4*)(xr + c) = v[q] * rstd * *(const pg8::f32x4*)(fg + c); }
    }
}

struct Args { const float* in[33]; float* out; unsigned char* ws; int ph_lo, ph_hi; };
__global__ void __launch_bounds__(NTHR, 2) fwd_kernel(Args args) {
    extern __shared__ __attribute__((aligned(16))) unsigned char lds_raw[];
    Frame F;
    F.lds = (char*)lds_raw; F.MISC = (volatile LAS unsigned*)((LAS unsigned char*)lds_raw + MISC_OFF);
    F.tid = threadIdx.x; F.lane = F.tid & 63; F.wave = __builtin_amdgcn_readfirstlane(F.tid >> 6); F.G = gridDim.x; F.bid = blockIdx.x;
    F.ws = args.ws; F.ctl = (unsigned*)(args.ws + WS_CTL); F.out = args.out;
    F.in = (const float* const __attribute__((address_space(4)))*)__builtin_amdgcn_kernarg_segment_ptr();
    if (F.tid < 128) ((LAS unsigned*)((LAS unsigned char*)lds_raw + MISC_OFF))[F.tid] = 0u;
    __syncthreads();
    XcdBarrier bar; bar.bar = F.ctl + CW_BAR; bar.x = 0; bar.st = nullptr;
    if (N_LAUNCHES == 1) bar = xcd_barrier_post(F.ctl + CW_BAR, F.MISC + 8);
    const int lo = args.ph_lo, hi = args.ph_hi;
#ifndef PH_MASK
#define PH_MASK 0xffff
#endif
#define IN(k) (((PH_MASK >> (k)) & 1) && lo <= (k) && (k) < hi)
#define SEAM(k) do { if (IN(k) && IN((k) + 1)) xcd_barrier(bar); } while (0)
    LAS unsigned char* ring = (LAS unsigned char*)lds_raw;

    if (IN(0)) { phase0(F); } SEAM(0);
    if (IN(1)) { phase1(F); } SEAM(1);
    if (IN(2)) {
        pg8::Gemm g{(const bf16*)(F.ws + WS_H), (const bf16*)(F.ws + WS_WTIN), MALL, NINP, DM, DM}; pg8::StaticOrder S; S.init(MALL, NINP, F.G, F.bid);
        pg8::EpiP E{(bf16*)(F.ws + WS_P), NINP, (float*)(F.ws + WS_RSS)};
        pg8::gemm_phase<pg8::EpiP, pg8::StaticOrder, true, true>(ring, g, S, E);
    } SEAM(2);
    if (IN(3)) {
        for (int tl = F.bid; tl < MALL / 64; tl += F.G) rwkv_prep_tile(F, tl);
        { pg8::Gemm g{(const bf16*)(F.ws + WS_P) + C_CQ, (const bf16*)(F.ws + WS_WTUQ), MROWS, 1536, 512, NINP}; pg8::StaticOrder S; S.init(MROWS, 1536, F.G, F.bid);
          pg8::EpiQ E{(bf16*)(F.ws + WS_Q), (const float*)(F.ws + WS_RSS)};
          pg8::gemm_phase<pg8::EpiQ, pg8::StaticOrder, true, true>(ring, g, S, E); }
        { pg8::Gemm g{(const bf16*)(F.ws + WS_P) + C_CKV, (const bf16*)(F.ws + WS_WTUKV), MALL, 2048, 256, NINP}; pg8::StaticOrder S; S.init(MALL, 2048, F.G, F.bid);
          pg8::EpiKV E{(bf16*)(F.ws + WS_KN), (bf16*)(F.ws + WS_V), (const float*)(F.ws + WS_RSS)};
          pg8::gemm_phase<pg8::EpiKV, pg8::StaticOrder, true, true>(ring, g, S, E); }
    } SEAM(3);
    if (IN(4)) {
        for (int u = F.bid; u < NB * 8 * (T / 256); u += F.G) {
            const int qb = u & 31, bh = u >> 5, b = bh >> 3, h = bh & 7;
            att::attn_dense_body((const bf16*)(F.ws + WS_Q) + ((size_t)(b * T + qb * 256)) * 1536 + h * 192,
                                 (const bf16*)(F.ws + WS_KN) + (size_t)bh * NKEY * 128, (const bf16*)(F.ws + WS_V) + (size_t)bh * NKEY * 128,
                                 (const bf16*)(F.ws + WS_KR) + (size_t)b * NKEY * 64,
                                 (bf16*)(F.ws + WS_MIX) + ((size_t)(b * T + qb * 256)) * DM + h * 128, NKEY, F.lds);
        }
    } SEAM(4);
    if (IN(5)) { phase_scan(F); } SEAM(5);
    if (IN(6)) { phase_readout(F); } SEAM(6);
    if (IN(7)) {
        pg8::Gemm g{(const bf16*)(F.ws + WS_MIX), (const bf16*)(F.ws + WS_WTOUT), MROWS, DM, DM, DM}; pg8::StaticOrder S; S.init(MROWS, DM, F.G, F.bid);
        pg8::EpiOut E{F.in[0], F.out, (const float*)(F.ws + WS_MODF) + 2 * DM};
        pg8::gemm_phase<pg8::EpiOut, pg8::StaticOrder, true, true>(ring, g, S, E);
    } SEAM(7);
    if (IN(8)) { phase_route(F); } SEAM(8);
    if (IN(9)) { phase_gather(F); } SEAM(9);
    if (IN(10)) {
        build_tiles(F); const int* tab = (const int*)(F.lds + EXTRA_OFF);
        pg8::Gemm g{(const bf16*)(F.ws + WS_XG), (const bf16*)(F.ws + WS_W13T), MAXTILES * 256, NEXP * 1024, DM, DM};
        pg8::MoeOrder S{(const LAS int*)((LAS unsigned char*)lds_raw + EXTRA_OFF) + 64, tab[32], 4, F.G, F.bid};
        pg8::EpiMoe1 E{(bf16*)(F.ws + WS_HM)};
        pg8::gemm_phase<pg8::EpiMoe1, pg8::MoeOrder, true, true>(ring, g, S, E);
    } SEAM(10);
    if (IN(11)) {
        build_tiles(F); const int* tab = (const int*)(F.lds + EXTRA_OFF);
        pg8::Gemm g{(const bf16*)(F.ws + WS_HM), (const bf16*)(F.ws + WS_W2T), MAXTILES * 256, NEXP * DM, DEXP, DEXP};
        pg8::MoeOrder S{(const LAS int*)((LAS unsigned char*)lds_raw + EXTRA_OFF) + 64, tab[32], 8, F.G, F.bid};
        pg8::EpiMoe2 E{(bf16*)(F.ws + WS_Y), (const float*)(F.ws + WS_ROUTE + RT_RGATE)};
        pg8::gemm_phase<pg8::EpiMoe2, pg8::MoeOrder, true, true>(ring, g, S, E);
    } SEAM(11);
    if (IN(12)) { phase_final(F); }
#undef IN
#undef SEAM
}

extern "C" void kernel_launch(void* const* d_in, const int* in_sizes, int n_in, void* d_out, int out_size, void* d_ws, size_t ws_size, hipStream_t stream) {
    static int grid = 0;
    if (grid == 0) {
        if (n_in != 33 || in_sizes[0] != MROWS * DM || out_size != MROWS * DM || ws_size < WS_END) {
            fprintf(stderr, "kernel_launch: shape mismatch: n_in %d in0 %d out %d ws %zu (need %zu); nothing launched\n", n_in, n_in > 0 ? in_sizes[0] : -1, out_size, ws_size, (size_t)WS_END); grid = -1; return; }
        int dev = 0, cus = 0, per_cu = 0;
        if (hipGetDevice(&dev) != hipSuccess || hipDeviceGetAttribute(&cus, hipDeviceAttributeMultiprocessorCount, dev) != hipSuccess) { grid = -1; return; }
        if (hipFuncSetAttribute((const void*)fwd_kernel, hipFuncAttributeMaxDynamicSharedMemorySize, LDS_BYTES) != hipSuccess) { fprintf(stderr, "kernel_launch: hipFuncSetAttribute failed\n"); grid = -1; return; }
        if (hipOccupancyMaxActiveBlocksPerMultiprocessor(&per_cu, (const void*)fwd_kernel, NTHR, LDS_BYTES) != hipSuccess || per_cu < 1)
            fprintf(stderr, "kernel_launch: occupancy query reports %d workgroups per CU\n", per_cu);
        (void)hipGetLastError();
        grid = cus;
    }
    if (grid < 0) return;
    if (hipMemsetAsync((char*)d_ws + WS_CTL, 0, CTL_ZERO_BYTES, stream) != hipSuccess) return;
    Args a{};
    for (int i = 0; i < 33; ++i) a.in[i] = (const float*)d_in[i];
    a.out = (float*)d_out; a.ws = (unsigned char*)d_ws;
    for (int li = 0; li < N_LAUNCHES; ++li) {
#ifdef PROBE_NOMOE
        if (li >= 8 && li <= 11) continue;
#endif
#ifdef PROBE_NOSCAN
        if (li == 5) continue;
#endif
#ifdef PROBE_NOATT
        if (li == 4) { hipMemsetAsync((char*)d_ws + WS_MIX, 0, (size_t)MROWS * DM * 2, stream); continue; }
#endif
#ifdef PROBE_NORWKV
        if (li == 4) hipMemsetAsync((char*)d_ws + WS_MIX, 0, (size_t)MROWS * DM * 2, stream);
        if (li == 5 || li == 6) continue;
#endif
        a.ph_lo = (N_LAUNCHES == 1) ? 0 : li; a.ph_hi = (N_LAUNCHES == 1) ? N_PHASES : li + 1;
        hipLaunchKernelGGL(fwd_kernel, dim3(grid), dim3(NTHR), LDS_BYTES, stream, a);
        const hipError_t le = hipPeekAtLastError();
        if (le != hipSuccess) { fprintf(stderr, "kernel_launch: launch %d failed: %s\n", li, hipGetErrorName(le)); break; }
    }
}
```

```cpp
#include <hip/hip_runtime.h>
#include <cstdio>
#include <cstdint>

#define GAS __attribute__((address_space(1)))
#define LAS __attribute__((address_space(3)))
typedef unsigned short bf16;
typedef unsigned v4u __attribute__((ext_vector_type(4)));
typedef unsigned v2u __attribute__((ext_vector_type(2)));
typedef float f32x2 __attribute__((ext_vector_type(2)));
typedef float f32x16 __attribute__((ext_vector_type(16)));
typedef short s16x4 __attribute__((ext_vector_type(4)));

constexpr int DM = 2048, NB = 2, T = 8192, TC = 256, MROWS = NB * T;
constexpr int MALL = MROWS + NB * TC;
constexpr int NIN = 4192, NINP = 4352;
constexpr int C_CQ = 0, C_CKV = 512, C_KR = 768, C_R = 832, C_K = 1856, C_V = 2880, C_WL = 3904, C_AL = 3968, C_GL = 4032;
constexpr int NKEY = T + TC;
constexpr int RH = 16, RN = 64, RW = 1024;
constexpr int NEXP = 32, DEXP = 512, MAXTILES = 160;

namespace pg8 {
#define PG8_LAS __attribute__((address_space(3)))
typedef unsigned short bf16_t;
typedef short bf16x8 __attribute__((ext_vector_type(8)));
typedef float f32x4 __attribute__((ext_vector_type(4)));
typedef unsigned u32x4 __attribute__((ext_vector_type(4)));
constexpr int BM = 256, BK = 64, HALF = 128, HTB = HALF * BK * 2  , STAGE_BYTES = 8 * HTB, NXCD = 8, WGM = 8;

__host__ __device__ __forceinline__ int lds_byte(int r, int c) { const int st = (r >> 4) * 2 + (c >> 5), rr = r & 15, cc = c & 31, ob = rr * 64 + cc * 2; return st * 1024 + (ob ^ (((ob >> 9) & 1) << 5)); }
__host__ __device__ __forceinline__ void stage_rc(int b, int& R, int& C) { const int st = b / 1024, sb = b % 1024, swz = sb ^ (((sb >> 9) & 1) << 5); R = (st >> 1) * 16 + swz / 64; C = (st & 1) * 32 + (swz % 64) / 2; }
__host__ __device__ __forceinline__ int perm32(int rho) { const int n = rho >> 4, i = rho & 15; return 8 * (i >> 2) + 4 * n + (i & 3); }

struct Unit { int pm, pn; };
struct Gemm { const bf16_t* A; const bf16_t* Bt; int M, N, K, lda; };

struct StaticOrder {
    int nM, nN, nwg, G, c;
    __host__ __device__ void init(int M, int N, int G_, int c_) { nM = M / BM; nN = N / BM; nwg = nM * nN; G = G_; c = c_; }
    __host__ __device__ bool next(int i, Unit& u) const {
        const long L = (long)i * G + c; if (L >= nwg) return false;
        int wgid = (int)L; { const int q = nwg / NXCD, r = nwg % NXCD, xcd = wgid % NXCD, off = wgid / NXCD; wgid = (xcd < r ? xcd * (q + 1) : r * (q + 1) + (xcd - r) * q) + off; }
        const int nig = WGM * nN, gid = wgid / nig, fm = gid * WGM, gsz = (nM - fm) < WGM ? (nM - fm) : WGM;
        u.pm = fm + ((wgid % nig) % gsz); u.pn = (wgid % nig) / gsz; return true;
    }
    __device__ __forceinline__ void a_ready(const Unit&) const {}
    __device__ __forceinline__ void done(const Unit&) const {}
};


__device__ __forceinline__ unsigned cvt_pk_bf16(float lo, float hi) { unsigned r; asm volatile("v_cvt_pk_bf16_f32 %0, %1, %2" : "=v"(r) : "v"(lo), "v"(hi)); return r; }
typedef unsigned u32x2 __attribute__((ext_vector_type(2)));
__device__ __forceinline__ u32x4 pack8(const f32x4 a, const f32x4 b) { u32x4 w; w.x = cvt_pk_bf16(a[0], a[1]); w.y = cvt_pk_bf16(a[2], a[3]); w.z = cvt_pk_bf16(b[0], b[1]); w.w = cvt_pk_bf16(b[2], b[3]); return w; }
__device__ __forceinline__ float dot4(const f32x4 a) { return (a[0] * a[0] + a[1] * a[1]) + (a[2] * a[2] + a[3] * a[3]); }

struct EpiP {
    static constexpr bool PERM = true, AFTER_DRAIN = false;
    bf16_t* O; int ldc; float* rss;
    __device__ __forceinline__ void operator()(const f32x4 (&acc)[2][2][4][2], const Unit& u, int wr, int wc, int fr, int fq) const {
        const int row0 = u.pm * BM + wr * 64 + fr, col0 = u.pn * BM + wc * 32 + 8 * fq;
#pragma unroll
        for (int ai = 0; ai < 2; ++ai)
#pragma unroll
            for (int m = 0; m < 4; ++m) { const int row = row0 + ai * HALF + m * 16; bf16_t* rowp = O + (size_t)row * ldc + col0; float ss = 0.f;
#pragma unroll
                for (int bj = 0; bj < 2; ++bj) { const f32x4 v0 = acc[ai][bj][m][0], v1 = acc[ai][bj][m][1]; ss += dot4(v0) + dot4(v1); *(u32x4*)(rowp + bj * HALF) = pack8(v0, v1); }
                if (u.pn < 3) { ss += __shfl_xor(ss, 16); ss += __shfl_xor(ss, 32); if (fq == 0) rss[(size_t)row * 12 + u.pn * 4 + wc] = ss; } }
    }
};
struct EpiQ {
    static constexpr bool PERM = false, AFTER_DRAIN = false;
    bf16_t* Q; const float* rss;
    __device__ __forceinline__ void operator()(const f32x4 (&acc)[2][2][4][2], const Unit& u, int wr, int wc, int fr, int fq) const {
        const int row0 = u.pm * BM + wr * 64 + fr;
        float rev[4];
#pragma unroll
        for (int e = 0; e < 4; ++e) rev[e] = __builtin_amdgcn_exp2f(-(float)(4 * fq + e) * 0.83048202372184059f) * 0.15915494309189535f;
#pragma unroll
        for (int ai = 0; ai < 2; ++ai)
#pragma unroll
            for (int m = 0; m < 4; ++m) { const int row = row0 + ai * HALF + m * 16;
                const f32x4 s0 = *(const f32x4*)(rss + (size_t)row * 12), s1 = *(const f32x4*)(rss + (size_t)row * 12 + 4);
                const float ss = ((s0[0] + s0[1]) + (s0[2] + s0[3])) + ((s1[0] + s1[1]) + (s1[2] + s1[3]));
                const float rstd = __builtin_amdgcn_rsqf(ss * (1.0f / 512.0f) + 1e-6f);
                const int t = row & (T - 1); const float pr = (float)(t >> 6), pc = (float)(t & 63);
#pragma unroll
                for (int bj = 0; bj < 2; ++bj) { const int g32 = 8 * u.pn + 4 * bj + wc, gi = g32 % 6; const int col = 256 * u.pn + 128 * bj + 32 * wc + 4 * fq;
                    f32x4 v0 = acc[ai][bj][m][0] * rstd, v1 = acc[ai][bj][m][1] * rstd;
                    if (gi >= 4) { const float pos = gi == 4 ? pr : pc;
#pragma unroll
                        for (int e = 0; e < 4; ++e) { float r = pos * rev[e]; r = r - __builtin_floorf(r); const float sn = __builtin_amdgcn_sinf(r), cs = __builtin_amdgcn_cosf(r);
                            const float x1 = v0[e], x2 = v1[e]; v0[e] = x1 * cs - x2 * sn; v1[e] = x1 * sn + x2 * cs; } }
                    u32x2 w0, w1; w0.x = cvt_pk_bf16(v0[0], v0[1]); w0.y = cvt_pk_bf16(v0[2], v0[3]); w1.x = cvt_pk_bf16(v1[0], v1[1]); w1.y = cvt_pk_bf16(v1[2], v1[3]);
                    bf16_t* p = Q + (size_t)row * 1536 + col; *(u32x2*)p = w0; *(u32x2*)(p + 16) = w1; } }
    }
};
struct EpiKV {
    static constexpr bool PERM = true, AFTER_DRAIN = false;
    bf16_t* KN; bf16_t* V; const float* rss;
    __device__ __forceinline__ void operator()(const f32x4 (&acc)[2][2][4][2], const Unit& u, int wr, int wc, int fr, int fq) const {
        const int row0 = u.pm * BM + wr * 64 + fr;
#pragma unroll
        for (int ai = 0; ai < 2; ++ai)
#pragma unroll
            for (int m = 0; m < 4; ++m) { const int row = row0 + ai * HALF + m * 16;
                const f32x4 s0 = *(const f32x4*)(rss + (size_t)row * 12 + 8);
                const float rstd = __builtin_amdgcn_rsqf(((s0[0] + s0[1]) + (s0[2] + s0[3])) * (1.0f / 256.0f) + 1e-6f);
                int b, key; if (row < MROWS) { b = row >> 13; key = row & (T - 1); } else { const int r2 = row - MROWS; b = r2 >> 8; key = T + (r2 & 255); }
                const size_t off = ((size_t)(b * 8 + u.pn) * NKEY + key) * 128 + wc * 32 + 8 * fq;
                *(u32x4*)(KN + off) = pack8(acc[ai][0][m][0] * rstd, acc[ai][0][m][1] * rstd);
                *(u32x4*)(V + off) = pack8(acc[ai][1][m][0] * rstd, acc[ai][1][m][1] * rstd); }
    }
};
struct EpiOut {
    static constexpr bool PERM = false, AFTER_DRAIN = false;
    const float* x; float* X1; const float* g1;
    __device__ __forceinline__ void operator()(const f32x4 (&acc)[2][2][4][2], const Unit& u, int wr, int wc, int fr, int fq) const {
        const int row0 = u.pm * BM + wr * 64 + fr, col0 = u.pn * BM + wc * 32 + 4 * fq; const int b = (u.pm * BM) >> 13;
        f32x4 gv[2][2];
#pragma unroll
        for (int bj = 0; bj < 2; ++bj)
#pragma unroll
            for (int n = 0; n < 2; ++n) gv[bj][n] = *(const f32x4*)(g1 + (size_t)b * 6 * DM + col0 + bj * HALF + n * 16);
#pragma unroll
        for (int ai = 0; ai < 2; ++ai)
#pragma unroll
            for (int m = 0; m < 4; ++m) { const size_t off = (size_t)(row0 + ai * HALF + m * 16) * DM + col0;
#pragma unroll
                for (int bj = 0; bj < 2; ++bj)
#pragma unroll
                    for (int n = 0; n < 2; ++n) { const f32x4 xv = *(const f32x4*)(x + off + bj * HALF + n * 16); *(f32x4*)(X1 + off + bj * HALF + n * 16) = xv + gv[bj][n] * acc[ai][bj][m][n]; }
                if (m & 1) asm volatile("" ::: "memory"); }
    }
};
struct EpiMoe1 {
    static constexpr bool PERM = true, AFTER_DRAIN = false;
    bf16_t* HM;
    __device__ __forceinline__ void operator()(const f32x4 (&acc)[2][2][4][2], const Unit& u, int wr, int wc, int fr, int fq) const {
        const int row0 = u.pm * BM + wr * 64 + fr, col0 = (u.pn & 3) * 128 + wc * 32 + 8 * fq;
#pragma unroll
        for (int ai = 0; ai < 2; ++ai)
#pragma unroll
            for (int m = 0; m < 4; ++m) { f32x4 h[2];
#pragma unroll
                for (int n = 0; n < 2; ++n)
#pragma unroll
                    for (int e = 0; e < 4; ++e) { const float a = acc[ai][0][m][n][e], b = acc[ai][1][m][n][e]; h[n][e] = a * __builtin_amdgcn_rcpf(1.0f + __expf(-a)) * b; }
                *(u32x4*)(HM + (size_t)(row0 + ai * HALF + m * 16) * DEXP + col0) = pack8(h[0], h[1]); }
    }
};
struct EpiMoe2 {
    static constexpr bool PERM = true, AFTER_DRAIN = false;
    bf16_t* Y; const float* rowgate;
    __device__ __forceinline__ void operator()(const f32x4 (&acc)[2][2][4][2], const Unit& u, int wr, int wc, int fr, int fq) const {
        const int row0 = u.pm * BM + wr * 64 + fr, col0 = (u.pn & 7) * 256 + wc * 32 + 8 * fq;
#pragma unroll
        for (int ai = 0; ai < 2; ++ai)
#pragma unroll
            for (int m = 0; m < 4; ++m) { const int row = row0 + ai * HALF + m * 16; const float gt = rowgate[row];
#pragma unroll
                for (int bj = 0; bj < 2; ++bj) *(u32x4*)(Y + (size_t)row * DM + col0 + bj * HALF) = pack8(acc[ai][bj][m][0] * gt, acc[ai][bj][m][1] * gt); }
    }
};
struct MoeOrder {
    const PG8_LAS int* tile_e; int ntiles, NJ, G, c;
    __device__ __forceinline__ bool next(int i, Unit& u) const { const int L = i * G + c; if (L >= ntiles * NJ) return false; const int rt = L / NJ, j = L - rt * NJ; u.pm = rt; u.pn = tile_e[rt] * NJ + j; return true; }
    __device__ __forceinline__ void a_ready(const Unit&) const {}
    __device__ __forceinline__ void done(const Unit&) const {}
};

template <class Epi, class Sched, bool ALIGN_EPI = false, bool SP2 = false>
__device__ __forceinline__ void gemm_phase(PG8_LAS unsigned char* lds, const Gemm g, const Sched& S, const Epi& E) {
    const int tid = threadIdx.x, wid = __builtin_amdgcn_readfirstlane(tid >> 6), lane = tid & 63, wr = wid >> 2, wc = wid & 3, fr = lane & 15, fq = lane >> 4;
    const int K = g.K, nt = K / BK;
    unsigned voffA[2], voffB[2];
#pragma unroll
    for (int i = 0; i < 2; ++i) { int R, C; stage_rc(tid * 16 + i * 8192, R, C); const int Rb = Epi::PERM ? ((R & ~31) + perm32(R & 31)) : R;
        voffA[i] = (unsigned)(R * g.lda + C) * 2u; voffB[i] = (unsigned)(Rb * K + C) * 2u; }
    const size_t kstep = (size_t)(BK * 2);
    const size_t hstepA = (size_t)HALF * g.lda * 2, hstepB = (size_t)HALF * K * 2;
    const size_t tstepA = 2 * hstepA, tstepB = 2 * hstepB;
    const unsigned ldsw = (unsigned)wid * 1024u;
    const int aoff = lds_byte(wr * 64 + fr, fq * 8), boff = lds_byte(wc * 32 + fr, fq * 8);
#define PG8_SA(b, h) (((b) * 2 + (h)) * HTB)
#define PG8_SB(b, h) ((4 + (b) * 2 + (h)) * HTB)
#define PG8_STAGE(bufoff, gbase, voff) do { _Pragma("unroll") for (int _i = 0; _i < 2; ++_i) \
        __builtin_amdgcn_global_load_lds((const unsigned*)((const char*)(gbase) + (voff)[_i]), (PG8_LAS unsigned*)(lds + (bufoff) + ldsw + _i * 8192), 16, 0, 0); } while (0)
#define PG8_LDA(dst, b, h) do { _Pragma("unroll") for (int m = 0; m < 4; ++m) _Pragma("unroll") for (int k = 0; k < 2; ++k) dst[m][k] = *(const PG8_LAS bf16x8*)(lds + PG8_SA(b, h) + aoff + m * 2048 + k * 1024); } while (0)
#define PG8_LDB(dst, b, h) do { _Pragma("unroll") for (int n = 0; n < 2; ++n) _Pragma("unroll") for (int k = 0; k < 2; ++k) dst[n][k] = *(const PG8_LAS bf16x8*)(lds + PG8_SB(b, h) + boff + n * 2048 + k * 1024); } while (0)
#define PG8_MMA(ai, bj, At, Bt) do { __builtin_amdgcn_s_setprio(1); _Pragma("unroll") for (int m = 0; m < 4; ++m) _Pragma("unroll") for (int n = 0; n < 2; ++n) _Pragma("unroll") for (int k = 0; k < 2; ++k) \
        acc[ai][bj][m][n] = __builtin_amdgcn_mfma_f32_16x16x32_bf16(Bt[n][k], At[m][k], acc[ai][bj][m][n], 0, 0, 0); __builtin_amdgcn_s_setprio(0); } while (0)
#define PG8_WAIT_V(n) asm volatile("s_waitcnt vmcnt(" #n ")" ::: "memory")
#define PG8_WAIT_L(n) asm volatile("s_waitcnt lgkmcnt(" #n ")" ::: "memory")
#define PG8_BAR __builtin_amdgcn_s_barrier()
#define PG8_SCHED __builtin_amdgcn_sched_barrier(0)
    Unit cur, nxt; int ui = 0;
    if (!S.next(0, cur)) return;
    f32x4 acc[2][2][4][2];
#pragma unroll
    for (int a = 0; a < 2; ++a)
#pragma unroll
        for (int b = 0; b < 2; ++b)
#pragma unroll
            for (int m = 0; m < 4; ++m)
#pragma unroll
                for (int n = 0; n < 2; ++n) acc[a][b][m][n] = (f32x4){0.f, 0.f, 0.f, 0.f};
    bf16x8 At[4][2], B0[2][2], B1[2][2];
    const char* cA = (const char*)g.A + (size_t)cur.pm * tstepA; const char* cB = (const char*)g.Bt + (size_t)cur.pn * tstepB;
    S.a_ready(cur);
    if constexpr (SP2) {
        PG8_STAGE(PG8_SB(0, 0), cB, voffB); PG8_STAGE(PG8_SB(0, 1), cB + hstepB, voffB); PG8_STAGE(PG8_SA(0, 0), cA, voffA); PG8_STAGE(PG8_SA(0, 1), cA + hstepA, voffA);
        if (wr == 1) PG8_BAR;
        PG8_WAIT_V(2); PG8_BAR;
        PG8_STAGE(PG8_SB(1, 0), cB + kstep, voffB); PG8_STAGE(PG8_SA(1, 0), cA + kstep, voffA); PG8_STAGE(PG8_SB(1, 1), cB + hstepB + kstep, voffB);
        PG8_WAIT_V(6); PG8_BAR;
    } else {
        PG8_STAGE(PG8_SB(0, 0), cB, voffB); PG8_STAGE(PG8_SA(0, 0), cA, voffA); PG8_STAGE(PG8_SB(0, 1), cB + hstepB, voffB); PG8_STAGE(PG8_SA(0, 1), cA + hstepA, voffA);
        if (wr == 1) PG8_BAR;
        PG8_WAIT_V(4); PG8_BAR;
        PG8_STAGE(PG8_SB(1, 0), cB + kstep, voffB); PG8_STAGE(PG8_SA(1, 0), cA + kstep, voffA); PG8_STAGE(PG8_SB(1, 1), cB + hstepB + kstep, voffB);
        PG8_WAIT_V(6); PG8_BAR;
    }
    for (;;) {
        const bool has_next = S.next(ui + 1, nxt);
        const char* nA = has_next ? (const char*)g.A + (size_t)nxt.pm * tstepA : cA; const char* nB = has_next ? (const char*)g.Bt + (size_t)nxt.pn * tstepB : cB;
        for (int t = 0; t < nt; t += 2) {
            const bool last = (t == nt - 2);
            const char* a1 = cA + (size_t)(t + 1) * kstep;
            const char* a2 = last ? nA : cA + (size_t)(t + 2) * kstep; const char* b2 = last ? nB : cB + (size_t)(t + 2) * kstep;
            const char* a3 = a2 + kstep; const char* b3 = b2 + kstep;
            if (last && has_next) S.a_ready(nxt);
            if constexpr (SP2) {
            PG8_LDB(B0, 0, 0); PG8_LDB(B1, 0, 1); PG8_SCHED; PG8_LDA(At, 0, 0); PG8_STAGE(PG8_SA(1, 1), a1 + hstepA, voffA);
            PG8_WAIT_V(8); PG8_WAIT_L(0); PG8_BAR; PG8_MMA(0, 0, At, B0); PG8_MMA(0, 1, At, B1); PG8_BAR; PG8_SCHED;
            PG8_LDA(At, 0, 1); PG8_STAGE(PG8_SB(0, 0), b2, voffB); PG8_STAGE(PG8_SB(0, 1), b2 + hstepB, voffB); PG8_STAGE(PG8_SA(0, 0), a2, voffA);
            PG8_WAIT_V(8); PG8_WAIT_L(0); PG8_BAR; PG8_MMA(1, 0, At, B0); PG8_MMA(1, 1, At, B1); PG8_BAR; PG8_SCHED;
            PG8_LDB(B0, 1, 0); PG8_LDB(B1, 1, 1); PG8_SCHED; PG8_LDA(At, 1, 0); PG8_STAGE(PG8_SA(0, 1), a2 + hstepA, voffA);
            PG8_WAIT_V(8); PG8_WAIT_L(0); PG8_BAR; PG8_MMA(0, 0, At, B0); PG8_MMA(0, 1, At, B1); PG8_BAR; PG8_SCHED;
            PG8_LDA(At, 1, 1); PG8_STAGE(PG8_SB(1, 0), b3, voffB); PG8_STAGE(PG8_SB(1, 1), b3 + hstepB, voffB); PG8_STAGE(PG8_SA(1, 0), a3, voffA);
            PG8_WAIT_V(8); PG8_WAIT_L(0); PG8_BAR; PG8_MMA(1, 0, At, B0); PG8_MMA(1, 1, At, B1); PG8_BAR; PG8_SCHED;
            } else {
            PG8_LDB(B0, 0, 0); PG8_SCHED; PG8_LDA(At, 0, 0); PG8_STAGE(PG8_SA(1, 1), a1 + hstepA, voffA);
            PG8_WAIT_L(8); PG8_BAR; PG8_WAIT_L(0); PG8_MMA(0, 0, At, B0); PG8_BAR; PG8_SCHED;
            PG8_LDB(B1, 0, 1); PG8_STAGE(PG8_SB(0, 0), b2, voffB);
            PG8_BAR; PG8_WAIT_L(0); PG8_MMA(0, 1, At, B1); PG8_BAR;
            PG8_LDA(At, 0, 1); PG8_STAGE(PG8_SA(0, 0), a2, voffA);
            PG8_BAR; PG8_WAIT_L(0); PG8_MMA(1, 0, At, B0); PG8_BAR; PG8_SCHED;
            PG8_STAGE(PG8_SB(0, 1), b2 + hstepB, voffB);
            PG8_WAIT_V(6); PG8_BAR; PG8_MMA(1, 1, At, B1); PG8_BAR;
            PG8_LDB(B0, 1, 0); PG8_SCHED; PG8_LDA(At, 1, 0); PG8_STAGE(PG8_SA(0, 1), a2 + hstepA, voffA);
            PG8_WAIT_L(8); PG8_BAR; PG8_WAIT_L(0); PG8_MMA(0, 0, At, B0); PG8_BAR; PG8_SCHED;
            PG8_LDB(B1, 1, 1); PG8_STAGE(PG8_SB(1, 0), b3, voffB);
            PG8_BAR; PG8_WAIT_L(0); PG8_MMA(0, 1, At, B1); PG8_BAR;
            PG8_LDA(At, 1, 1); PG8_STAGE(PG8_SA(1, 0), a3, voffA);
            PG8_BAR; PG8_WAIT_L(0); PG8_MMA(1, 0, At, B0); PG8_BAR; PG8_SCHED;
            PG8_STAGE(PG8_SB(1, 1), b3 + hstepB, voffB);
            PG8_WAIT_V(6); PG8_BAR; PG8_MMA(1, 1, At, B1); PG8_BAR;
            }
        }
        if constexpr (ALIGN_EPI) { if (wr == 0) PG8_BAR; }
        if constexpr (!Epi::AFTER_DRAIN) { E(acc, cur, wr, wc, fr, fq); S.done(cur); }
        if (!has_next) break;
#pragma unroll
        for (int a = 0; a < 2; ++a)
#pragma unroll
            for (int b = 0; b < 2; ++b)
#pragma unroll
                for (int m = 0; m < 4; ++m)
#pragma unroll
                    for (int n = 0; n < 2; ++n) acc[a][b][m][n] = (f32x4){0.f, 0.f, 0.f, 0.f};
        cur = nxt; cA = nA; cB = nB; ++ui;
        if constexpr (ALIGN_EPI) { if (wr == 1) PG8_BAR; }
    }
    PG8_WAIT_V(0);
    if constexpr (!ALIGN_EPI) { if (wr == 0) PG8_BAR; }
    PG8_BAR;
    if constexpr (Epi::AFTER_DRAIN) { E.fused(acc, cur, wr, wc, fr, fq, lds, wid, lane); S.done(cur); }
#undef PG8_SA
#undef PG8_SB
#undef PG8_STAGE
#undef PG8_LDA
#undef PG8_LDB
#undef PG8_MMA
#undef PG8_WAIT_V
#undef PG8_WAIT_L
#undef PG8_BAR
#undef PG8_SCHED
}
}

namespace att {
using bf16x8 = __attribute__((ext_vector_type(8))) short;
using u32x4 = __attribute__((ext_vector_type(4))) unsigned;
constexpr int D = 128, DR = 64, NW = 8, QBLK = 32, KVBLK = 64;
constexpr float SCALE = 0.07216878364870322f;
constexpr float THR = 8.f;
#ifndef ATT_SDEPTH
#define ATT_SDEPTH 1
#endif
#ifndef ATT_QROPE_LDS
#define ATT_QROPE_LDS 1
#endif
constexpr int SDEPTH = ATT_SDEPTH; constexpr bool QROPE_LDS = ATT_QROPE_LDS;
constexpr int LDQ = 1536, LDK = 128, LDR = 64, LDO = 2048;
constexpr int SHM_V = KVBLK * D * 2, SHM_K = KVBLK * D * 2, SHM_R = KVBLK * DR * 2;
constexpr int OFF_V = 0, OFF_K = 2 * SHM_V, OFF_R = OFF_K + 2 * SHM_K, OFF_WS = OFF_R + 2 * SHM_R, OFF_QR = OFF_WS + NW * 64 * 4, SHM_ATTN = OFF_QR + 256 * DR * 2;
#define KSWZ(row, colB) ((row) * 256 + ((colB) ^ (((row) & 7) << 4)))
#define RSWZ(row, colB) ((row) * 128 + ((colB) ^ ((((row) >> 1) & 7) << 4)))
#define SBAR() __builtin_amdgcn_sched_barrier(0)
__device__ __forceinline__ int crow(int r, int hi) { return (r & 3) + 8 * (r >> 2) + 4 * hi; }
__device__ __forceinline__ unsigned cvtpk(float lo, float hi) { unsigned r; asm volatile("v_cvt_pk_bf16_f32 %0, %1, %2" : "=v"(r) : "v"(lo), "v"(hi)); return r; }
__device__ __forceinline__ void partialSM(f32x16& p0, f32x16& p1, float& m_reg, float& mn, float& alpha) {
  constexpr float C = SCALE * 1.4426950408889634f;
  float pmax = p0[0]; for (int r = 1; r < 16; ++r) pmax = fmaxf(pmax, p0[r]); for (int r = 0; r < 16; ++r) pmax = fmaxf(pmax, p1[r]);
  { auto rr = __builtin_amdgcn_permlane32_swap(__float_as_uint(pmax), __float_as_uint(pmax), false, false);
    pmax = fmaxf(__uint_as_float(rr[0]), __uint_as_float(rr[1])); }
  if (__builtin_expect(__all(pmax - m_reg <= THR / SCALE), 1)) { mn = m_reg; alpha = 1.f; }
  else { mn = fmaxf(m_reg, pmax); alpha = __builtin_amdgcn_exp2f((m_reg - mn) * C); m_reg = mn; }
  float mnC = -mn * C;
  for (int r = 0; r < 16; ++r) p0[r] = fmaf(p0[r], C, mnC); for (int r = 0; r < 16; ++r) p1[r] = fmaf(p1[r], C, mnC);
  for (int r = 0; r < 16; ++r) p0[r] = __builtin_amdgcn_exp2f(p0[r]);
}
__device__ __forceinline__ void finishSM(f32x16& p0, f32x16& p1, float alpha, float& l_reg, bf16x8& pa0, bf16x8& pa1, bf16x8& pa2, bf16x8& pa3) {
  for (int r = 0; r < 16; ++r) p1[r] = __builtin_amdgcn_exp2f(p1[r]);
  float ps = 0; for (int r = 0; r < 16; ++r) ps += p0[r]; for (int r = 0; r < 16; ++r) ps += p1[r];
  { auto rr = __builtin_amdgcn_permlane32_swap(__float_as_uint(ps), __float_as_uint(ps), false, false);
    ps = __uint_as_float(rr[0]) + __uint_as_float(rr[1]); }
  l_reg = l_reg * alpha + ps;
#define PK4(P, BASE, OUT) do { unsigned a0 = cvtpk(P[BASE + 0], P[BASE + 1]), a1 = cvtpk(P[BASE + 2], P[BASE + 3]);   \
    unsigned b0 = cvtpk(P[BASE + 4], P[BASE + 5]), b1 = cvtpk(P[BASE + 6], P[BASE + 7]);                              \
    auto r0 = __builtin_amdgcn_permlane32_swap(a0, b0, false, false); auto r1 = __builtin_amdgcn_permlane32_swap(a1, b1, false, false); \
    u32x4 w = {r0[0], r1[0], r0[1], r1[1]}; OUT = *reinterpret_cast<bf16x8*>(&w); } while (0)
  PK4(p0, 0, pa0); PK4(p0, 8, pa1); PK4(p1, 0, pa2); PK4(p1, 8, pa3);
#undef PK4
}
__device__ __forceinline__ void qkt(f32x16& p0, f32x16& p1, const char* Ks, const char* Rs, const bf16x8* qr, int r32, int hi, const char* Qrs) {
  p0 = f32x16{}; p1 = f32x16{};
#pragma unroll
  for (int d0 = 0; d0 < 8; ++d0) { int cb = (d0 * 16 + hi * 8) * 2;
    bf16x8 b0 = *reinterpret_cast<const bf16x8*>(Ks + KSWZ(r32, cb));
    bf16x8 b1 = *reinterpret_cast<const bf16x8*>(Ks + KSWZ(32 + r32, cb));
    p0 = __builtin_amdgcn_mfma_f32_32x32x16_bf16(b0, qr[d0], p0, 0, 0, 0);
    p1 = __builtin_amdgcn_mfma_f32_32x32x16_bf16(b1, qr[d0], p1, 0, 0, 0);
#ifdef ATT_QK_SBAR
    if (d0 == 3 || d0 == 7) SBAR();
#endif
  }
#pragma unroll
  for (int d0 = 0; d0 < 4; ++d0) { int cb = (d0 * 16 + hi * 8) * 2;
    bf16x8 b0 = *reinterpret_cast<const bf16x8*>(Rs + d0 * 2048 + r32 * 32 + hi * 16);
    bf16x8 b1 = *reinterpret_cast<const bf16x8*>(Rs + d0 * 2048 + 1024 + r32 * 32 + hi * 16);
    bf16x8 qf; if constexpr (QROPE_LDS) qf = *reinterpret_cast<const bf16x8*>(Qrs + d0 * 8192); else qf = qr[8 + d0];
    p0 = __builtin_amdgcn_mfma_f32_32x32x16_bf16(b0, qf, p0, 0, 0, 0);
    p1 = __builtin_amdgcn_mfma_f32_32x32x16_bf16(b1, qf, p1, 0, 0, 0); }
}
__device__ __forceinline__ int v_st(int k, int c) { const int kk = (k & ~0xC) | ((k & 4) << 1) | ((k & 8) >> 1); return ((kk >> 3) * 4 + (c >> 5)) * 512 + ((kk & 7) * 32 + (c & 31)) * 2; }
__device__ __forceinline__ int v_rd_base(int lane) { return ((lane & 3) << 3) | (((lane >> 2) & 3) << 6) | (((lane >> 4) & 1) << 5) | (((lane >> 5) & 1) << 8); }
constexpr int v_rd_off(int d0, int ks, int half) { return d0 * 512 + ks * 4096 + half * 2048; }
template <int OFF> __device__ __forceinline__ s16x4 tr_read(int vb) {
  s16x4 r; asm volatile("ds_read_b64_tr_b16 %0, %1 offset:%2" : "=&v"(r) : "v"(vb), "i"(OFF) : "memory"); return r;
}
template <int D0> __device__ __forceinline__ void pv_one(f32x16& od, int vb, bf16x8 pa0, bf16x8 pa1, bf16x8 pa2, bf16x8 pa3) {
  const s16x4 l0 = tr_read<v_rd_off(D0, 0, 0)>(vb), h0 = tr_read<v_rd_off(D0, 0, 1)>(vb), l1 = tr_read<v_rd_off(D0, 1, 0)>(vb), h1 = tr_read<v_rd_off(D0, 1, 1)>(vb);
  const s16x4 l2 = tr_read<v_rd_off(D0, 2, 0)>(vb), h2 = tr_read<v_rd_off(D0, 2, 1)>(vb), l3 = tr_read<v_rd_off(D0, 3, 0)>(vb), h3 = tr_read<v_rd_off(D0, 3, 1)>(vb);
  asm volatile("s_waitcnt lgkmcnt(0)" ::: "memory"); SBAR();
#define PK(L, H) (bf16x8){L[0], L[1], L[2], L[3], H[0], H[1], H[2], H[3]}
  od = __builtin_amdgcn_mfma_f32_32x32x16_bf16(pa0, PK(l0, h0), od, 0, 0, 0);
  od = __builtin_amdgcn_mfma_f32_32x32x16_bf16(pa1, PK(l1, h1), od, 0, 0, 0);
  od = __builtin_amdgcn_mfma_f32_32x32x16_bf16(pa2, PK(l2, h2), od, 0, 0, 0);
  od = __builtin_amdgcn_mfma_f32_32x32x16_bf16(pa3, PK(l3, h3), od, 0, 0, 0);
#undef PK
}
__device__ __forceinline__ void pv_d0(f32x16* o, int vb, bf16x8 pa0, bf16x8 pa1, bf16x8 pa2, bf16x8 pa3) {
  pv_one<0>(o[0], vb, pa0, pa1, pa2, pa3); pv_one<1>(o[1], vb, pa0, pa1, pa2, pa3); pv_one<2>(o[2], vb, pa0, pa1, pa2, pa3); pv_one<3>(o[3], vb, pa0, pa1, pa2, pa3);
}
__device__ __forceinline__ void attn_dense_body(const bf16* __restrict__ Qb, const bf16* __restrict__ Kh, const bf16* __restrict__ Vh, const bf16* __restrict__ Rh,
                                                bf16* __restrict__ Ob, int seq, char* lds) {
  const int tid = threadIdx.x, wid = tid >> 6, lane = tid & 63, r32 = lane & 31, hi = lane >> 5;
  char* V_lds = lds + OFF_V; char* K_lds = lds + OFF_K; char* R_lds = lds + OFF_R;
  float* ws = (float*)(lds + OFF_WS) + wid * 64; float* li_l = ws; float* al_l = ws + 32;
  float m_reg = -1e30f, l_reg = 0; f32x16 o[4] = {}; bf16x8 qr[QROPE_LDS ? 8 : 12];
  int tq_ = threadIdx.x; asm volatile("" : "+v"(tq_));
  const bf16* Qw = (const bf16*)((const char*)Qb + (unsigned)((((tq_ >> 6) * QBLK + (tq_ & 31)) * LDQ + ((tq_ >> 5) & 1) * 8) * 2));
  const char* Qrs = lds + OFF_QR + (wid * QBLK + r32) * 32 + hi * 16;
#pragma unroll
  for (int d0 = 0; d0 < (QROPE_LDS ? 8 : 12); ++d0) qr[d0] = *reinterpret_cast<const bf16x8*>(Qw + d0 * 16);
  if constexpr (QROPE_LDS) {
#pragma unroll
    for (int d0 = 0; d0 < 4; ++d0) { const bf16x8 t = *reinterpret_cast<const bf16x8*>(Qw + 128 + d0 * 16); *(bf16x8*)(lds + OFF_QR + d0 * 8192 + (wid * QBLK + r32) * 32 + hi * 16) = t; }
    asm volatile("s_waitcnt lgkmcnt(0)" ::: "memory");
  }
  const int sr = tid >> 4, sc = (tid & 15) * 8, vst0 = v_st(sr, sc), vst1 = v_st(32 + sr, sc);
  const int rr_ = tid >> 3, rc_ = (tid & 7) * 8, rst_ = (rc_ >> 4) * 2048 + rr_ * 32 + (rc_ & 8) * 2;
  const int vb0 = (int)(uintptr_t)(V_lds) + v_rd_base(lane);
  struct { bf16x8 vs0, vs1, ks0, ks1, rs0; } sr_[SDEPTH];
  const unsigned kvo_ = (unsigned)((sr * LDK + sc) * 2), ro_ = (unsigned)((rr_ * LDR + rc_) * 2);
#define SLOAD(i, k0) do { const char* vb_ = (const char*)Vh + (size_t)(k0) * (LDK * 2); const char* kb_ = (const char*)Kh + (size_t)(k0) * (LDK * 2); const char* rb_ = (const char*)Rh + (size_t)(k0) * (LDR * 2); \
    sr_[i].vs0 = *(const bf16x8*)(vb_ + kvo_); sr_[i].vs1 = *(const bf16x8*)(vb_ + 32 * LDK * 2 + kvo_); \
    sr_[i].ks0 = *(const bf16x8*)(kb_ + kvo_); sr_[i].ks1 = *(const bf16x8*)(kb_ + 32 * LDK * 2 + kvo_); \
    sr_[i].rs0 = *(const bf16x8*)(rb_ + ro_); } while (0)
#define SWRITE(b, i) do { *(bf16x8*)(V_lds + (b) * SHM_V + vst0) = sr_[i].vs0;          \
    *(bf16x8*)(V_lds + (b) * SHM_V + vst1) = sr_[i].vs1; int kc = sc * 2;               \
    *(bf16x8*)(K_lds + (b) * SHM_K + KSWZ(sr, kc)) = sr_[i].ks0;                       \
    *(bf16x8*)(K_lds + (b) * SHM_K + KSWZ(32 + sr, kc)) = sr_[i].ks1;                  \
    *(bf16x8*)(R_lds + (b) * SHM_R + rst_) = sr_[i].rs0; } while (0)
#define SWAIT() do { if constexpr (SDEPTH == 2) asm volatile("s_waitcnt vmcnt(5)" ::: "memory"); else asm volatile("s_waitcnt vmcnt(0)" ::: "memory"); } while (0)
#define RESC(a) do { if (__any((a) < 1.f)) { if (hi == 0) al_l[r32] = (a); asm volatile("s_waitcnt lgkmcnt(0)" ::: "memory"); \
    for (int d = 0; d < 4; ++d) for (int r = 0; r < 16; ++r) o[d][r] *= al_l[crow(r, hi)]; } } while (0)
  f32x16 pA0, pA1, pB0, pB1; float mnA, mnB, alA, alB; bf16x8 pa0, pa1, pa2, pa3; const int NT = seq / KVBLK;
  constexpr int SE = 0, SO = SDEPTH - 1;
  SLOAD(SE, 0); asm volatile("s_waitcnt vmcnt(0)" ::: "memory"); SWRITE(0, SE); __syncthreads();
  qkt(pA0, pA1, K_lds, R_lds, qr, r32, hi, Qrs); partialSM(pA0, pA1, m_reg, mnA, alA);
  SLOAD(SO, KVBLK); if constexpr (SDEPTH == 2) { if (2 < NT) SLOAD(SE, 2 * KVBLK); }
  SWAIT(); SWRITE(1, SO); __syncthreads();
  for (int j = 1; j + 1 < NT; j += 2) {
    SBAR(); qkt(pB0, pB1, K_lds + SHM_K, R_lds + SHM_R, qr, r32, hi, Qrs);
    finishSM(pA0, pA1, alA, l_reg, pa0, pa1, pa2, pa3); SBAR();
    SLOAD(SO, (j + SDEPTH) * KVBLK); SBAR();
    pv_d0(o, vb0, pa0, pa1, pa2, pa3); partialSM(pB0, pB1, m_reg, mnB, alB);
    __syncthreads(); SWAIT(); SWRITE(0, SE);
    RESC(alB); __syncthreads();
    SBAR(); qkt(pA0, pA1, K_lds, R_lds, qr, r32, hi, Qrs);
    finishSM(pB0, pB1, alB, l_reg, pa0, pa1, pa2, pa3); SBAR();
    if (SDEPTH == 1 || j + 3 < NT) SLOAD(SE, (j + 1 + SDEPTH) * KVBLK); SBAR();
    pv_d0(o, vb0 + SHM_V, pa0, pa1, pa2, pa3); partialSM(pA0, pA1, m_reg, mnA, alA);
    __syncthreads(); SWAIT(); SWRITE(1, SO);
    RESC(alA); __syncthreads();
  }
  SBAR(); qkt(pB0, pB1, K_lds + SHM_K, R_lds + SHM_R, qr, r32, hi, Qrs);
  finishSM(pA0, pA1, alA, l_reg, pa0, pa1, pa2, pa3); SBAR();
  pv_d0(o, vb0, pa0, pa1, pa2, pa3); partialSM(pB0, pB1, m_reg, mnB, alB);
  __syncthreads(); RESC(alB);
  finishSM(pB0, pB1, alB, l_reg, pa0, pa1, pa2, pa3); SBAR();
  pv_d0(o, vb0 + SHM_V, pa0, pa1, pa2, pa3);
  if (hi == 0) li_l[r32] = l_reg; asm volatile("s_waitcnt lgkmcnt(0)" ::: "memory");
  float rli[16];
#pragma unroll
  for (int r = 0; r < 16; ++r) rli[r] = __builtin_amdgcn_rcpf(li_l[crow(r, hi)]);
  int tl_ = threadIdx.x; asm volatile("" : "+v"(tl_));
  const unsigned oo_ = (unsigned)((((tl_ >> 6) * QBLK + 4 * ((tl_ >> 5) & 1)) * LDO + (tl_ & 31)) * 2);
#pragma unroll
  for (int r = 0; r < 16; ++r) { const char* ob_ = (const char*)Ob + (size_t)(((r & 3) + 8 * (r >> 2)) * LDO * 2);
#pragma unroll
    for (int d0 = 0; d0 < 4; ++d0) { const unsigned w = cvtpk(o[d0][r] * rli[r], 0.f); *(bf16*)(ob_ + d0 * 64 + oo_) = (bf16)(w & 0xffffu); } }
  __syncthreads();
#undef SLOAD
#undef SWRITE
#undef SWAIT
#undef RESC
}
}


constexpr int NWAVES = 8, NTHR = 512;
constexpr int N_PHASES = 13;
#ifndef MK_N_LAUNCHES
#define MK_N_LAUNCHES 1
#endif
constexpr int N_LAUNCHES = MK_N_LAUNCHES;

constexpr size_t MiB = 1u << 20;
constexpr size_t WS_CTL = 0, CTL_ZERO_BYTES = 1 * MiB;
constexpr size_t WS_MODP = 1 * MiB, WS_MODF = 4 * MiB, WS_RSS = 5 * MiB, WS_ROUTE = 6 * MiB, WS_WRT = 8 * MiB, WS_LORA = 9 * MiB;
constexpr size_t WS_WTUQ = 10 * MiB, WS_WTUKV = 12 * MiB, WS_WTOUT = 13 * MiB, WS_WTIN = 21 * MiB;
constexpr size_t WS_SCAN = 40 * MiB, SCAN_ARR = (size_t)NB * RH * NKEY * RN * 2;
constexpr size_t WS_H = 40 * MiB;
constexpr size_t WS_G = 337 * MiB;
constexpr size_t WS_P = 369 * MiB;
constexpr size_t WS_Q = 510 * MiB, WS_KN = 558 * MiB, WS_V = 591 * MiB, WS_KR = 624 * MiB;
constexpr size_t WS_MIX = 369 * MiB;
constexpr size_t WS_W13T = 433 * MiB, WS_W2T = 561 * MiB;
constexpr size_t WS_H2 = 40 * MiB, WS_XG = 104 * MiB, WS_HM = 264 * MiB, WS_Y = 104 * MiB;
constexpr size_t WS_END = 627 * MiB;
static_assert(WS_SCAN + 9 * SCAN_ARR <= WS_G && WS_G + (size_t)MROWS * RW * 2 <= WS_P && WS_P + (size_t)MALL * NINP * 2 <= WS_Q, "ws map 1");
static_assert(WS_Q + (size_t)MROWS * 1536 * 2 <= WS_KN && WS_KN + (size_t)NB * 8 * NKEY * 128 * 2 <= WS_V && WS_V + (size_t)NB * 8 * NKEY * 128 * 2 <= WS_KR && WS_KR + (size_t)NB * NKEY * 64 * 2 <= WS_END, "ws map 2");
static_assert(WS_MIX + (size_t)MROWS * DM * 2 <= WS_W13T && WS_W13T + (size_t)NEXP * 1024 * DM * 2 <= WS_W2T && WS_W2T + (size_t)NEXP * DM * DEXP * 2 <= WS_END, "ws map 3");
static_assert(WS_H2 + (size_t)MROWS * DM * 2 <= WS_XG && WS_XG + (size_t)MAXTILES * 256 * DM * 2 <= WS_HM && WS_HM + (size_t)MAXTILES * 256 * DEXP * 2 <= WS_G, "ws map 4");
static_assert(WS_WTIN + (size_t)NINP * DM * 2 <= WS_SCAN && WS_H + (size_t)MALL * DM * 2 <= WS_G, "ws map 5");
constexpr int CW_CNT = 64;
constexpr int CW_BAR = 4096;
constexpr size_t RT_E = 0, RT_POS = 131072, RT_GATE = 262144, RT_ROW = 393216, RT_RGATE = 524288;

constexpr int RING_BYTES = 131072, MISC_OFF = 131072, EXTRA_OFF = 131584, LDS_BYTES = 155648;

#define LDS_WAIT() asm volatile("s_waitcnt lgkmcnt(0)" ::: "memory")
#define VM_WAIT() asm volatile("s_waitcnt vmcnt(0)" ::: "memory")
__device__ __forceinline__ unsigned f2bf(float f) { unsigned u = __builtin_bit_cast(unsigned, f); return (u + 0x7fffu + ((u >> 16) & 1u)) >> 16; }
__device__ __forceinline__ unsigned pk2(float lo, float hi) { return pg8::cvt_pk_bf16(lo, hi); }
__device__ __forceinline__ float bflo(unsigned w) { return __builtin_bit_cast(float, w << 16); }
__device__ __forceinline__ float bfhi(unsigned w) { return __builtin_bit_cast(float, w & 0xffff0000u); }
__device__ __forceinline__ float bf1(bf16 h) { return __builtin_bit_cast(float, (unsigned)h << 16); }
__device__ __forceinline__ void unpack8(const v4u w, float (&f)[8]) { f[0] = bflo(w.x); f[1] = bfhi(w.x); f[2] = bflo(w.y); f[3] = bfhi(w.y); f[4] = bflo(w.z); f[5] = bfhi(w.z); f[6] = bflo(w.w); f[7] = bfhi(w.w); }
__device__ __forceinline__ v4u pack8f(const float (&f)[8]) { v4u w; w.x = pk2(f[0], f[1]); w.y = pk2(f[2], f[3]); w.z = pk2(f[4], f[5]); w.w = pk2(f[6], f[7]); return w; }
__device__ __forceinline__ float wave_sum(float v) {
#pragma unroll
    for (int o = 1; o < 64; o <<= 1) v += __shfl_xor(v, o);
    return v;
}
__device__ __forceinline__ float sigmoidf_(float x) { return __builtin_amdgcn_rcpf(1.0f + __expf(-x)); }

#define XB_TMO      128
#define XB_XCNT(j)  (256  + 64 * (j))
#define XB_XSUB(j)  (1280 + 64 * (j))
#define XB_XGEN(j)  (2304 + 64 * (j))
#define XB_TOP      3328
#define XB_TOPGEN   3392
#define XCD_BAR_WORDS 3456
#define XB_SPIN_CAP (1u << 18)

__device__ __forceinline__ unsigned xb_ld(unsigned* p)              { return __hip_atomic_load(p, __ATOMIC_RELAXED, __HIP_MEMORY_SCOPE_AGENT); }
__device__ __forceinline__ unsigned xb_add(unsigned* p, unsigned v) { return __hip_atomic_fetch_add(p, v, __ATOMIC_RELAXED, __HIP_MEMORY_SCOPE_AGENT); }
__device__ __forceinline__ unsigned xb_xcc_id() { return (unsigned)__builtin_amdgcn_s_getreg((3 << 11) | 20) & 0xFu; }
#define XB_SPIN(cond, bar) do { unsigned _sp = 0; while (cond) { __builtin_amdgcn_s_sleep(1); \
    if ((++_sp & 255u) == 0u) { if (xb_ld(&(bar)[XB_TMO])) break; if (_sp > XB_SPIN_CAP) { atomicAdd(&(bar)[XB_TMO], 1u); break; } } } } while (0)

struct XcdBarrier {
    unsigned* bar; unsigned x;
    volatile LAS unsigned* st;
};

__device__ __forceinline__ XcdBarrier xcd_barrier_post(unsigned* bar, volatile LAS unsigned* st) {
    XcdBarrier b; b.bar = bar; b.x = xb_xcc_id(); b.st = st;
    if (threadIdx.x == 0) (void)xb_add(&bar[XB_XCNT(b.x)], 1u);
    return b;
}
__device__ __forceinline__ void xcd_barrier_complete(unsigned* bar, unsigned x, unsigned& nloc, unsigned& nx) {
    const unsigned G = gridDim.x * gridDim.y * gridDim.z;
    unsigned sum, cnt, mine, sp = 0u;
    for (;;) {
        sum = 0u; cnt = 0u; mine = 0u;
#pragma unroll
        for (unsigned j = 0; j < 16; ++j) { const unsigned c = xb_ld(&bar[XB_XCNT(j)]); sum += c; cnt += (c > 0u) ? 1u : 0u; mine = (j == x) ? c : mine; }
        if (sum == G) break;
        __builtin_amdgcn_s_sleep(1);
        if ((++sp & 255u) == 0u) { if (xb_ld(&bar[XB_TMO])) break; if (sp > XB_SPIN_CAP) { atomicAdd(&bar[XB_TMO], 1u); break; } }
    }
    nloc = mine > 0u ? mine : 1u; nx = cnt > 0u ? cnt : 1u;
}

__device__ __forceinline__ void xcd_barrier(const XcdBarrier& b) {
    asm volatile("s_waitcnt vmcnt(0)" ::: "memory");
    __syncthreads();
    if (threadIdx.x == 0) {
        unsigned* bar = b.bar;
        __builtin_amdgcn_s_waitcnt(0);
        unsigned nloc = b.st[0], nx = b.st[1];
        if (nloc == 0u) { xcd_barrier_complete(bar, b.x, nloc, nx); b.st[0] = nloc; b.st[1] = nx; }
        const unsigned old = xb_add(&bar[XB_XSUB(b.x)], 1u);
        const unsigned gen = old / nloc;
        if (old + 1u == (gen + 1u) * nloc) {
            __builtin_amdgcn_fence(__ATOMIC_RELEASE, "agent");
            asm volatile("s_waitcnt vmcnt(0)" ::: "memory");
            const unsigned og = xb_add(&bar[XB_TOP], 1u);
            const unsigned tg = og / nx;
            if (og + 1u == (tg + 1u) * nx) xb_add(&bar[XB_TOPGEN], 1u);
            else XB_SPIN(xb_ld(&bar[XB_TOPGEN]) == tg, bar);
            __builtin_amdgcn_fence(__ATOMIC_ACQUIRE, "agent");
            xb_add(&bar[XB_XGEN(b.x)], 1u);
            asm volatile("s_waitcnt vmcnt(0)" ::: "memory");
        } else {
            XB_SPIN(xb_ld(&bar[XB_XGEN(b.x)]) == gen, bar);
            __builtin_amdgcn_fence(__ATOMIC_ACQUIRE, "agent");
            asm volatile("s_waitcnt vmcnt(0)" ::: "memory");
        }
    }
    __syncthreads();
}

#ifndef PROBE_DW
#define PROBE_DW 0
#endif
struct Frame {
    char* lds;
    volatile LAS unsigned* MISC;
    unsigned* ctl;
    unsigned char* ws;
    int tid, lane, wave, G, bid;
    const float* const __attribute__((address_space(4)))* in;
    float* out;
};

__device__ __forceinline__ void transpose_item(const float* W, int K, int N, bf16* WT, int row_off, const float* kscale, float* scr, int item, int lane) {
    const int nblk = N / 32, kb = item / nblk, nb = item % nblk, k0 = 64 * kb, n0 = 32 * nb;
#pragma unroll 8
    for (int i = 0; i < 32; ++i) { const int kk = 2 * i + (lane >> 5); float v = W[(size_t)(k0 + kk) * N + n0 + (lane & 31)]; if (kscale) v *= kscale[k0 + kk]; scr[kk * 33 + (lane & 31)] = v; }
    LDS_WAIT(); asm volatile("" ::: "memory");
    const int c = lane & 7;
#pragma unroll
    for (int j = 0; j < 4; ++j) { const int n = (lane >> 3) + 8 * j; const float* s = scr + (8 * c) * 33 + n;
        v4u o; o.x = pk2(s[0 * 33], s[1 * 33]); o.y = pk2(s[2 * 33], s[3 * 33]); o.z = pk2(s[4 * 33], s[5 * 33]); o.w = pk2(s[6 * 33], s[7 * 33]);
        *(v4u*)(WT + (size_t)(row_off + n0 + n) * K + k0 + 8 * c) = o; }
    LDS_WAIT(); asm volatile("" ::: "memory");
}

__device__ __forceinline__ void small_conversions(Frame& F, const int gt, const int NGT) {
    { bf16* wr = (bf16*)(F.ws + WS_WRT);
      for (int i = gt; i < 48 * DM; i += NGT) { const int n = i / DM, k = i - n * DM; float v = 0.f; if (n < 4) v = F.in[25][k * 4 + n]; else if (n < 36) v = F.in[27][k * 32 + (n - 4)]; wr[i] = (bf16)f2bf(v); } }
    { bf16* lw = (bf16*)(F.ws + WS_LORA);
      for (int i = gt; i < 2 * RW * 64; i += NGT) { const int d = i / (RW * 64), r = i - d * RW * 64, ch = r >> 6, k = r & 63;
          lw[i] = (bf16)f2bf(F.in[PROBE_DW == 5 ? 17 : 15][(size_t)(d * 64 + k) * RW + ch]); lw[2 * RW * 64 + i] = (bf16)f2bf(F.in[17][(size_t)(d * 64 + k) * RW + ch]); }
      for (int i = gt; i < RW * 160; i += NGT) { const int ch = i / 160, k = i - ch * 160; lw[4 * RW * 64 + i] = (bf16)f2bf(F.in[18][(size_t)k * RW + ch]); } }
}

__device__ __forceinline__ void phase0(Frame& F) {
    float* st = (float*)F.lds;
    for (int i = F.tid; i < 3 * DM; i += NTHR) { const int j = i / DM, k = i - j * DM; const float v = j < 2 ? F.in[1][j * DM + k] : F.in[3][k]; st[i] = v * sigmoidf_(v); }
    __syncthreads();
    const int gw = F.bid * NWAVES + F.wave, NGW = F.G * NWAVES;
    const float* wmod = F.in[4]; float* modp = (float*)(F.ws + WS_MODP);
    for (int it = gw; it < 768; it += NGW) {
        const int cc = it % 48, ks = it / 48, n0 = cc * 256 + F.lane * 4;
        pg8::f32x4 a0 = {0.f, 0.f, 0.f, 0.f}, a1 = a0, a2 = a0;
        const float* wp = wmod + (size_t)(ks * 128) * (6 * DM) + n0;
#pragma unroll 8
        for (int k = 0; k < 128; ++k) { const pg8::f32x4 w = *(const pg8::f32x4*)(wp + (size_t)k * (6 * DM)); const int kk = ks * 128 + k;
            a0 += w * st[kk]; a1 += w * st[DM + kk]; a2 += w * st[2 * DM + kk]; }
        *(pg8::f32x4*)(modp + (size_t)(ks * 3 + 0) * (6 * DM) + n0) = a0; *(pg8::f32x4*)(modp + (size_t)(ks * 3 + 1) * (6 * DM) + n0) = a1; *(pg8::f32x4*)(modp + (size_t)(ks * 3 + 2) * (6 * DM) + n0) = a2;
    }
    __syncthreads();
    float* scr = (float*)(F.lds + F.wave * 8448);
    constexpr int I_IN = (DM / 64) * (NIN / 32), I_UQ = (512 / 64) * (1536 / 32), I_UKV = (256 / 64) * (2048 / 32), I_OUT = (DM / 64) * (DM / 32);
    for (int it = gw; it < I_IN + I_UQ + I_UKV + I_OUT; it += NGW) {
        int r = it;
        if (r < I_IN) { transpose_item(F.in[8], DM, NIN, (bf16*)(F.ws + WS_WTIN), 0, nullptr, scr, r, F.lane); continue; } r -= I_IN;
        if (r < I_UQ) { transpose_item(F.in[11], 512, 1536, (bf16*)(F.ws + WS_WTUQ), 0, F.in[10], scr, r, F.lane); continue; } r -= I_UQ;
        if (r < I_UKV) { transpose_item(F.in[13], 256, 2048, (bf16*)(F.ws + WS_WTUKV), 0, F.in[12], scr, r, F.lane); continue; } r -= I_UKV;
        transpose_item(F.in[24], DM, DM, (bf16*)(F.ws + WS_WTOUT), 0, nullptr, scr, r, F.lane);
    }
    const int gt = F.bid * NTHR + F.tid, NGT = F.G * NTHR;
    { v4u* z = (v4u*)((bf16*)(F.ws + WS_WTIN) + (size_t)NIN * DM); const v4u zero = {0u, 0u, 0u, 0u};
      for (int i = gt; i < (NINP - NIN) * DM / 8; i += NGT) z[i] = zero; }
#ifndef PROBE_SMALL_IN_P1
    small_conversions(F, gt, NGT);
#endif
}

__device__ __forceinline__ void phase1(Frame& F) {
    float* sft = (float*)F.lds; float* scl = sft + 3 * DM;
    const float* modp = (const float*)(F.ws + WS_MODP); const float* bmod = F.in[5]; const float* gat = F.in[6];
    for (int i = F.tid; i < 3 * 2 * DM; i += NTHR) { const int j = i / (2 * DM), n = i - j * 2 * DM; float s = bmod[n];
        for (int ks = 0; ks < 16; ++ks) s += modp[(size_t)(ks * 3 + j) * (6 * DM) + n];
        if (n < DM) sft[j * DM + n] = s; else scl[j * DM + n - DM] = gat[n - DM] * (1.0f + s); }
    if (F.bid < 144 && F.tid < 256) { const int j = F.bid / 48, n = (F.bid % 48) * 256 + F.tid; float s = bmod[n];
        for (int ks = 0; ks < 16; ++ks) s += modp[(size_t)(ks * 3 + j) * (6 * DM) + n];
        ((float*)(F.ws + WS_MODF))[j * 6 * DM + n] = s; }
    __syncthreads();
    const int gw = F.bid * NWAVES + F.wave, NGW = F.G * NWAVES;
    bf16* H = (bf16*)(F.ws + WS_H);
    for (int m = gw; m < MALL; m += NGW) {
        const int j = m < T ? 0 : (m < MROWS ? 1 : 2);
        const float* xr = m < MROWS ? F.in[0] + (size_t)m * DM : F.in[2] + (size_t)(m - MROWS) * DM;
        pg8::f32x4 v[8]; float s = 0.f;
#pragma unroll
        for (int q = 0; q < 8; ++q) { v[q] = *(const pg8::f32x4*)(xr + q * 256 + F.lane * 4); s += pg8::dot4(v[q]); }
        const float rstd = __builtin_amdgcn_rsqf(wave_sum(s) * (1.0f / DM) + 1e-6f);
#pragma unroll
        for (int q = 0; q < 8; ++q) { const int c = q * 256 + F.lane * 4; const pg8::f32x4 sc = *(const pg8::f32x4*)(scl + j * DM + c), sh = *(const pg8::f32x4*)(sft + j * DM + c);
            const pg8::f32x4 o = v[q] * rstd * sc + sh; v2u w; w.x = pk2(o[0], o[1]); w.y = pk2(o[2], o[3]); *(v2u*)(H + (size_t)m * DM + c) = w; }
    }
#ifdef PROBE_SMALL_IN_P1
    small_conversions(F, F.bid * NTHR + F.tid, F.G * NTHR);
#endif
}

__device__ __forceinline__ void rwkv_prep_tile(Frame& F, int tile) {
    const bf16* P = (const bf16*)(F.ws + WS_P); const float* mu = F.in[9];
    const int m0 = tile * 64;
    const bool isctx = m0 >= MROWS; const int seqlen = isctx ? TC : T;
    const int b = isctx ? (m0 - MROWS) >> 8 : m0 >> 13, t0 = isctx ? (m0 - MROWS) & 255 : m0 & (T - 1), pos0 = isctx ? T + t0 : t0;
    bf16* XW = (bf16*)F.lds; bf16* XA = XW + 64 * 72; bf16* XGt = XA + 64 * 72; float* KS = (float*)(XGt + 64 * 168); float* KKS = KS + 64 * 64;
    for (int i = F.tid; i < 64 * 44; i += NTHR) {
        const int tk = i / 44, gq = i - tk * 44; const int t = t0 + tk; const size_t row = (size_t)(m0 + tk);
        if (gq < 36) {
            const int col = C_WL + gq * 8;
            float c[8], p[8], n[8], o[8];
            unpack8(*(const v4u*)(P + row * NINP + col), c);
            if (t > 0) unpack8(*(const v4u*)(P + (row - 1) * NINP + col), p); else { for (int e = 0; e < 8; ++e) p[e] = 0.f; }
            if (t < seqlen - 1) unpack8(*(const v4u*)(P + (row + 1) * NINP + col), n); else { for (int e = 0; e < 8; ++e) n[e] = 0.f; }
#pragma unroll
            for (int e = 0; e < 8; ++e) { const int rc = col - C_R + e; const float s = c[e] + mu[rc] * (p[e] - c[e]) + mu[3360 + rc] * (n[e] - c[e]);
                o[e] = gq < 8 ? 1.0f - 2.0f * __builtin_amdgcn_rcpf(1.0f + __expf(2.0f * s)) : (gq < 16 ? s : sigmoidf_(s)); }
            bf16* dst = gq < 8 ? XW + tk * 72 + gq * 8 : (gq < 16 ? XA + tk * 72 + (gq - 8) * 8 : XGt + tk * 168 + (gq - 16) * 8);
            *(v4u*)dst = pack8f(o);
        } else {
            const int g8 = gq - 36, half = g8 >> 2, j0 = (g8 & 3) * 8;
            float x[8], y[8], o[8];
            unpack8(*(const v4u*)(P + row * NINP + C_KR + half * 32 + j0), x);
            unpack8(*(const v4u*)(P + row * NINP + C_KR + half * 32 + (j0 ^ 16)), y);
            if (isctx) { for (int e = 0; e < 8; ++e) o[e] = x[e]; }
            else { const float pos = half == 0 ? (float)(t >> 6) : (float)(t & 63);
#pragma unroll
                for (int e = 0; e < 8; ++e) { const int jf = (j0 & 15) + e; float r = pos * (__builtin_amdgcn_exp2f(-(float)jf * 0.83048202372184059f) * 0.15915494309189535f); r = r - __builtin_floorf(r);
                    const float sn = __builtin_amdgcn_sinf(r), cs = __builtin_amdgcn_cosf(r);
                    o[e] = j0 < 16 ? x[e] * cs - y[e] * sn : y[e] * sn + x[e] * cs; } }
            *(v4u*)((bf16*)(F.ws + WS_KR) + ((size_t)b * NKEY + pos0 + tk) * 64 + half * 32 + j0) = pack8f(o);
        }
    }
    __syncthreads();
    const float* w0 = F.in[14]; const float* a0 = F.in[16]; const float* keyk = F.in[19]; const float* keya = F.in[20];
    const bf16* LW = (const bf16*)(F.ws + WS_LORA); const bf16* LA = LW + 2 * RW * 64; const bf16* LG = LW + 4 * RW * 64;
    const int fr = F.lane & 15, fq = F.lane >> 4;
    for (int h = 0; h < RH; ++h) {
        const size_t hb = ((size_t)(b * RH + h) * NKEY + pos0) * RN;
        {
            const int tk = F.tid >> 3, c8 = (F.tid & 7) * 8; const int t = t0 + tk; const size_t row = (size_t)(m0 + tk);
            float sh[3][8];
#pragma unroll
            for (int a = 0; a < 3; ++a) { const int col = (a == 0 ? C_R : (a == 1 ? C_K : C_V)) + h * 64 + c8; float c[8], p[8], n[8];
                unpack8(*(const v4u*)(P + row * NINP + col), c);
                if (t > 0) unpack8(*(const v4u*)(P + (row - 1) * NINP + col), p); else { for (int e = 0; e < 8; ++e) p[e] = 0.f; }
                if (t < seqlen - 1) unpack8(*(const v4u*)(P + (row + 1) * NINP + col), n); else { for (int e = 0; e < 8; ++e) n[e] = 0.f; }
#pragma unroll
                for (int e = 0; e < 8; ++e) { const int rc = col - C_R + e; sh[a][e] = c[e] + mu[rc] * (p[e] - c[e]) + mu[3360 + rc] * (n[e] - c[e]); } }
            *(v4u*)((bf16*)(F.ws + WS_SCAN + 0 * SCAN_ARR) + hb + tk * 64 + c8) = pack8f(sh[0]);
            *(v4u*)((bf16*)(F.ws + WS_SCAN + 1 * SCAN_ARR) + hb + tk * 64 + c8) = pack8f(sh[2]);
            float kk[8], ss = 0.f;
#pragma unroll
            for (int e = 0; e < 8; ++e) { kk[e] = sh[1][e] * keyk[h * 64 + c8 + e]; ss += kk[e] * kk[e]; }
            ss += __shfl_xor(ss, 1); ss += __shfl_xor(ss, 2); ss += __shfl_xor(ss, 4);
            const float rn = __builtin_amdgcn_rsqf(ss + 1e-12f);
#pragma unroll
            for (int e = 0; e < 8; ++e) { kk[e] *= rn; KS[tk * 64 + c8 + e] = sh[1][e]; KKS[tk * 64 + c8 + e] = kk[e]; }
            *(v4u*)((bf16*)(F.ws + WS_SCAN + 2 * SCAN_ARR) + hb + tk * 64 + c8) = pack8f(kk);
        }
        __syncthreads();
        {
            const int tb = F.wave & 3, cbp = F.wave >> 2;
            pg8::bf16x8 xw[2], xa[2], xg[5];
#pragma unroll
            for (int kb = 0; kb < 2; ++kb) { xw[kb] = *(const pg8::bf16x8*)(XW + (tb * 16 + fr) * 72 + kb * 32 + fq * 8); xa[kb] = *(const pg8::bf16x8*)(XA + (tb * 16 + fr) * 72 + kb * 32 + fq * 8); }
#pragma unroll
            for (int kb = 0; kb < 5; ++kb) xg[kb] = *(const pg8::bf16x8*)(XGt + (tb * 16 + fr) * 168 + kb * 32 + fq * 8);
#pragma unroll
            for (int cbi = 0; cbi < 2; ++cbi) {
                const int cb = cbp * 2 + cbi, chl = cb * 16 + fr, chg = h * 64 + chl;
                pg8::f32x4 dw[2], da[2], dg = {0.f, 0.f, 0.f, 0.f};
#pragma unroll
                for (int d = 0; d < 2; ++d) { dw[d] = (pg8::f32x4){0.f, 0.f, 0.f, 0.f}; da[d] = dw[d];
#pragma unroll
                    for (int kb = 0; kb < 2; ++kb) {
                        const pg8::bf16x8 fw = *(const pg8::bf16x8*)(LW + ((size_t)(d * RW + chg)) * 64 + kb * 32 + fq * 8);
                        const pg8::bf16x8 fa = *(const pg8::bf16x8*)(LA + ((size_t)(d * RW + chg)) * 64 + kb * 32 + fq * 8);
#if PROBE_DW == 3
                        dw[d] = __builtin_amdgcn_mfma_f32_16x16x32_bf16(fw, xa[kb], dw[d], 0, 0, 0);
#elif PROBE_DW == 4
                        dw[d] = __builtin_amdgcn_mfma_f32_16x16x32_bf16(fa, xw[kb], dw[d], 0, 0, 0);
#else
                        dw[d] = __builtin_amdgcn_mfma_f32_16x16x32_bf16(fw, xw[kb], dw[d], 0, 0, 0);
#endif
                        da[d] = __builtin_amdgcn_mfma_f32_16x16x32_bf16(fa, xa[kb], da[d], 0, 0, 0); } }
#pragma unroll
                for (int kb = 0; kb < 5; ++kb) { const pg8::bf16x8 fg = *(const pg8::bf16x8*)(LG + (size_t)chg * 160 + kb * 32 + fq * 8); dg = __builtin_amdgcn_mfma_f32_16x16x32_bf16(fg, xg[kb], dg, 0, 0, 0); }
                asm volatile("s_nop 15\n\ts_nop 15" : "+v"(dw[0]), "+v"(dw[1]), "+v"(da[0]), "+v"(da[1]), "+v"(dg));
                const int tk = tb * 16 + fr, c4 = cb * 16 + 4 * fq, cg = h * 64 + c4;
                const pg8::f32x4 ks = *(const pg8::f32x4*)(KS + tk * 64 + c4), kk = *(const pg8::f32x4*)(KKS + tk * 64 + c4);
                const pg8::f32x4 ka = *(const pg8::f32x4*)(keya + cg);
#pragma unroll
                for (int d = 0; d < 2; ++d) { const pg8::f32x4 w0v = *(const pg8::f32x4*)(w0 + d * RW + cg), a0v = *(const pg8::f32x4*)(a0 + d * RW + cg);
                    float dec[4], kd[4], bd[4];
#pragma unroll
                                        for (int j = 0; j < 4; ++j) { const float wr = PROBE_DW == 1 ? w0v[j] : (PROBE_DW == 2 ? dw[d][j] : w0v[j] + dw[d][j]); dec[j] = __expf(-0.60653065971263342f * sigmoidf_(wr));
                        const float eta = sigmoidf_(a0v[j] + da[d][j]); kd[j] = ks[j] * (1.0f + (eta - 1.0f) * ka[j]); bd[j] = kk[j] * eta; }
                    v2u w; w.x = pk2(dec[0], dec[1]); w.y = pk2(dec[2], dec[3]); *(v2u*)((bf16*)(F.ws + WS_SCAN + (3 + d) * SCAN_ARR) + hb + tk * 64 + c4) = w;
                    w.x = pk2(kd[0], kd[1]); w.y = pk2(kd[2], kd[3]); *(v2u*)((bf16*)(F.ws + WS_SCAN + (5 + d) * SCAN_ARR) + hb + tk * 64 + c4) = w;
                    w.x = pk2(bd[0], bd[1]); w.y = pk2(bd[2], bd[3]); *(v2u*)((bf16*)(F.ws + WS_SCAN + (7 + d) * SCAN_ARR) + hb + tk * 64 + c4) = w; }
                if (!isctx) { v2u w; w.x = pk2(dg[0], dg[1]); w.y = pk2(dg[2], dg[3]); *(v2u*)((bf16*)(F.ws + WS_G) + ((size_t)(b * RH + h) * T + t0 + tk) * RN + c4) = w; }
            }
        }
        __syncthreads();
    }
}

template <int CTRL> __device__ __forceinline__ float dpp_add(float x) { return x + __builtin_bit_cast(float, __builtin_amdgcn_update_dpp(0, __builtin_bit_cast(int, x), CTRL, 0xf, 0xf, false)); }
__device__ __forceinline__ float red16(float x) { x = dpp_add<0xB1>(x); x = dpp_add<0x4E>(x); x = dpp_add<0x141>(x); x = dpp_add<0x140>(x); return x; }

__device__ __forceinline__ void scan_unit(Frame& F, int sc) {
    const int dir = sc & 1, bh = sc >> 1; const bool fwd = dir == 0;
    const size_t hb = (size_t)bh * NKEY * RN;
    const bf16* src0 = (const bf16*)(F.ws + WS_SCAN) + hb;
#ifdef PROBE_YWS
    float* Yg = (float*)(F.ws + WS_W13T) + (size_t)dir * MROWS * RW + (size_t)bh * T * RN;
#else
    float* Yg = F.out + (size_t)dir * MROWS * RW + (size_t)bh * T * RN;
#endif
    float* buf = (float*)F.lds;
    float* ybuf = buf + 2 * 6 * 2048;
    constexpr int NCH = (TC + T) / 32;
    auto chunk_pos = [&](int c) { if (c < 8) { const int cn = fwd ? c : 7 - c; return T + 32 * cn; } const int cl = c - 8, cn = fwd ? cl : 255 - cl; return 32 * cn; };
    auto load_chunk = [&](int c, int nthreads, int t0) {
        const int pos = chunk_pos(c); float* dst = buf + (c & 1) * 6 * 2048;
        for (int i = F.tid - t0; i < 6 * 256; i += nthreads) { const int a = i >> 8, e8 = (i & 255) * 8; float f[8]; const int ai = a < 3 ? a : 3 + 2 * (a - 3) + dir; unpack8(*(const v4u*)(src0 + (size_t)ai * (SCAN_ARR / 2) + (size_t)pos * RN + e8), f);
            *(pg8::f32x4*)(dst + a * 2048 + e8) = (pg8::f32x4){f[0], f[1], f[2], f[3]}; *(pg8::f32x4*)(dst + a * 2048 + e8 + 4) = (pg8::f32x4){f[4], f[5], f[6], f[7]}; }
    };
#ifdef PROBE_NOCTX
    constexpr int C0 = 8;
#else
    constexpr int C0 = 0;
#endif
    load_chunk(C0, NTHR, 0);
    __syncthreads();
    const int vg = F.lane >> 4, kl = F.lane & 15, vrow = 16 * F.wave + 4 * vg;
    float S[4][4];
#pragma unroll
    for (int i = 0; i < 4; ++i)
#pragma unroll
        for (int j = 0; j < 4; ++j) S[i][j] = 0.f;
    for (int c = C0; c < NCH; ++c) {
        const bool latent = c >= 8;
        if (F.wave >= 4) { if (c + 1 < NCH) load_chunk(c + 1, 256, 256); }
        else {
            const float* cb = buf + (c & 1) * 6 * 2048;
            for (int s = 0; s < 32; ++s) {
                const int sn = fwd ? s : 31 - s;
                const pg8::f32x4 rv = *(const pg8::f32x4*)(cb + 0 * 2048 + sn * 64 + 4 * kl), vv = *(const pg8::f32x4*)(cb + 1 * 2048 + sn * 64 + vrow);
                const pg8::f32x4 kk = *(const pg8::f32x4*)(cb + 2 * 2048 + sn * 64 + 4 * kl), w = *(const pg8::f32x4*)(cb + 3 * 2048 + sn * 64 + 4 * kl);
                const pg8::f32x4 kv = *(const pg8::f32x4*)(cb + 4 * 2048 + sn * 64 + 4 * kl), bt = *(const pg8::f32x4*)(cb + 5 * 2048 + sn * 64 + 4 * kl);
                float sa[4];
#pragma unroll
                for (int i = 0; i < 4; ++i) sa[i] = -red16((S[i][0] * kk[0] + S[i][1] * kk[1]) + (S[i][2] * kk[2] + S[i][3] * kk[3]));
#pragma unroll
                for (int i = 0; i < 4; ++i)
#pragma unroll
                    for (int j = 0; j < 4; ++j) S[i][j] = S[i][j] * w[j] + sa[i] * bt[j] + vv[i] * kv[j];
                if (latent) {
                    float y[4];
#pragma unroll
                    for (int i = 0; i < 4; ++i) y[i] = red16((S[i][0] * rv[0] + S[i][1] * rv[1]) + (S[i][2] * rv[2] + S[i][3] * rv[3]));
                    if (kl == 0) *(pg8::f32x4*)(ybuf + sn * 64 + vrow) = (pg8::f32x4){y[0], y[1], y[2], y[3]};
                }
            }
        }
        __syncthreads();
        if (latent) { const int pos = chunk_pos(c); *(pg8::f32x4*)(Yg + (size_t)pos * RN + F.tid * 4) = *(const pg8::f32x4*)(ybuf + F.tid * 4); }
        __syncthreads();
    }
}
__device__ __forceinline__ void phase_scan(Frame& F) {
    if (F.bid < 64) { scan_unit(F, F.bid); return; }
#ifdef PROBE_YWS
    return;
#endif
    float* scr = (float*)(F.lds + F.wave * 8448);
    const int gw = (F.bid - 64) * NWAVES + F.wave, NGW = (F.G - 64) * NWAVES;
    constexpr int I13 = (DM / 64) * (DEXP / 32), I2 = (DEXP / 64) * (DM / 32);
    for (int it = gw; it < NEXP * (2 * I13 + I2); it += NGW) {
        const int e = it / (2 * I13 + I2); int r = it - e * (2 * I13 + I2);
        if (r < 2 * I13) { const int is3 = r >= I13; if (is3) r -= I13; const int n0 = 32 * (r % (DEXP / 32));
            transpose_item(F.in[is3 ? 30 : 29] + (size_t)e * DM * DEXP, DM, DEXP, (bf16*)(F.ws + WS_W13T), e * 1024 + (n0 / 128) * 128 + 128 * is3, nullptr, scr, r, F.lane); }
        else transpose_item(F.in[31] + (size_t)e * DEXP * DM, DEXP, DM, (bf16*)(F.ws + WS_W2T), e * DM, nullptr, scr, r - 2 * I13, F.lane);
    }
}

__device__ __forceinline__ void phase_readout(Frame& F) {
    const float* rk = F.in[21]; const float* lg = F.in[22]; const float* lb = F.in[23];
    bf16* MIX = (bf16*)(F.ws + WS_MIX);
    const int tk = F.tid >> 3, c8 = (F.tid & 7) * 8;
    for (int it = F.bid; it < NB * RH * (T / 64); it += F.G) {
        const int bh = it >> 7, tt = (it & 127) * 64 + tk, b = bh >> 4, h = bh & 15;
        const size_t ys = ((size_t)bh * T + tt) * RN + c8, ss = ((size_t)bh * NKEY + tt) * RN + c8;
#ifdef PROBE_YWS
        const float* Ysrc = (const float*)(F.ws + WS_W13T);
#else
        const float* Ysrc = F.out;
#endif
        const pg8::f32x4 f0 = *(const pg8::f32x4*)(Ysrc + ys), f1 = *(const pg8::f32x4*)(Ysrc + ys + 4);
        const pg8::f32x4 b0 = *(const pg8::f32x4*)(Ysrc + (size_t)MROWS * RW + ys), b1 = *(const pg8::f32x4*)(Ysrc + (size_t)MROWS * RW + ys + 4);
        float y[8] = {f0[0] + b0[0], f0[1] + b0[1], f0[2] + b0[2], f0[3] + b0[3], f1[0] + b1[0], f1[1] + b1[1], f1[2] + b1[2], f1[3] + b1[3]};
#ifdef PROBE_NOSCAN
        for (int e = 0; e < 8; ++e) y[e] = 0.f;
#endif
#ifdef PROBE_SCANIN
        { float t0[8], t1[8], t2[8], t3[8], t4[8];
          unpack8(*(const v4u*)((const bf16*)(F.ws + WS_SCAN + 2 * SCAN_ARR) + ss), t0); unpack8(*(const v4u*)((const bf16*)(F.ws + WS_SCAN + 3 * SCAN_ARR) + ss), t1);
          unpack8(*(const v4u*)((const bf16*)(F.ws + WS_SCAN + 4 * SCAN_ARR) + ss), t2); unpack8(*(const v4u*)((const bf16*)(F.ws + WS_SCAN + 7 * SCAN_ARR) + ss), t3);
          unpack8(*(const v4u*)((const bf16*)(F.ws + WS_SCAN + 8 * SCAN_ARR) + ss), t4);
#ifndef PROBE_SEL
#define PROBE_SEL 31
#endif
          for (int e = 0; e < 8; ++e) y[e] = ((PROBE_SEL & 1) ? t0[e] : 0.f) + ((PROBE_SEL & 2) ? t1[e] * (1.0f + e) : 0.f) + ((PROBE_SEL & 4) ? t2[e] * (2.0f - e) : 0.f) + ((PROBE_SEL & 8) ? t3[e] * 3.0f : 0.f) + ((PROBE_SEL & 16) ? t4[e] * (e - 3.5f) : 0.f); }
#endif
        float r[8], v[8], k0[8], k1[8], g[8];
        unpack8(*(const v4u*)((const bf16*)(F.ws + WS_SCAN + 0 * SCAN_ARR) + ss), r); unpack8(*(const v4u*)((const bf16*)(F.ws + WS_SCAN + 1 * SCAN_ARR) + ss), v);
        unpack8(*(const v4u*)((const bf16*)(F.ws + WS_SCAN + 5 * SCAN_ARR) + ss), k0); unpack8(*(const v4u*)((const bf16*)(F.ws + WS_SCAN + 6 * SCAN_ARR) + ss), k1);
        unpack8(*(const v4u*)((const bf16*)(F.ws + WS_G) + ys), g);
        float s = 0.f, bon = 0.f;
#pragma unroll
        for (int e = 0; e < 8; ++e) { s += y[e]; bon += r[e] * (k0[e] + k1[e]) * rk[h * 64 + c8 + e]; }
        s += __shfl_xor(s, 1); s += __shfl_xor(s, 2); s += __shfl_xor(s, 4); bon += __shfl_xor(bon, 1); bon += __shfl_xor(bon, 2); bon += __shfl_xor(bon, 4);
        const float mean = s * (1.0f / 64.0f); float q = 0.f;
#pragma unroll
        for (int e = 0; e < 8; ++e) { y[e] -= mean; q += y[e] * y[e]; }
        q += __shfl_xor(q, 1); q += __shfl_xor(q, 2); q += __shfl_xor(q, 4);
        const float rstd = __builtin_amdgcn_rsqf(q * (1.0f / 64.0f) + 64e-5f);
        float o[8];
#pragma unroll
        for (int e = 0; e < 8; ++e) { const int ch = h * 64 + c8 + e; o[e] = (y[e] * rstd * lg[ch] + lb[ch] + bon * v[e]) * g[e]; }
        *(v4u*)(MIX + ((size_t)b * T + tt) * DM + RW + h * 64 + c8) = pack8f(o);
    }
}

__device__ __forceinline__ void phase_route(Frame& F) {
    const float* X1 = F.out; const float* modf = (const float*)(F.ws + WS_MODF); const float* gf = F.in[7];
    const bf16* WR = (const bf16*)(F.ws + WS_WRT); bf16* H2 = (bf16*)(F.ws + WS_H2);
    int* rte = (int*)(F.ws + WS_ROUTE + RT_E); int* rtp = (int*)(F.ws + WS_ROUTE + RT_POS); float* rtg = (float*)(F.ws + WS_ROUTE + RT_GATE);
    float* lg = (float*)(F.lds) + F.wave * (16 * 48);
    const int fr = F.lane & 15, fq = F.lane >> 4;
    const int gw = F.bid * NWAVES + F.wave, NGW = F.G * NWAVES;
    for (int it = gw; it < MROWS / 16; it += NGW) {
        const int row = it * 16 + fr, b = row >> 13; const float* xr = X1 + (size_t)row * DM + fq * 8;
        float ss = 0.f;
#pragma unroll 8
        for (int k = 0; k < 64; ++k) { const pg8::f32x4 a = *(const pg8::f32x4*)(xr + k * 32), c = *(const pg8::f32x4*)(xr + k * 32 + 4); ss += pg8::dot4(a) + pg8::dot4(c); }
        ss += __shfl_xor(ss, 16); ss += __shfl_xor(ss, 32);
        const float rstd = __builtin_amdgcn_rsqf(ss * (1.0f / DM) + 1e-6f);
        const float* sh2 = modf + (size_t)b * 6 * DM + 3 * DM + fq * 8; const float* sc2 = modf + (size_t)b * 6 * DM + 4 * DM + fq * 8;
        pg8::f32x4 acc[3] = {{0.f, 0.f, 0.f, 0.f}, {0.f, 0.f, 0.f, 0.f}, {0.f, 0.f, 0.f, 0.f}};
#pragma unroll 4
        for (int k = 0; k < 64; ++k) {
            const pg8::f32x4 a = *(const pg8::f32x4*)(xr + k * 32), c = *(const pg8::f32x4*)(xr + k * 32 + 4);
            const pg8::f32x4 g0 = *(const pg8::f32x4*)(gf + fq * 8 + k * 32), g1 = *(const pg8::f32x4*)(gf + fq * 8 + k * 32 + 4);
            const pg8::f32x4 s0 = *(const pg8::f32x4*)(sc2 + k * 32), s1 = *(const pg8::f32x4*)(sc2 + k * 32 + 4), h0 = *(const pg8::f32x4*)(sh2 + k * 32), h1 = *(const pg8::f32x4*)(sh2 + k * 32 + 4);
            const pg8::f32x4 o0 = a * rstd * g0 * (s0 + 1.0f) + h0, o1 = c * rstd * g1 * (s1 + 1.0f) + h1;
            const pg8::u32x4 w = pg8::pack8(o0, o1);
            *(pg8::u32x4*)(H2 + (size_t)row * DM + fq * 8 + k * 32) = w;
            const pg8::bf16x8 xb = __builtin_bit_cast(pg8::bf16x8, w);
#pragma unroll
            for (int nb = 0; nb < 3; ++nb) { const pg8::bf16x8 wf = *(const pg8::bf16x8*)(WR + (size_t)(nb * 16 + fr) * DM + k * 32 + fq * 8); acc[nb] = __builtin_amdgcn_mfma_f32_16x16x32_bf16(wf, xb, acc[nb], 0, 0, 0); }
        }
        asm volatile("s_nop 15\n\ts_nop 15" : "+v"(acc[0]), "+v"(acc[1]), "+v"(acc[2]));
#pragma unroll
        for (int nb = 0; nb < 3; ++nb)
#pragma unroll
            for (int j = 0; j < 4; ++j) lg[fr * 48 + nb * 16 + 4 * fq + j] = acc[nb][j];
        LDS_WAIT(); asm volatile("" ::: "memory");
        if (F.lane < 16) {
            const float* l = lg + F.lane * 48; const float* bg = F.in[26]; const float* be = F.in[28];
            int g = 0; float gm = l[0] + bg[0]; float gl[4]; gl[0] = gm;
#pragma unroll
            for (int i = 1; i < 4; ++i) { gl[i] = l[i] + bg[i]; if (gl[i] > gm) { gm = gl[i]; g = i; } }
            float gs = 0.f;
#pragma unroll
            for (int i = 0; i < 4; ++i) gs += __expf(gl[i] - gm);
            const float gval = 1.0f / gs;
            float w8[8]; int i1 = 0; float m1 = -3.0e38f;
#pragma unroll
            for (int i = 0; i < 8; ++i) { w8[i] = l[4 + 8 * g + i] + be[8 * g + i]; if (w8[i] > m1) { m1 = w8[i]; i1 = i; } }
            int i2 = 0; float m2 = -3.0e38f;
#pragma unroll
            for (int i = 0; i < 8; ++i) { if (i != i1 && w8[i] > m2) { m2 = w8[i]; i2 = i; } }
            const float e2 = __expf(m2 - m1), inv = 1.0f / (1.0f + e2);
            const int ea = 8 * g + i1, eb = 8 * g + i2; const int t = it * 16 + F.lane;
            const int pa = (int)atomicAdd(F.ctl + CW_CNT + ea, 1u), pb = (int)atomicAdd(F.ctl + CW_CNT + eb, 1u);
            rte[2 * t] = ea; rte[2 * t + 1] = eb; rtp[2 * t] = pa; rtp[2 * t + 1] = pb; rtg[2 * t] = gval * inv; rtg[2 * t + 1] = gval * e2 * inv;
        }
        LDS_WAIT(); asm volatile("" ::: "memory");
    }
}

__device__ __forceinline__ void build_tiles(Frame& F) {
    int* tab = (int*)(F.lds + EXTRA_OFF);
    if (F.tid == 0) { int tb = 0;
        for (int e = 0; e < NEXP; ++e) { const int c = (int)__hip_atomic_load(F.ctl + CW_CNT + e, __ATOMIC_RELAXED, __HIP_MEMORY_SCOPE_AGENT); const int nt = (c + 255) >> 8; tab[e] = tb * 256;
            for (int i = 0; i < nt && tb + i < MAXTILES; ++i) tab[64 + tb + i] = e; tb += nt; }
        tab[32] = tb < MAXTILES ? tb : MAXTILES; }
    __syncthreads();
}
__device__ __forceinline__ void phase_gather(Frame& F) {
    build_tiles(F);
    const int* tab = (const int*)(F.lds + EXTRA_OFF);
    const int* rte = (const int*)(F.ws + WS_ROUTE + RT_E); const int* rtp = (const int*)(F.ws + WS_ROUTE + RT_POS); const float* rtg = (const float*)(F.ws + WS_ROUTE + RT_GATE);
    int* rtr = (int*)(F.ws + WS_ROUTE + RT_ROW); float* rgate = (float*)(F.ws + WS_ROUTE + RT_RGATE);
    const bf16* H2 = (const bf16*)(F.ws + WS_H2); bf16* XG = (bf16*)(F.ws + WS_XG);
    const int gw = F.bid * NWAVES + F.wave, NGW = F.G * NWAVES;
    for (int p = gw; p < 2 * MROWS; p += NGW) {
        const int t = p >> 1; const int row = tab[rte[p]] + rtp[p];
        const v4u* s = (const v4u*)(H2 + (size_t)t * DM) + F.lane; v4u* d = (v4u*)(XG + (size_t)row * DM) + F.lane;
#pragma unroll
        for (int q = 0; q < 4; ++q) d[64 * q] = s[64 * q];
        if (F.lane == 0) { rtr[p] = row; rgate[row] = rtg[p]; }
    }
}
__device__ __forceinline__ void phase_final(Frame& F) {
    const float* modf = (const float*)(F.ws + WS_MODF); const float* fg = F.in[32]; const bf16* Y = (const bf16*)(F.ws + WS_Y); const int* rtr = (const int*)(F.ws + WS_ROUTE + RT_ROW);
    const int gw = F.bid * NWAVES + F.wave, NGW = F.G * NWAVES;
    for (int m = gw; m < MROWS; m += NGW) {
#ifdef PROBE_NOMOE
        const int b = m >> 13, ra = 0, rb = 0; const float* g2 = modf + (size_t)b * 6 * DM + 5 * DM;
#else
        const int b = m >> 13, ra = rtr[2 * m], rb = rtr[2 * m + 1]; const float* g2 = modf + (size_t)b * 6 * DM + 5 * DM;
#endif
        float* xr = F.out + (size_t)m * DM; pg8::f32x4 v[8]; float s = 0.f;
#pragma unroll
        for (int q = 0; q < 8; ++q) { const int c = q * 256 + F.lane * 4; const pg8::f32x4 x = *(const pg8::f32x4*)(xr + c), g = *(const pg8::f32x4*)(g2 + c);
            const v2u ya = *(const v2u*)(Y + (size_t)ra * DM + c), yb = *(const v2u*)(Y + (size_t)rb * DM + c);
            const pg8::f32x4 ys = {bflo(ya.x) + bflo(yb.x), bfhi(ya.x) + bfhi(yb.x), bflo(ya.y) + bflo(yb.y), bfhi(ya.y) + bfhi(yb.y)};
#ifdef PROBE_NOMOE
            v[q] = x + g * 0.0f; s += pg8::dot4(v[q]); (void)ys; }
#else
            v[q] = x + g * ys; s += pg8::dot4(v[q]); }
#endif
        const float rstd = __builtin_amdgcn_rsqf(wave_sum(s) * (1.0f / DM) + 1e-6f);
#pragma unroll
        for (int q = 0; q < 8; ++q) { const int c = q * 256 + F.lane * 4; *(pg8::f32x4*)(xr + c) = v[q] * rstd * *(const pg8::f32x4*)(fg + c); }
    }
}

struct Args { const float* in[33]; float* out; unsigned char* ws; int ph_lo, ph_hi; };
__global__ void __launch_bounds__(NTHR, 2) fwd_kernel(Args args) {
    extern __shared__ __attribute__((aligned(16))) unsigned char lds_raw[];
    Frame F;
    F.lds = (char*)lds_raw; F.MISC = (volatile LAS unsigned*)((LAS unsigned char*)lds_raw + MISC_OFF);
    F.tid = threadIdx.x; F.lane = F.tid & 63; F.wave = __builtin_amdgcn_readfirstlane(F.tid >> 6); F.G = gridDim.x; F.bid = blockIdx.x;
    F.ws = args.ws; F.ctl = (unsigned*)(args.ws + WS_CTL); F.out = args.out;
    F.in = (const float* const __attribute__((address_space(4)))*)__builtin_amdgcn_kernarg_segment_ptr();
    if (F.tid < 128) ((LAS unsigned*)((LAS unsigned char*)lds_raw + MISC_OFF))[F.tid] = 0u;
    __syncthreads();
    XcdBarrier bar; bar.bar = F.ctl + CW_BAR; bar.x = 0; bar.st = nullptr;
    if (N_LAUNCHES == 1) bar = xcd_barrier_post(F.ctl + CW_BAR, F.MISC + 8);
    const int lo = args.ph_lo, hi = args.ph_hi;
#ifndef PH_MASK
#define PH_MASK 0xffff
#endif
#define IN(k) (((PH_MASK >> (k)) & 1) && lo <= (k) && (k) < hi)
#define SEAM(k) do { if (IN(k) && IN((k) + 1)) xcd_barrier(bar); } while (0)
    LAS unsigned char* ring = (LAS unsigned char*)lds_raw;

    if (IN(0)) { phase0(F); } SEAM(0);
    if (IN(1)) { phase1(F); } SEAM(1);
    if (IN(2)) {
        pg8::Gemm g{(const bf16*)(F.ws + WS_H), (const bf16*)(F.ws + WS_WTIN), MALL, NINP, DM, DM}; pg8::StaticOrder S; S.init(MALL, NINP, F.G, F.bid);
        pg8::EpiP E{(bf16*)(F.ws + WS_P), NINP, (float*)(F.ws + WS_RSS)};
        pg8::gemm_phase<pg8::EpiP, pg8::StaticOrder, true, true>(ring, g, S, E);
    } SEAM(2);
    if (IN(3)) {
        for (int tl = F.bid; tl < MALL / 64; tl += F.G) rwkv_prep_tile(F, tl);
        { pg8::Gemm g{(const bf16*)(F.ws + WS_P) + C_CQ, (const bf16*)(F.ws + WS_WTUQ), MROWS, 1536, 512, NINP}; pg8::StaticOrder S; S.init(MROWS, 1536, F.G, F.bid);
          pg8::EpiQ E{(bf16*)(F.ws + WS_Q), (const float*)(F.ws + WS_RSS)};
          pg8::gemm_phase<pg8::EpiQ, pg8::StaticOrder, true, true>(ring, g, S, E); }
        { pg8::Gemm g{(const bf16*)(F.ws + WS_P) + C_CKV, (const bf16*)(F.ws + WS_WTUKV), MALL, 2048, 256, NINP}; pg8::StaticOrder S; S.init(MALL, 2048, F.G, F.bid);
          pg8::EpiKV E{(bf16*)(F.ws + WS_KN), (bf16*)(F.ws + WS_V), (const float*)(F.ws + WS_RSS)};
          pg8::gemm_phase<pg8::EpiKV, pg8::StaticOrder, true, true>(ring, g, S, E); }
    } SEAM(3);
    if (IN(4)) {
        for (int u = F.bid; u < NB * 8 * (T / 256); u += F.G) {
            const int qb = u & 31, bh = u >> 5, b = bh >> 3, h = bh & 7;
            att::attn_dense_body((const bf16*)(F.ws + WS_Q) + ((size_t)(b * T + qb * 256)) * 1536 + h * 192,
                                 (const bf16*)(F.ws + WS_KN) + (size_t)bh * NKEY * 128, (const bf16*)(F.ws + WS_V) + (size_t)bh * NKEY * 128,
                                 (const bf16*)(F.ws + WS_KR) + (size_t)b * NKEY * 64,
                                 (bf16*)(F.ws + WS_MIX) + ((size_t)(b * T + qb * 256)) * DM + h * 128, NKEY, F.lds);
        }
    } SEAM(4);
    if (IN(5)) { phase_scan(F); } SEAM(5);
    if (IN(6)) { phase_readout(F); } SEAM(6);
    if (IN(7)) {
        pg8::Gemm g{(const bf16*)(F.ws + WS_MIX), (const bf16*)(F.ws + WS_WTOUT), MROWS, DM, DM, DM}; pg8::StaticOrder S; S.init(MROWS, DM, F.G, F.bid);
        pg8::EpiOut E{F.in[0], F.out, (const float*)(F.ws + WS_MODF) + 2 * DM};
        pg8::gemm_phase<pg8::EpiOut, pg8::StaticOrder, true, true>(ring, g, S, E);
    } SEAM(7);
    if (IN(8)) { phase_route(F); } SEAM(8);
    if (IN(9)) { phase_gather(F); } SEAM(9);
    if (IN(10)) {
        build_tiles(F); const int* tab = (const int*)(F.lds + EXTRA_OFF);
        pg8::Gemm g{(const bf16*)(F.ws + WS_XG), (const bf16*)(F.ws + WS_W13T), MAXTILES * 256, NEXP * 1024, DM, DM};
        pg8::MoeOrder S{(const LAS int*)((LAS unsigned char*)lds_raw + EXTRA_OFF) + 64, tab[32], 4, F.G, F.bid};
        pg8::EpiMoe1 E{(bf16*)(F.ws + WS_HM)};
        pg8::gemm_phase<pg8::EpiMoe1, pg8::MoeOrder, true, true>(ring, g, S, E);
    } SEAM(10);
    if (IN(11)) {
        build_tiles(F); const int* tab = (const int*)(F.lds + EXTRA_OFF);
        pg8::Gemm g{(const bf16*)(F.ws + WS_HM), (const bf16*)(F.ws + WS_W2T), MAXTILES * 256, NEXP * DM, DEXP, DEXP};
        pg8::MoeOrder S{(const LAS int*)((LAS unsigned char*)lds_raw + EXTRA_OFF) + 64, tab[32], 8, F.G, F.bid};
        pg8::EpiMoe2 E{(bf16*)(F.ws + WS_Y), (const float*)(F.ws + WS_ROUTE + RT_RGATE)};
        pg8::gemm_phase<pg8::EpiMoe2, pg8::MoeOrder, true, true>(ring, g, S, E);
    } SEAM(11);
    if (IN(12)) { phase_final(F); }
#undef IN
#undef SEAM
}

extern "C" void kernel_launch(void* const* d_in, const int* in_sizes, int n_in, void* d_out, int out_size, void* d_ws, size_t ws_size, hipStream_t stream) {
    static int grid = 0;
    if (grid == 0) {
        if (n_in != 33 || in_sizes[0] != MROWS * DM || out_size != MROWS * DM || ws_size < WS_END) {
            fprintf(stderr, "kernel_launch: shape mismatch: n_in %d in0 %d out %d ws %zu (need %zu); nothing launched\n", n_in, n_in > 0 ? in_sizes[0] : -1, out_size, ws_size, (size_t)WS_END); grid = -1; return; }
        int dev = 0, cus = 0, per_cu = 0;
        if (hipGetDevice(&dev) != hipSuccess || hipDeviceGetAttribute(&cus, hipDeviceAttributeMultiprocessorCount, dev) != hipSuccess) { grid = -1; return; }
        if (hipFuncSetAttribute((const void*)fwd_kernel, hipFuncAttributeMaxDynamicSharedMemorySize, LDS_BYTES) != hipSuccess) { fprintf(stderr, "kernel_launch: hipFuncSetAttribute failed\n"); grid = -1; return; }
        if (hipOccupancyMaxActiveBlocksPerMultiprocessor(&per_cu, (const void*)fwd_kernel, NTHR, LDS_BYTES) != hipSuccess || per_cu < 1)
            fprintf(stderr, "kernel_launch: occupancy query reports %d workgroups per CU\n", per_cu);
        (void)hipGetLastError();
        grid = cus;
    }
    if (grid < 0) return;
    if (hipMemsetAsync((char*)d_ws + WS_CTL, 0, CTL_ZERO_BYTES, stream) != hipSuccess) return;
    Args a{};
    for (int i = 0; i < 33; ++i) a.in[i] = (const float*)d_in[i];
    a.out = (float*)d_out; a.ws = (unsigned char*)d_ws;
    for (int li = 0; li < N_LAUNCHES; ++li) {
#ifdef PROBE_NOMOE
        if (li >= 8 && li <= 11) continue;
#endif
#ifdef PROBE_NOSCAN
        if (li == 5) continue;
#endif
#ifdef PROBE_NOATT
        if (li == 4) { hipMemsetAsync((char*)d_ws + WS_MIX, 0, (size_t)MROWS * DM * 2, stream); continue; }
#endif
#ifdef PROBE_NORWKV
        if (li == 4) hipMemsetAsync((char*)d_ws + WS_MIX, 0, (size_t)MROWS * DM * 2, stream);
        if (li == 5 || li == 6) continue;
#endif
        a.ph_lo = (N_LAUNCHES == 1) ? 0 : li; a.ph_hi = (N_LAUNCHES == 1) ? N_PHASES : li + 1;
        hipLaunchKernelGGL(fwd_kernel, dim3(grid), dim3(NTHR), LDS_BYTES, stream, a);
        const hipError_t le = hipPeekAtLastError();
        if (le != hipSuccess) { fprintf(stderr, "kernel_launch: launch %d failed: %s\n", li, hipGetErrorName(le)); break; }
    }
}
```

```cpp
#include <hip/hip_runtime.h>
#include <cstdio>
#include <cstdint>

#define GAS __attribute__((address_space(1)))
#define LAS __attribute__((address_space(3)))
typedef unsigned short bf16;
typedef unsigned v4u __attribute__((ext_vector_type(4)));
typedef unsigned v2u __attribute__((ext_vector_type(2)));
typedef float f32x2 __attribute__((ext_vector_type(2)));
typedef float f32x16 __attribute__((ext_vector_type(16)));
typedef short s16x4 __attribute__((ext_vector_type(4)));

constexpr int DM = 2048, NB = 2, T = 8192, TC = 256, MROWS = NB * T;
constexpr int MALL = MROWS + NB * TC;
constexpr int NIN = 4192, NINP = 4352;
constexpr int C_CQ = 0, C_CKV = 512, C_KR = 768, C_R = 832, C_K = 1856, C_V = 2880, C_WL = 3904, C_AL = 3968, C_GL = 4032;
constexpr int NKEY = T + TC;
constexpr int RH = 16, RN = 64, RW = 1024;
constexpr int NEXP = 32, DEXP = 512, MAXTILES = 160;

namespace pg8 {
#define PG8_LAS __attribute__((address_space(3)))
typedef unsigned short bf16_t;
typedef short bf16x8 __attribute__((ext_vector_type(8)));
typedef float f32x4 __attribute__((ext_vector_type(4)));
typedef unsigned u32x4 __attribute__((ext_vector_type(4)));
constexpr int BM = 256, BK = 64, HALF = 128, HTB = HALF * BK * 2  , STAGE_BYTES = 8 * HTB, NXCD = 8, WGM = 8;

__host__ __device__ __forceinline__ int lds_byte(int r, int c) { const int st = (r >> 4) * 2 + (c >> 5), rr = r & 15, cc = c & 31, ob = rr * 64 + cc * 2; return st * 1024 + (ob ^ (((ob >> 9) & 1) << 5)); }
__host__ __device__ __forceinline__ void stage_rc(int b, int& R, int& C) { const int st = b / 1024, sb = b % 1024, swz = sb ^ (((sb >> 9) & 1) << 5); R = (st >> 1) * 16 + swz / 64; C = (st & 1) * 32 + (swz % 64) / 2; }
__host__ __device__ __forceinline__ int perm32(int rho) { const int n = rho >> 4, i = rho & 15; return 8 * (i >> 2) + 4 * n + (i & 3); }

struct Unit { int pm, pn; };
struct Gemm { const bf16_t* A; const bf16_t* Bt; int M, N, K, lda; };

struct StaticOrder {
    int nM, nN, nwg, G, c;
    __host__ __device__ void init(int M, int N, int G_, int c_) { nM = M / BM; nN = N / BM; nwg = nM * nN; G = G_; c = c_; }
    __host__ __device__ bool next(int i, Unit& u) const {
        const long L = (long)i * G + c; if (L >= nwg) return false;
        int wgid = (int)L; { const int q = nwg / NXCD, r = nwg % NXCD, xcd = wgid % NXCD, off = wgid / NXCD; wgid = (xcd < r ? xcd * (q + 1) : r * (q + 1) + (xcd - r) * q) + off; }
        const int nig = WGM * nN, gid = wgid / nig, fm = gid * WGM, gsz = (nM - fm) < WGM ? (nM - fm) : WGM;
        u.pm = fm + ((wgid % nig) % gsz); u.pn = (wgid % nig) / gsz; return true;
    }
    __device__ __forceinline__ void a_ready(const Unit&) const {}
    __device__ __forceinline__ void done(const Unit&) const {}
};


__device__ __forceinline__ unsigned cvt_pk_bf16(float lo, float hi) { unsigned r; asm volatile("v_cvt_pk_bf16_f32 %0, %1, %2" : "=v"(r) : "v"(lo), "v"(hi)); return r; }
typedef unsigned u32x2 __attribute__((ext_vector_type(2)));
__device__ __forceinline__ u32x4 pack8(const f32x4 a, const f32x4 b) { u32x4 w; w.x = cvt_pk_bf16(a[0], a[1]); w.y = cvt_pk_bf16(a[2], a[3]); w.z = cvt_pk_bf16(b[0], b[1]); w.w = cvt_pk_bf16(b[2], b[3]); return w; }
__device__ __forceinline__ float dot4(const f32x4 a) { return (a[0] * a[0] + a[1] * a[1]) + (a[2] * a[2] + a[3] * a[3]); }

struct EpiP {
    static constexpr bool PERM = true, AFTER_DRAIN = false;
    bf16_t* O; int ldc; float* rss;
    __device__ __forceinline__ void operator()(const f32x4 (&acc)[2][2][4][2], const Unit& u, int wr, int wc, int fr, int fq) const {
        const int row0 = u.pm * BM + wr * 64 + fr, col0 = u.pn * BM + wc * 32 + 8 * fq;
#pragma unroll
        for (int ai = 0; ai < 2; ++ai)
#pragma unroll
            for (int m = 0; m < 4; ++m) { const int row = row0 + ai * HALF + m * 16; bf16_t* rowp = O + (size_t)row * ldc + col0; float ss = 0.f;
#pragma unroll
                for (int bj = 0; bj < 2; ++bj) { const f32x4 v0 = acc[ai][bj][m][0], v1 = acc[ai][bj][m][1]; ss += dot4(v0) + dot4(v1); *(u32x4*)(rowp + bj * HALF) = pack8(v0, v1); }
                if (u.pn < 3) { ss += __shfl_xor(ss, 16); ss += __shfl_xor(ss, 32); if (fq == 0) rss[(size_t)row * 12 + u.pn * 4 + wc] = ss; } }
    }
};
struct EpiQ {
    static constexpr bool PERM = false, AFTER_DRAIN = false;
    bf16_t* Q; const float* rss;
    __device__ __forceinline__ void operator()(const f32x4 (&acc)[2][2][4][2], const Unit& u, int wr, int wc, int fr, int fq) const {
        const int row0 = u.pm * BM + wr * 64 + fr;
        float rev[4];
#pragma unroll
        for (int e = 0; e < 4; ++e) rev[e] = __builtin_amdgcn_exp2f(-(float)(4 * fq + e) * 0.83048202372184059f) * 0.15915494309189535f;
#pragma unroll
        for (int ai = 0; ai < 2; ++ai)
#pragma unroll
            for (int m = 0; m < 4; ++m) { const int row = row0 + ai * HALF + m * 16;
                const f32x4 s0 = *(const f32x4*)(rss + (size_t)row * 12), s1 = *(const f32x4*)(rss + (size_t)row * 12 + 4);
                const float ss = ((s0[0] + s0[1]) + (s0[2] + s0[3])) + ((s1[0] + s1[1]) + (s1[2] + s1[3]));
                const float rstd = __builtin_amdgcn_rsqf(ss * (1.0f / 512.0f) + 1e-6f);
                const int t = row & (T - 1); const float pr = (float)(t >> 6), pc = (float)(t & 63);
#pragma unroll
                for (int bj = 0; bj < 2; ++bj) { const int g32 = 8 * u.pn + 4 * bj + wc, gi = g32 % 6; const int col = 256 * u.pn + 128 * bj + 32 * wc + 4 * fq;
                    f32x4 v0 = acc[ai][bj][m][0] * rstd, v1 = acc[ai][bj][m][1] * rstd;
                    if (gi >= 4) { const float pos = gi == 4 ? pr : pc;
#pragma unroll
                        for (int e = 0; e < 4; ++e) { float r = pos * rev[e]; r = r - __builtin_floorf(r); const float sn = __builtin_amdgcn_sinf(r), cs = __builtin_amdgcn_cosf(r);
                            const float x1 = v0[e], x2 = v1[e]; v0[e] = x1 * cs - x2 * sn; v1[e] = x1 * sn + x2 * cs; } }
                    u32x2 w0, w1; w0.x = cvt_pk_bf16(v0[0], v0[1]); w0.y = cvt_pk_bf16(v0[2], v0[3]); w1.x = cvt_pk_bf16(v1[0], v1[1]); w1.y = cvt_pk_bf16(v1[2], v1[3]);
                    bf16_t* p = Q + (size_t)row * 1536 + col; *(u32x2*)p = w0; *(u32x2*)(p + 16) = w1; } }
    }
};
struct EpiKV {
    static constexpr bool PERM = true, AFTER_DRAIN = false;
    bf16_t* KN; bf16_t* V; const float* rss;
    __device__ __forceinline__ void operator()(const f32x4 (&acc)[2][2][4][2], const Unit& u, int wr, int wc, int fr, int fq) const {
        const int row0 = u.pm * BM + wr * 64 + fr;
#pragma unroll
        for (int ai = 0; ai < 2; ++ai)
#pragma unroll
            for (int m = 0; m < 4; ++m) { const int row = row0 + ai * HALF + m * 16;
                const f32x4 s0 = *(const f32x4*)(rss + (size_t)row * 12 + 8);
                const float rstd = __builtin_amdgcn_rsqf(((s0[0] + s0[1]) + (s0[2] + s0[3])) * (1.0f / 256.0f) + 1e-6f);
                int b, key; if (row < MROWS) { b = row >> 13; key = row & (T - 1); } else { const int r2 = row - MROWS; b = r2 >> 8; key = T + (r2 & 255); }
                const size_t off = ((size_t)(b * 8 + u.pn) * NKEY + key) * 128 + wc * 32 + 8 * fq;
                *(u32x4*)(KN + off) = pack8(acc[ai][0][m][0] * rstd, acc[ai][0][m][1] * rstd);
                *(u32x4*)(V + off) = pack8(acc[ai][1][m][0] * rstd, acc[ai][1][m][1] * rstd); }
    }
};
struct EpiOut {
    static constexpr bool PERM = false, AFTER_DRAIN = false;
    const float* x; float* X1; const float* g1;
    __device__ __forceinline__ void operator()(const f32x4 (&acc)[2][2][4][2], const Unit& u, int wr, int wc, int fr, int fq) const {
        const int row0 = u.pm * BM + wr * 64 + fr, col0 = u.pn * BM + wc * 32 + 4 * fq; const int b = (u.pm * BM) >> 13;
        f32x4 gv[2][2];
#pragma unroll
        for (int bj = 0; bj < 2; ++bj)
#pragma unroll
            for (int n = 0; n < 2; ++n) gv[bj][n] = *(const f32x4*)(g1 + (size_t)b * 6 * DM + col0 + bj * HALF + n * 16);
#pragma unroll
        for (int ai = 0; ai < 2; ++ai)
#pragma unroll
            for (int m = 0; m < 4; ++m) { const size_t off = (size_t)(row0 + ai * HALF + m * 16) * DM + col0;
#pragma unroll
                for (int bj = 0; bj < 2; ++bj)
#pragma unroll
                    for (int n = 0; n < 2; ++n) { const f32x4 xv = *(const f32x4*)(x + off + bj * HALF + n * 16); *(f32x4*)(X1 + off + bj * HALF + n * 16) = xv + gv[bj][n] * acc[ai][bj][m][n]; }
                if (m & 1) asm volatile("" ::: "memory"); }
    }
};
struct EpiMoe1 {
    static constexpr bool PERM = true, AFTER_DRAIN = false;
    bf16_t* HM;
    __device__ __forceinline__ void operator()(const f32x4 (&acc)[2][2][4][2], const Unit& u, int wr, int wc, int fr, int fq) const {
        const int row0 = u.pm * BM + wr * 64 + fr, col0 = (u.pn & 3) * 128 + wc * 32 + 8 * fq;
#pragma unroll
        for (int ai = 0; ai < 2; ++ai)
#pragma unroll
            for (int m = 0; m < 4; ++m) { f32x4 h[2];
#pragma unroll
                for (int n = 0; n < 2; ++n)
#pragma unroll
                    for (int e = 0; e < 4; ++e) { const float a = acc[ai][0][m][n][e], b = acc[ai][1][m][n][e]; h[n][e] = a * __builtin_amdgcn_rcpf(1.0f + __expf(-a)) * b; }
                *(u32x4*)(HM + (size_t)(row0 + ai * HALF + m * 16) * DEXP + col0) = pack8(h[0], h[1]); }
    }
};
struct EpiMoe2 {
    static constexpr bool PERM = true, AFTER_DRAIN = false;
    bf16_t* Y; const float* rowgate;
    __device__ __forceinline__ void operator()(const f32x4 (&acc)[2][2][4][2], const Unit& u, int wr, int wc, int fr, int fq) const {
        const int row0 = u.pm * BM + wr * 64 + fr, col0 = (u.pn & 7) * 256 + wc * 32 + 8 * fq;
#pragma unroll
        for (int ai = 0; ai < 2; ++ai)
#pragma unroll
            for (int m = 0; m < 4; ++m) { const int row = row0 + ai * HALF + m * 16; const float gt = rowgate[row];
#pragma unroll
                for (int bj = 0; bj < 2; ++bj) *(u32x4*)(Y + (size_t)row * DM + col0 + bj * HALF) = pack8(acc[ai][bj][m][0] * gt, acc[ai][bj][m][1] * gt); }
    }
};
struct MoeOrder {
    const PG8_LAS int* tile_e; int ntiles, NJ, G, c;
    __device__ __forceinline__ bool next(int i, Unit& u) const { const int L = i * G + c; if (L >= ntiles * NJ) return false; const int rt = L / NJ, j = L - rt * NJ; u.pm = rt; u.pn = tile_e[rt] * NJ + j; return true; }
    __device__ __forceinline__ void a_ready(const Unit&) const {}
    __device__ __forceinline__ void done(const Unit&) const {}
};

template <class Epi, class Sched, bool ALIGN_EPI = false, bool SP2 = false>
__device__ __forceinline__ void gemm_phase(PG8_LAS unsigned char* lds, const Gemm g, const Sched& S, const Epi& E) {
    const int tid = threadIdx.x, wid = __builtin_amdgcn_readfirstlane(tid >> 6), lane = tid & 63, wr = wid >> 2, wc = wid & 3, fr = lane & 15, fq = lane >> 4;
    const int K = g.K, nt = K / BK;
    unsigned voffA[2], voffB[2];
#pragma unroll
    for (int i = 0; i < 2; ++i) { int R, C; stage_rc(tid * 16 + i * 8192, R, C); const int Rb = Epi::PERM ? ((R & ~31) + perm32(R & 31)) : R;
        voffA[i] = (unsigned)(R * g.lda + C) * 2u; voffB[i] = (unsigned)(Rb * K + C) * 2u; }
    const size_t kstep = (size_t)(BK * 2);
    const size_t hstepA = (size_t)HALF * g.lda * 2, hstepB = (size_t)HALF * K * 2;
    const size_t tstepA = 2 * hstepA, tstepB = 2 * hstepB;
    const unsigned ldsw = (unsigned)wid * 1024u;
    const int aoff = lds_byte(wr * 64 + fr, fq * 8), boff = lds_byte(wc * 32 + fr, fq * 8);
#define PG8_SA(b, h) (((b) * 2 + (h)) * HTB)
#define PG8_SB(b, h) ((4 + (b) * 2 + (h)) * HTB)
#define PG8_STAGE(bufoff, gbase, voff) do { _Pragma("unroll") for (int _i = 0; _i < 2; ++_i) \
        __builtin_amdgcn_global_load_lds((const unsigned*)((const char*)(gbase) + (voff)[_i]), (PG8_LAS unsigned*)(lds + (bufoff) + ldsw + _i * 8192), 16, 0, 0); } while (0)
#define PG8_LDA(dst, b, h) do { _Pragma("unroll") for (int m = 0; m < 4; ++m) _Pragma("unroll") for (int k = 0; k < 2; ++k) dst[m][k] = *(const PG8_LAS bf16x8*)(lds + PG8_SA(b, h) + aoff + m * 2048 + k * 1024); } while (0)
#define PG8_LDB(dst, b, h) do { _Pragma("unroll") for (int n = 0; n < 2; ++n) _Pragma("unroll") for (int k = 0; k < 2; ++k) dst[n][k] = *(const PG8_LAS bf16x8*)(lds + PG8_SB(b, h) + boff + n * 2048 + k * 1024); } while (0)
#define PG8_MMA(ai, bj, At, Bt) do { __builtin_amdgcn_s_setprio(1); _Pragma("unroll") for (int m = 0; m < 4; ++m) _Pragma("unroll") for (int n = 0; n < 2; ++n) _Pragma("unroll") for (int k = 0; k < 2; ++k) \
        acc[ai][bj][m][n] = __builtin_amdgcn_mfma_f32_16x16x32_bf16(Bt[n][k], At[m][k], acc[ai][bj][m][n], 0, 0, 0); __builtin_amdgcn_s_setprio(0); } while (0)
#define PG8_WAIT_V(n) asm volatile("s_waitcnt vmcnt(" #n ")" ::: "memory")
#define PG8_WAIT_L(n) asm volatile("s_waitcnt lgkmcnt(" #n ")" ::: "memory")
#define PG8_BAR __builtin_amdgcn_s_barrier()
#define PG8_SCHED __builtin_amdgcn_sched_barrier(0)
    Unit cur, nxt; int ui = 0;
    if (!S.next(0, cur)) return;
    f32x4 acc[2][2][4][2];
#pragma unroll
    for (int a = 0; a < 2; ++a)
#pragma unroll
        for (int b = 0; b < 2; ++b)
#pragma unroll
            for (int m = 0; m < 4; ++m)
#pragma unroll
                for (int n = 0; n < 2; ++n) acc[a][b][m][n] = (f32x4){0.f, 0.f, 0.f, 0.f};
    bf16x8 At[4][2], B0[2][2], B1[2][2];
    const char* cA = (const char*)g.A + (size_t)cur.pm * tstepA; const char* cB = (const char*)g.Bt + (size_t)cur.pn * tstepB;
    S.a_ready(cur);
    if constexpr (SP2) {
        PG8_STAGE(PG8_SB(0, 0), cB, voffB); PG8_STAGE(PG8_SB(0, 1), cB + hstepB, voffB); PG8_STAGE(PG8_SA(0, 0), cA, voffA); PG8_STAGE(PG8_SA(0, 1), cA + hstepA, voffA);
        if (wr == 1) PG8_BAR;
        PG8_WAIT_V(2); PG8_BAR;
        PG8_STAGE(PG8_SB(1, 0), cB + kstep, voffB); PG8_STAGE(PG8_SA(1, 0), cA + kstep, voffA); PG8_STAGE(PG8_SB(1, 1), cB + hstepB + kstep, voffB);
        PG8_WAIT_V(6); PG8_BAR;
    } else {
        PG8_STAGE(PG8_SB(0, 0), cB, voffB); PG8_STAGE(PG8_SA(0, 0), cA, voffA); PG8_STAGE(PG8_SB(0, 1), cB + hstepB, voffB); PG8_STAGE(PG8_SA(0, 1), cA + hstepA, voffA);
        if (wr == 1) PG8_BAR;
        PG8_WAIT_V(4); PG8_BAR;
        PG8_STAGE(PG8_SB(1, 0), cB + kstep, voffB); PG8_STAGE(PG8_SA(1, 0), cA + kstep, voffA); PG8_STAGE(PG8_SB(1, 1), cB + hstepB + kstep, voffB);
        PG8_WAIT_V(6); PG8_BAR;
    }
    for (;;) {
        const bool has_next = S.next(ui + 1, nxt);
        const char* nA = has_next ? (const char*)g.A + (size_t)nxt.pm * tstepA : cA; const char* nB = has_next ? (const char*)g.Bt + (size_t)nxt.pn * tstepB : cB;
        for (int t = 0; t < nt; t += 2) {
            const bool last = (t == nt - 2);
            const char* a1 = cA + (size_t)(t + 1) * kstep;
            const char* a2 = last ? nA : cA + (size_t)(t + 2) * kstep; const char* b2 = last ? nB : cB + (size_t)(t + 2) * kstep;
            const char* a3 = a2 + kstep; const char* b3 = b2 + kstep;
            if (last && has_next) S.a_ready(nxt);
            if constexpr (SP2) {
            PG8_LDB(B0, 0, 0); PG8_LDB(B1, 0, 1); PG8_SCHED; PG8_LDA(At, 0, 0); PG8_STAGE(PG8_SA(1, 1), a1 + hstepA, voffA);
            PG8_WAIT_V(8); PG8_WAIT_L(0); PG8_BAR; PG8_MMA(0, 0, At, B0); PG8_MMA(0, 1, At, B1); PG8_BAR; PG8_SCHED;
            PG8_LDA(At, 0, 1); PG8_STAGE(PG8_SB(0, 0), b2, voffB); PG8_STAGE(PG8_SB(0, 1), b2 + hstepB, voffB); PG8_STAGE(PG8_SA(0, 0), a2, voffA);
            PG8_WAIT_V(8); PG8_WAIT_L(0); PG8_BAR; PG8_MMA(1, 0, At, B0); PG8_MMA(1, 1, At, B1); PG8_BAR; PG8_SCHED;
            PG8_LDB(B0, 1, 0); PG8_LDB(B1, 1, 1); PG8_SCHED; PG8_LDA(At, 1, 0); PG8_STAGE(PG8_SA(0, 1), a2 + hstepA, voffA);
            PG8_WAIT_V(8); PG8_WAIT_L(0); PG8_BAR; PG8_MMA(0, 0, At, B0); PG8_MMA(0, 1, At, B1); PG8_BAR; PG8_SCHED;
            PG8_LDA(At, 1, 1); PG8_STAGE(PG8_SB(1, 0), b3, voffB); PG8_STAGE(PG8_SB(1, 1), b3 + hstepB, voffB); PG8_STAGE(PG8_SA(1, 0), a3, voffA);
            PG8_WAIT_V(8); PG8_WAIT_L(0); PG8_BAR; PG8_MMA(1, 0, At, B0); PG8_MMA(1, 1, At, B1); PG8_BAR; PG8_SCHED;
            } else {
            PG8_LDB(B0, 0, 0); PG8_SCHED; PG8_LDA(At, 0, 0); PG8_STAGE(PG8_SA(1, 1), a1 + hstepA, voffA);
            PG8_WAIT_L(8); PG8_BAR; PG8_WAIT_L(0); PG8_MMA(0, 0, At, B0); PG8_BAR; PG8_SCHED;
            PG8_LDB(B1, 0, 1); PG8_STAGE(PG8_SB(0, 0), b2, voffB);
            PG8_BAR; PG8_WAIT_L(0); PG8_MMA(0, 1, At, B1); PG8_BAR;
            PG8_LDA(At, 0, 1); PG8_STAGE(PG8_SA(0, 0), a2, voffA);
            PG8_BAR; PG8_WAIT_L(0); PG8_MMA(1, 0, At, B0); PG8_BAR; PG8_SCHED;
            PG8_STAGE(PG8_SB(0, 1), b2 + hstepB, voffB);
            PG8_WAIT_V(6); PG8_BAR; PG8_MMA(1, 1, At, B1); PG8_BAR;
            PG8_LDB(B0, 1, 0); PG8_SCHED; PG8_LDA(At, 1, 0); PG8_STAGE(PG8_SA(0, 1), a2 + hstepA, voffA);
            PG8_WAIT_L(8); PG8_BAR; PG8_WAIT_L(0); PG8_MMA(0, 0, At, B0); PG8_BAR; PG8_SCHED;
            PG8_LDB(B1, 1, 1); PG8_STAGE(PG8_SB(1, 0), b3, voffB);
            PG8_BAR; PG8_WAIT_L(0); PG8_MMA(0, 1, At, B1); PG8_BAR;
            PG8_LDA(At, 1, 1); PG8_STAGE(PG8_SA(1, 0), a3, voffA);
            PG8_BAR; PG8_WAIT_L(0); PG8_MMA(1, 0, At, B0); PG8_BAR; PG8_SCHED;
            PG8_STAGE(PG8_SB(1, 1), b3 + hstepB, voffB);
            PG8_WAIT_V(6); PG8_BAR; PG8_MMA(1, 1, At, B1); PG8_BAR;
            }
        }
        if constexpr (ALIGN_EPI) { if (wr == 0) PG8_BAR; }
        if constexpr (!Epi::AFTER_DRAIN) { E(acc, cur, wr, wc, fr, fq); S.done(cur); }
        if (!has_next) break;
#pragma unroll
        for (int a = 0; a < 2; ++a)
#pragma unroll
            for (int b = 0; b < 2; ++b)
#pragma unroll
                for (int m = 0; m < 4; ++m)
#pragma unroll
                    for (int n = 0; n < 2; ++n) acc[a][b][m][n] = (f32x4){0.f, 0.f, 0.f, 0.f};
        cur = nxt; cA = nA; cB = nB; ++ui;
        if constexpr (ALIGN_EPI) { if (wr == 1) PG8_BAR; }
    }
    PG8_WAIT_V(0);
    if constexpr (!ALIGN_EPI) { if (wr == 0) PG8_BAR; }
    PG8_BAR;
    if constexpr (Epi::AFTER_DRAIN) { E.fused(acc, cur, wr, wc, fr, fq, lds, wid, lane); S.done(cur); }
#undef PG8_SA
#undef PG8_SB
#undef PG8_STAGE
#undef PG8_LDA
#undef PG8_LDB
#undef PG8_MMA
#undef PG8_WAIT_V
#undef PG8_WAIT_L
#undef PG8_BAR
#undef PG8_SCHED
}
}

namespace att {
using bf16x8 = __attribute__((ext_vector_type(8))) short;
using u32x4 = __attribute__((ext_vector_type(4))) unsigned;
constexpr int D = 128, DR = 64, NW = 8, QBLK = 32, KVBLK = 64;
constexpr float SCALE = 0.07216878364870322f;
constexpr float THR = 8.f;
#ifndef ATT_SDEPTH
#define ATT_SDEPTH 1
#endif
#ifndef ATT_QROPE_LDS
#define ATT_QROPE_LDS 1
#endif
constexpr int SDEPTH = ATT_SDEPTH; constexpr bool QROPE_LDS = ATT_QROPE_LDS;
constexpr int LDQ = 1536, LDK = 128, LDR = 64, LDO = 2048;
constexpr int SHM_V = KVBLK * D * 2, SHM_K = KVBLK * D * 2, SHM_R = KVBLK * DR * 2;
constexpr int OFF_V = 0, OFF_K = 2 * SHM_V, OFF_R = OFF_K + 2 * SHM_K, OFF_WS = OFF_R + 2 * SHM_R, OFF_QR = OFF_WS + NW * 64 * 4, SHM_ATTN = OFF_QR + 256 * DR * 2;
#define KSWZ(row, colB) ((row) * 256 + ((colB) ^ (((row) & 7) << 4)))
#define RSWZ(row, colB) ((row) * 128 + ((colB) ^ ((((row) >> 1) & 7) << 4)))
#define SBAR() __builtin_amdgcn_sched_barrier(0)
__device__ __forceinline__ int crow(int r, int hi) { return (r & 3) + 8 * (r >> 2) + 4 * hi; }
__device__ __forceinline__ unsigned cvtpk(float lo, float hi) { unsigned r; asm volatile("v_cvt_pk_bf16_f32 %0, %1, %2" : "=v"(r) : "v"(lo), "v"(hi)); return r; }
__device__ __forceinline__ void partialSM(f32x16& p0, f32x16& p1, float& m_reg, float& mn, float& alpha) {
  constexpr float C = SCALE * 1.4426950408889634f;
  float pmax = p0[0]; for (int r = 1; r < 16; ++r) pmax = fmaxf(pmax, p0[r]); for (int r = 0; r < 16; ++r) pmax = fmaxf(pmax, p1[r]);
  { auto rr = __builtin_amdgcn_permlane32_swap(__float_as_uint(pmax), __float_as_uint(pmax), false, false);
    pmax = fmaxf(__uint_as_float(rr[0]), __uint_as_float(rr[1])); }
  if (__builtin_expect(__all(pmax - m_reg <= THR / SCALE), 1)) { mn = m_reg; alpha = 1.f; }
  else { mn = fmaxf(m_reg, pmax); alpha = __builtin_amdgcn_exp2f((m_reg - mn) * C); m_reg = mn; }
  float mnC = -mn * C;
  for (int r = 0; r < 16; ++r) p0[r] = fmaf(p0[r], C, mnC); for (int r = 0; r < 16; ++r) p1[r] = fmaf(p1[r], C, mnC);
  for (int r = 0; r < 16; ++r) p0[r] = __builtin_amdgcn_exp2f(p0[r]);
}
__device__ __forceinline__ void finishSM(f32x16& p0, f32x16& p1, float alpha, float& l_reg, bf16x8& pa0, bf16x8& pa1, bf16x8& pa2, bf16x8& pa3) {
  for (int r = 0; r < 16; ++r) p1[r] = __builtin_amdgcn_exp2f(p1[r]);
  float ps = 0; for (int r = 0; r < 16; ++r) ps += p0[r]; for (int r = 0; r < 16; ++r) ps += p1[r];
  { auto rr = __builtin_amdgcn_permlane32_swap(__float_as_uint(ps), __float_as_uint(ps), false, false);
    ps = __uint_as_float(rr[0]) + __uint_as_float(rr[1]); }
  l_reg = l_reg * alpha + ps;
#define PK4(P, BASE, OUT) do { unsigned a0 = cvtpk(P[BASE + 0], P[BASE + 1]), a1 = cvtpk(P[BASE + 2], P[BASE + 3]);   \
    unsigned b0 = cvtpk(P[BASE + 4], P[BASE + 5]), b1 = cvtpk(P[BASE + 6], P[BASE + 7]);                              \
    auto r0 = __builtin_amdgcn_permlane32_swap(a0, b0, false, false); auto r1 = __builtin_amdgcn_permlane32_swap(a1, b1, false, false); \
    u32x4 w = {r0[0], r1[0], r0[1], r1[1]}; OUT = *reinterpret_cast<bf16x8*>(&w); } while (0)
  PK4(p0, 0, pa0); PK4(p0, 8, pa1); PK4(p1, 0, pa2); PK4(p1, 8, pa3);
#undef PK4
}
__device__ __forceinline__ void qkt(f32x16& p0, f32x16& p1, const char* Ks, const char* Rs, const bf16x8* qr, int r32, int hi, const char* Qrs) {
  p0 = f32x16{}; p1 = f32x16{};
#pragma unroll
  for (int d0 = 0; d0 < 8; ++d0) { int cb = (d0 * 16 + hi * 8) * 2;
    bf16x8 b0 = *reinterpret_cast<const bf16x8*>(Ks + KSWZ(r32, cb));
    bf16x8 b1 = *reinterpret_cast<const bf16x8*>(Ks + KSWZ(32 + r32, cb));
    p0 = __builtin_amdgcn_mfma_f32_32x32x16_bf16(b0, qr[d0], p0, 0, 0, 0);
    p1 = __builtin_amdgcn_mfma_f32_32x32x16_bf16(b1, qr[d0], p1, 0, 0, 0);
#ifdef ATT_QK_SBAR
    if (d0 == 3 || d0 == 7) SBAR();
#endif
  }
#pragma unroll
  for (int d0 = 0; d0 < 4; ++d0) { int cb = (d0 * 16 + hi * 8) * 2;
    bf16x8 b0 = *reinterpret_cast<const bf16x8*>(Rs + d0 * 2048 + r32 * 32 + hi * 16);
    bf16x8 b1 = *reinterpret_cast<const bf16x8*>(Rs + d0 * 2048 + 1024 + r32 * 32 + hi * 16);
    bf16x8 qf; if constexpr (QROPE_LDS) qf = *reinterpret_cast<const bf16x8*>(Qrs + d0 * 8192); else qf = qr[8 + d0];
    p0 = __builtin_amdgcn_mfma_f32_32x32x16_bf16(b0, qf, p0, 0, 0, 0);
    p1 = __builtin_amdgcn_mfma_f32_32x32x16_bf16(b1, qf, p1, 0, 0, 0); }
}
__device__ __forceinline__ int v_st(int k, int c) { const int kk = (k & ~0xC) | ((k & 4) << 1) | ((k & 8) >> 1); return ((kk >> 3) * 4 + (c >> 5)) * 512 + ((kk & 7) * 32 + (c & 31)) * 2; }
__device__ __forceinline__ int v_rd_base(int lane) { return ((lane & 3) << 3) | (((lane >> 2) & 3) << 6) | (((lane >> 4) & 1) << 5) | (((lane >> 5) & 1) << 8); }
constexpr int v_rd_off(int d0, int ks, int half) { return d0 * 512 + ks * 4096 + half * 2048; }
template <int OFF> __device__ __forceinline__ s16x4 tr_read(int vb) {
  s16x4 r; asm volatile("ds_read_b64_tr_b16 %0, %1 offset:%2" : "=&v"(r) : "v"(vb), "i"(OFF) : "memory"); return r;
}
template <int D0> __device__ __forceinline__ void pv_one(f32x16& od, int vb, bf16x8 pa0, bf16x8 pa1, bf16x8 pa2, bf16x8 pa3) {
  const s16x4 l0 = tr_read<v_rd_off(D0, 0, 0)>(vb), h0 = tr_read<v_rd_off(D0, 0, 1)>(vb), l1 = tr_read<v_rd_off(D0, 1, 0)>(vb), h1 = tr_read<v_rd_off(D0, 1, 1)>(vb);
  const s16x4 l2 = tr_read<v_rd_off(D0, 2, 0)>(vb), h2 = tr_read<v_rd_off(D0, 2, 1)>(vb), l3 = tr_read<v_rd_off(D0, 3, 0)>(vb), h3 = tr_read<v_rd_off(D0, 3, 1)>(vb);
  asm volatile("s_waitcnt lgkmcnt(0)" ::: "memory"); SBAR();
#define PK(L, H) (bf16x8){L[0], L[1], L[2], L[3], H[0], H[1], H[2], H[3]}
  od = __builtin_amdgcn_mfma_f32_32x32x16_bf16(pa0, PK(l0, h0), od, 0, 0, 0);
  od = __builtin_amdgcn_mfma_f32_32x32x16_bf16(pa1, PK(l1, h1), od, 0, 0, 0);
  od = __builtin_amdgcn_mfma_f32_32x32x16_bf16(pa2, PK(l2, h2), od, 0, 0, 0);
  od = __builtin_amdgcn_mfma_f32_32x32x16_bf16(pa3, PK(l3, h3), od, 0, 0, 0);
#undef PK
}
__device__ __forceinline__ void pv_d0(f32x16* o, int vb, bf16x8 pa0, bf16x8 pa1, bf16x8 pa2, bf16x8 pa3) {
  pv_one<0>(o[0], vb, pa0, pa1, pa2, pa3); pv_one<1>(o[1], vb, pa0, pa1, pa2, pa3); pv_one<2>(o[2], vb, pa0, pa1, pa2, pa3); pv_one<3>(o[3], vb, pa0, pa1, pa2, pa3);
}
__device__ __forceinline__ void attn_dense_body(const bf16* __restrict__ Qb, const bf16* __restrict__ Kh, const bf16* __restrict__ Vh, const bf16* __restrict__ Rh,
                                                bf16* __restrict__ Ob, int seq, char* lds) {
  const int tid = threadIdx.x, wid = tid >> 6, lane = tid & 63, r32 = lane & 31, hi = lane >> 5;
  char* V_lds = lds + OFF_V; char* K_lds = lds + OFF_K; char* R_lds = lds + OFF_R;
  float* ws = (float*)(lds + OFF_WS) + wid * 64; float* li_l = ws; float* al_l = ws + 32;
  float m_reg = -1e30f, l_reg = 0; f32x16 o[4] = {}; bf16x8 qr[QROPE_LDS ? 8 : 12];
  int tq_ = threadIdx.x; asm volatile("" : "+v"(tq_));
  const bf16* Qw = (const bf16*)((const char*)Qb + (unsigned)((((tq_ >> 6) * QBLK + (tq_ & 31)) * LDQ + ((tq_ >> 5) & 1) * 8) * 2));
  const char* Qrs = lds + OFF_QR + (wid * QBLK + r32) * 32 + hi * 16;
#pragma unroll
  for (int d0 = 0; d0 < (QROPE_LDS ? 8 : 12); ++d0) qr[d0] = *reinterpret_cast<const bf16x8*>(Qw + d0 * 16);
  if constexpr (QROPE_LDS) {
#pragma unroll
    for (int d0 = 0; d0 < 4; ++d0) { const bf16x8 t = *reinterpret_cast<const bf16x8*>(Qw + 128 + d0 * 16); *(bf16x8*)(lds + OFF_QR + d0 * 8192 + (wid * QBLK + r32) * 32 + hi * 16) = t; }
    asm volatile("s_waitcnt lgkmcnt(0)" ::: "memory");
  }
  const int sr = tid >> 4, sc = (tid & 15) * 8, vst0 = v_st(sr, sc), vst1 = v_st(32 + sr, sc);
  const int rr_ = tid >> 3, rc_ = (tid & 7) * 8, rst_ = (rc_ >> 4) * 2048 + rr_ * 32 + (rc_ & 8) * 2;
  const int vb0 = (int)(uintptr_t)(V_lds) + v_rd_base(lane);
  struct { bf16x8 vs0, vs1, ks0, ks1, rs0; } sr_[SDEPTH];
  const unsigned kvo_ = (unsigned)((sr * LDK + sc) * 2), ro_ = (unsigned)((rr_ * LDR + rc_) * 2);
#define SLOAD(i, k0) do { const char* vb_ = (const char*)Vh + (size_t)(k0) * (LDK * 2); const char* kb_ = (const char*)Kh + (size_t)(k0) * (LDK * 2); const char* rb_ = (const char*)Rh + (size_t)(k0) * (LDR * 2); \
    sr_[i].vs0 = *(const bf16x8*)(vb_ + kvo_); sr_[i].vs1 = *(const bf16x8*)(vb_ + 32 * LDK * 2 + kvo_); \
    sr_[i].ks0 = *(const bf16x8*)(kb_ + kvo_); sr_[i].ks1 = *(const bf16x8*)(kb_ + 32 * LDK * 2 + kvo_); \
    sr_[i].rs0 = *(const bf16x8*)(rb_ + ro_); } while (0)
#define SWRITE(b, i) do { *(bf16x8*)(V_lds + (b) * SHM_V + vst0) = sr_[i].vs0;          \
    *(bf16x8*)(V_lds + (b) * SHM_V + vst1) = sr_[i].vs1; int kc = sc * 2;               \
    *(bf16x8*)(K_lds + (b) * SHM_K + KSWZ(sr, kc)) = sr_[i].ks0;                       \
    *(bf16x8*)(K_lds + (b) * SHM_K + KSWZ(32 + sr, kc)) = sr_[i].ks1;                  \
    *(bf16x8*)(R_lds + (b) * SHM_R + rst_) = sr_[i].rs0; } while (0)
#define SWAIT() do { if constexpr (SDEPTH == 2) asm volatile("s_waitcnt vmcnt(5)" ::: "memory"); else asm volatile("s_waitcnt vmcnt(0)" ::: "memory"); } while (0)
#define RESC(a) do { if (__any((a) < 1.f)) { if (hi == 0) al_l[r32] = (a); asm volatile("s_waitcnt lgkmcnt(0)" ::: "memory"); \
    for (int d = 0; d < 4; ++d) for (int r = 0; r < 16; ++r) o[d][r] *= al_l[crow(r, hi)]; } } while (0)
  f32x16 pA0, pA1, pB0, pB1; float mnA, mnB, alA, alB; bf16x8 pa0, pa1, pa2, pa3; const int NT = seq / KVBLK;
  constexpr int SE = 0, SO = SDEPTH - 1;
  SLOAD(SE, 0); asm volatile("s_waitcnt vmcnt(0)" ::: "memory"); SWRITE(0, SE); __syncthreads();
  qkt(pA0, pA1, K_lds, R_lds, qr, r32, hi, Qrs); partialSM(pA0, pA1, m_reg, mnA, alA);
  SLOAD(SO, KVBLK); if constexpr (SDEPTH == 2) { if (2 < NT) SLOAD(SE, 2 * KVBLK); }
  SWAIT(); SWRITE(1, SO); __syncthreads();
  for (int j = 1; j + 1 < NT; j += 2) {
    SBAR(); qkt(pB0, pB1, K_lds + SHM_K, R_lds + SHM_R, qr, r32, hi, Qrs);
    finishSM(pA0, pA1, alA, l_reg, pa0, pa1, pa2, pa3); SBAR();
    SLOAD(SO, (j + SDEPTH) * KVBLK); SBAR();
    pv_d0(o, vb0, pa0, pa1, pa2, pa3); partialSM(pB0, pB1, m_reg, mnB, alB);
    __syncthreads(); SWAIT(); SWRITE(0, SE);
    RESC(alB); __syncthreads();
    SBAR(); qkt(pA0, pA1, K_lds, R_lds, qr, r32, hi, Qrs);
    finishSM(pB0, pB1, alB, l_reg, pa0, pa1, pa2, pa3); SBAR();
    if (SDEPTH == 1 || j + 3 < NT) SLOAD(SE, (j + 1 + SDEPTH) * KVBLK); SBAR();
    pv_d0(o, vb0 + SHM_V, pa0, pa1, pa2, pa3); partialSM(pA0, pA1, m_reg, mnA, alA);
    __syncthreads(); SWAIT(); SWRITE(1, SO);
    RESC(alA); __syncthreads();
  }
  SBAR(); qkt(pB0, pB1, K_lds + SHM_K, R_lds + SHM_R, qr, r32, hi, Qrs);
  finishSM(pA0, pA1, alA, l_reg, pa0, pa1, pa2, pa3); SBAR();
  pv_d0(o, vb0, pa0, pa1, pa2, pa3); partialSM(pB0, pB1, m_reg, mnB, alB);
  __syncthreads(); RESC(alB);
  finishSM(pB0, pB1, alB, l_reg, pa0, pa1, pa2, pa3); SBAR();
  pv_d0(o, vb0 + SHM_V, pa0, pa1, pa2, pa3);
  if (hi == 0) li_l[r32] = l_reg; asm volatile("s_waitcnt lgkmcnt(0)" ::: "memory");
  float rli[16];
#pragma unroll
  for (int r = 0; r < 16; ++r) rli[r] = __builtin_amdgcn_rcpf(li_l[crow(r, hi)]);
  int tl_ = threadIdx.x; asm volatile("" : "+v"(tl_));
  const unsigned oo_ = (unsigned)((((tl_ >> 6) * QBLK + 4 * ((tl_ >> 5) & 1)) * LDO + (tl_ & 31)) * 2);
#pragma unroll
  for (int r = 0; r < 16; ++r) { const char* ob_ = (const char*)Ob + (size_t)(((r & 3) + 8 * (r >> 2)) * LDO * 2);
#pragma unroll
    for (int d0 = 0; d0 < 4; ++d0) { const unsigned w = cvtpk(o[d0][r] * rli[r], 0.f); *(bf16*)(ob_ + d0 * 64 + oo_) = (bf16)(w & 0xffffu); } }
  __syncthreads();
#undef SLOAD
#undef SWRITE
#undef SWAIT
#undef RESC
}
}


constexpr int NWAVES = 8, NTHR = 512;
constexpr int N_PHASES = 14;
#ifndef MK_N_LAUNCHES
#define MK_N_LAUNCHES 1
#endif
constexpr int N_LAUNCHES = MK_N_LAUNCHES;

constexpr size_t MiB = 1u << 20;
constexpr size_t WS_CTL = 0, CTL_ZERO_BYTES = 1 * MiB;
constexpr size_t WS_MODP = 1 * MiB, WS_MODF = 4 * MiB, WS_RSS = 5 * MiB, WS_ROUTE = 6 * MiB, WS_BON = 7 * MiB, WS_WRT = 8 * MiB, WS_LORA = 9 * MiB;
constexpr size_t WS_WTUQ = 10 * MiB, WS_WTUKV = 12 * MiB, WS_WTOUT = 13 * MiB, WS_WTIN = 21 * MiB;
constexpr size_t WS_SCAN = 40 * MiB, SCAN_ARR = (size_t)NB * RH * NKEY * RN * 2;
constexpr int A_R = 0, A_KK = 1, A_W = 2, A_K = 4, A_B = 6, A_V = 8;
constexpr size_t WS_H = 40 * MiB;
constexpr size_t WS_G = 337 * MiB;
constexpr size_t WS_P = 369 * MiB;
constexpr size_t WS_Q = 510 * MiB, WS_KN = 558 * MiB, WS_V = 591 * MiB, WS_KR = 624 * MiB;
constexpr size_t WS_MIX = 369 * MiB;
constexpr size_t WS_MN = 433 * MiB;
constexpr size_t WS_YS = 40 * MiB;
constexpr size_t WS_W13T = 168 * MiB, WS_W2T = 565 * MiB;
constexpr size_t WS_H2 = 40 * MiB, WS_XG = 296 * MiB, WS_HM = 456 * MiB, WS_Y = 296 * MiB;
constexpr size_t WS_END = 629 * MiB;
constexpr int NCHUNK = NKEY / 64;
static_assert(WS_SCAN + 9 * SCAN_ARR <= WS_G && WS_G + (size_t)MROWS * RW * 2 <= WS_P && WS_P + (size_t)MALL * NINP * 2 <= WS_Q, "ws map 1");
static_assert(WS_Q + (size_t)MROWS * 1536 * 2 <= WS_KN && WS_KN + (size_t)NB * 8 * NKEY * 128 * 2 <= WS_V && WS_V + (size_t)NB * 8 * NKEY * 128 * 2 <= WS_KR && WS_KR + (size_t)NB * NKEY * 64 * 2 <= WS_END, "ws map 2");
static_assert(WS_MIX + (size_t)MROWS * DM * 2 <= WS_MN && WS_MN + (size_t)NB * RH * NCHUNK * 2 * 16384 <= WS_W2T && WS_W2T + (size_t)NEXP * DM * DEXP * 2 <= WS_END, "ws map 3");
static_assert(WS_YS + (size_t)2 * MROWS * RW * 4 <= WS_W13T && WS_W13T + (size_t)NEXP * 1024 * DM * 2 <= WS_XG && WS_W13T >= WS_SCAN && WS_XG <= WS_SCAN + 8 * SCAN_ARR, "ws map 4: Y and W13T overlay only the scan inputs that are dead after the chunk builder");
static_assert(WS_H2 + (size_t)MROWS * DM * 2 <= WS_W13T && WS_XG + (size_t)MAXTILES * 256 * DM * 2 <= WS_HM && WS_HM + (size_t)MAXTILES * 256 * DEXP * 2 <= WS_W2T, "ws map 5");
static_assert(WS_WTIN + (size_t)NINP * DM * 2 <= WS_SCAN && WS_H + (size_t)MALL * DM * 2 <= WS_G, "ws map 6");
constexpr int CW_CNT = 64;
constexpr int CW_BAR = 4096;
constexpr size_t RT_E = 0, RT_POS = 131072, RT_GATE = 262144, RT_ROW = 393216, RT_RGATE = 524288;

constexpr int RING_BYTES = 131072, MISC_OFF = 131072, EXTRA_OFF = 131584, LDS_BYTES = 155648;

#define LDS_WAIT() asm volatile("s_waitcnt lgkmcnt(0)" ::: "memory")
#define VM_WAIT() asm volatile("s_waitcnt vmcnt(0)" ::: "memory")
__device__ __forceinline__ unsigned f2bf(float f) { unsigned u = __builtin_bit_cast(unsigned, f); return (u + 0x7fffu + ((u >> 16) & 1u)) >> 16; }
__device__ __forceinline__ unsigned pk2(float lo, float hi) { return pg8::cvt_pk_bf16(lo, hi); }
__device__ __forceinline__ float bflo(unsigned w) { return __builtin_bit_cast(float, w << 16); }
__device__ __forceinline__ float bfhi(unsigned w) { return __builtin_bit_cast(float, w & 0xffff0000u); }
__device__ __forceinline__ float bf1(bf16 h) { return __builtin_bit_cast(float, (unsigned)h << 16); }
__device__ __forceinline__ void unpack8(const v4u w, float (&f)[8]) { f[0] = bflo(w.x); f[1] = bfhi(w.x); f[2] = bflo(w.y); f[3] = bfhi(w.y); f[4] = bflo(w.z); f[5] = bfhi(w.z); f[6] = bflo(w.w); f[7] = bfhi(w.w); }
__device__ __forceinline__ v4u pack8f(const float (&f)[8]) { v4u w; w.x = pk2(f[0], f[1]); w.y = pk2(f[2], f[3]); w.z = pk2(f[4], f[5]); w.w = pk2(f[6], f[7]); return w; }
__device__ __forceinline__ float wave_sum(float v) {
#pragma unroll
    for (int o = 1; o < 64; o <<= 1) v += __shfl_xor(v, o);
    return v;
}
__device__ __forceinline__ float sigmoidf_(float x) { return __builtin_amdgcn_rcpf(1.0f + __expf(-x)); }

#define XB_TMO      128
#define XB_XCNT(j)  (256  + 64 * (j))
#define XB_XSUB(j)  (1280 + 64 * (j))
#define XB_XGEN(j)  (2304 + 64 * (j))
#define XB_TOP      3328
#define XB_TOPGEN   3392
#define XCD_BAR_WORDS 3456
#define XB_SPIN_CAP (1u << 18)

__device__ __forceinline__ unsigned xb_ld(unsigned* p)              { return __hip_atomic_load(p, __ATOMIC_RELAXED, __HIP_MEMORY_SCOPE_AGENT); }
__device__ __forceinline__ unsigned xb_add(unsigned* p, unsigned v) { return __hip_atomic_fetch_add(p, v, __ATOMIC_RELAXED, __HIP_MEMORY_SCOPE_AGENT); }
__device__ __forceinline__ unsigned xb_xcc_id() { return (unsigned)__builtin_amdgcn_s_getreg((3 << 11) | 20) & 0xFu; }
#define XB_SPIN(cond, bar) do { unsigned _sp = 0; while (cond) { __builtin_amdgcn_s_sleep(1); \
    if ((++_sp & 255u) == 0u) { if (xb_ld(&(bar)[XB_TMO])) break; if (_sp > XB_SPIN_CAP) { atomicAdd(&(bar)[XB_TMO], 1u); break; } } } } while (0)

struct XcdBarrier {
    unsigned* bar; unsigned x;
    volatile LAS unsigned* st;
};

__device__ __forceinline__ XcdBarrier xcd_barrier_post(unsigned* bar, volatile LAS unsigned* st) {
    XcdBarrier b; b.bar = bar; b.x = xb_xcc_id(); b.st = st;
    if (threadIdx.x == 0) (void)xb_add(&bar[XB_XCNT(b.x)], 1u);
    return b;
}
__device__ __forceinline__ void xcd_barrier_complete(unsigned* bar, unsigned x, unsigned& nloc, unsigned& nx) {
    const unsigned G = gridDim.x * gridDim.y * gridDim.z;
    unsigned sum, cnt, mine, sp = 0u;
    for (;;) {
        sum = 0u; cnt = 0u; mine = 0u;
#pragma unroll
        for (unsigned j = 0; j < 16; ++j) { const unsigned c = xb_ld(&bar[XB_XCNT(j)]); sum += c; cnt += (c > 0u) ? 1u : 0u; mine = (j == x) ? c : mine; }
        if (sum == G) break;
        __builtin_amdgcn_s_sleep(1);
        if ((++sp & 255u) == 0u) { if (xb_ld(&bar[XB_TMO])) break; if (sp > XB_SPIN_CAP) { atomicAdd(&bar[XB_TMO], 1u); break; } }
    }
    nloc = mine > 0u ? mine : 1u; nx = cnt > 0u ? cnt : 1u;
}

__device__ __forceinline__ void xcd_barrier(const XcdBarrier& b) {
    asm volatile("s_waitcnt vmcnt(0)" ::: "memory");
    __syncthreads();
    if (threadIdx.x == 0) {
        unsigned* bar = b.bar;
        __builtin_amdgcn_s_waitcnt(0);
        unsigned nloc = b.st[0], nx = b.st[1];
        if (nloc == 0u) { xcd_barrier_complete(bar, b.x, nloc, nx); b.st[0] = nloc; b.st[1] = nx; }
        const unsigned old = xb_add(&bar[XB_XSUB(b.x)], 1u);
        const unsigned gen = old / nloc;
        if (old + 1u == (gen + 1u) * nloc) {
            __builtin_amdgcn_fence(__ATOMIC_RELEASE, "agent");
            asm volatile("s_waitcnt vmcnt(0)" ::: "memory");
            const unsigned og = xb_add(&bar[XB_TOP], 1u);
            const unsigned tg = og / nx;
            if (og + 1u == (tg + 1u) * nx) xb_add(&bar[XB_TOPGEN], 1u);
            else XB_SPIN(xb_ld(&bar[XB_TOPGEN]) == tg, bar);
            __builtin_amdgcn_fence(__ATOMIC_ACQUIRE, "agent");
            xb_add(&bar[XB_XGEN(b.x)], 1u);
            asm volatile("s_waitcnt vmcnt(0)" ::: "memory");
        } else {
            XB_SPIN(xb_ld(&bar[XB_XGEN(b.x)]) == gen, bar);
            __builtin_amdgcn_fence(__ATOMIC_ACQUIRE, "agent");
            asm volatile("s_waitcnt vmcnt(0)" ::: "memory");
        }
    }
    __syncthreads();
}

struct Frame {
    char* lds;
    volatile LAS unsigned* MISC;
    unsigned* ctl;
    unsigned char* ws;
    int tid, lane, wave, G, bid;
    const float* const __attribute__((address_space(4)))* in;
    float* out;
};

__device__ __forceinline__ void transpose_item(const float* W, int K, int N, bf16* WT, int row_off, const float* kscale, float* scr, int item, int lane) {
    const int nblk = N / 32, kb = item / nblk, nb = item % nblk, k0 = 64 * kb, n0 = 32 * nb;
#pragma unroll 8
    for (int i = 0; i < 32; ++i) { const int kk = 2 * i + (lane >> 5); float v = W[(size_t)(k0 + kk) * N + n0 + (lane & 31)]; if (kscale) v *= kscale[k0 + kk]; scr[kk * 33 + (lane & 31)] = v; }
    LDS_WAIT(); asm volatile("" ::: "memory");
    const int c = lane & 7;
#pragma unroll
    for (int j = 0; j < 4; ++j) { const int n = (lane >> 3) + 8 * j; const float* s = scr + (8 * c) * 33 + n;
        v4u o; o.x = pk2(s[0 * 33], s[1 * 33]); o.y = pk2(s[2 * 33], s[3 * 33]); o.z = pk2(s[4 * 33], s[5 * 33]); o.w = pk2(s[6 * 33], s[7 * 33]);
        *(v4u*)(WT + (size_t)(row_off + n0 + n) * K + k0 + 8 * c) = o; }
    LDS_WAIT(); asm volatile("" ::: "memory");
}

__device__ __forceinline__ void small_conversions(Frame& F, const int gt, const int NGT) {
    { bf16* wr = (bf16*)(F.ws + WS_WRT);
      for (int i = gt; i < 48 * DM; i += NGT) { const int n = i / DM, k = i - n * DM; float v = 0.f; if (n < 4) v = F.in[25][k * 4 + n]; else if (n < 36) v = F.in[27][k * 32 + (n - 4)]; wr[i] = (bf16)f2bf(v); } }
    { bf16* lw = (bf16*)(F.ws + WS_LORA);
      for (int i = gt; i < 2 * RW * 64; i += NGT) { const int d = i / (RW * 64), r = i - d * RW * 64, ch = r >> 6, k = r & 63;
          lw[i] = (bf16)f2bf(F.in[15][(size_t)(d * 64 + k) * RW + ch]); lw[2 * RW * 64 + i] = (bf16)f2bf(F.in[17][(size_t)(d * 64 + k) * RW + ch]); }
      for (int i = gt; i < RW * 160; i += NGT) { const int ch = i / 160, k = i - ch * 160; lw[4 * RW * 64 + i] = (bf16)f2bf(F.in[18][(size_t)k * RW + ch]); } }
}

__device__ __forceinline__ void phase0(Frame& F) {
    float* st = (float*)F.lds;
    for (int i = F.tid; i < 3 * DM; i += NTHR) { const int j = i / DM, k = i - j * DM; const float v = j < 2 ? F.in[1][j * DM + k] : F.in[3][k]; st[i] = v * sigmoidf_(v); }
    __syncthreads();
    const int gw = F.bid * NWAVES + F.wave, NGW = F.G * NWAVES;
    const float* wmod = F.in[4]; float* modp = (float*)(F.ws + WS_MODP);
    for (int it = gw; it < 768; it += NGW) {
        const int cc = it % 48, ks = it / 48, n0 = cc * 256 + F.lane * 4;
        pg8::f32x4 a0 = {0.f, 0.f, 0.f, 0.f}, a1 = a0, a2 = a0;
        const float* wp = wmod + (size_t)(ks * 128) * (6 * DM) + n0;
#pragma unroll 8
        for (int k = 0; k < 128; ++k) { const pg8::f32x4 w = *(const pg8::f32x4*)(wp + (size_t)k * (6 * DM)); const int kk = ks * 128 + k;
            a0 += w * st[kk]; a1 += w * st[DM + kk]; a2 += w * st[2 * DM + kk]; }
        *(pg8::f32x4*)(modp + (size_t)(ks * 3 + 0) * (6 * DM) + n0) = a0; *(pg8::f32x4*)(modp + (size_t)(ks * 3 + 1) * (6 * DM) + n0) = a1; *(pg8::f32x4*)(modp + (size_t)(ks * 3 + 2) * (6 * DM) + n0) = a2;
    }
    __syncthreads();
    float* scr = (float*)(F.lds + F.wave * 8448);
    constexpr int I_IN = (DM / 64) * (NIN / 32), I_UQ = (512 / 64) * (1536 / 32), I_UKV = (256 / 64) * (2048 / 32), I_OUT = (DM / 64) * (DM / 32);
    for (int it = gw; it < I_IN + I_UQ + I_UKV + I_OUT; it += NGW) {
        int r = it;
        if (r < I_IN) { transpose_item(F.in[8], DM, NIN, (bf16*)(F.ws + WS_WTIN), 0, nullptr, scr, r, F.lane); continue; } r -= I_IN;
        if (r < I_UQ) { transpose_item(F.in[11], 512, 1536, (bf16*)(F.ws + WS_WTUQ), 0, F.in[10], scr, r, F.lane); continue; } r -= I_UQ;
        if (r < I_UKV) { transpose_item(F.in[13], 256, 2048, (bf16*)(F.ws + WS_WTUKV), 0, F.in[12], scr, r, F.lane); continue; } r -= I_UKV;
        transpose_item(F.in[24], DM, DM, (bf16*)(F.ws + WS_WTOUT), 0, nullptr, scr, r, F.lane);
    }
    const int gt = F.bid * NTHR + F.tid, NGT = F.G * NTHR;
    { v4u* z = (v4u*)((bf16*)(F.ws + WS_WTIN) + (size_t)NIN * DM); const v4u zero = {0u, 0u, 0u, 0u};
      for (int i = gt; i < (NINP - NIN) * DM / 8; i += NGT) z[i] = zero; }
    small_conversions(F, gt, NGT);
}

__device__ __forceinline__ void phase1(Frame& F) {
    float* sft = (float*)F.lds; float* scl = sft + 3 * DM;
    const float* modp = (const float*)(F.ws + WS_MODP); const float* bmod = F.in[5]; const float* gat = F.in[6];
    for (int i = F.tid; i < 3 * 2 * DM; i += NTHR) { const int j = i / (2 * DM), n = i - j * 2 * DM; float s = bmod[n];
        for (int ks = 0; ks < 16; ++ks) s += modp[(size_t)(ks * 3 + j) * (6 * DM) + n];
        if (n < DM) sft[j * DM + n] = s; else scl[j * DM + n - DM] = gat[n - DM] * (1.0f + s); }
    if (F.bid < 144 && F.tid < 256) { const int j = F.bid / 48, n = (F.bid % 48) * 256 + F.tid; float s = bmod[n];
        for (int ks = 0; ks < 16; ++ks) s += modp[(size_t)(ks * 3 + j) * (6 * DM) + n];
        ((float*)(F.ws + WS_MODF))[j * 6 * DM + n] = s; }
    __syncthreads();
    const int gw = F.bid * NWAVES + F.wave, NGW = F.G * NWAVES;
    bf16* H = (bf16*)(F.ws + WS_H);
    for (int m = gw; m < MALL; m += NGW) {
        const int j = m < T ? 0 : (m < MROWS ? 1 : 2);
        const float* xr = m < MROWS ? F.in[0] + (size_t)m * DM : F.in[2] + (size_t)(m - MROWS) * DM;
        pg8::f32x4 v[8]; float s = 0.f;
#pragma unroll
        for (int q = 0; q < 8; ++q) { v[q] = *(const pg8::f32x4*)(xr + q * 256 + F.lane * 4); s += pg8::dot4(v[q]); }
        const float rstd = __builtin_amdgcn_rsqf(wave_sum(s) * (1.0f / DM) + 1e-6f);
#pragma unroll
        for (int q = 0; q < 8; ++q) { const int c = q * 256 + F.lane * 4; const pg8::f32x4 sc = *(const pg8::f32x4*)(scl + j * DM + c), sh = *(const pg8::f32x4*)(sft + j * DM + c);
            const pg8::f32x4 o = v[q] * rstd * sc + sh; v2u w; w.x = pk2(o[0], o[1]); w.y = pk2(o[2], o[3]); *(v2u*)(H + (size_t)m * DM + c) = w; }
    }
}

__device__ __forceinline__ void rwkv_prep_tile(Frame& F, int tile) {
    const bf16* P = (const bf16*)(F.ws + WS_P); const float* mu = F.in[9];
    const int m0 = tile * 64;
    const bool isctx = m0 >= MROWS; const int seqlen = isctx ? TC : T;
    const int b = isctx ? (m0 - MROWS) >> 8 : m0 >> 13, t0 = isctx ? (m0 - MROWS) & 255 : m0 & (T - 1), pos0 = isctx ? T + t0 : t0;
    bf16* XW = (bf16*)F.lds; bf16* XA = XW + 64 * 72; bf16* XGt = XA + 64 * 72; float* KS = (float*)(XGt + 64 * 168); float* KKS = KS + 64 * 64; float* KSUM = KKS + 64 * 64;
    for (int i = F.tid; i < 64 * 44; i += NTHR) {
        const int tk = i / 44, gq = i - tk * 44; const int t = t0 + tk; const size_t row = (size_t)(m0 + tk);
        if (gq < 36) {
            const int col = C_WL + gq * 8;
            float c[8], p[8], n[8], o[8];
            unpack8(*(const v4u*)(P + row * NINP + col), c);
            if (t > 0) unpack8(*(const v4u*)(P + (row - 1) * NINP + col), p); else { for (int e = 0; e < 8; ++e) p[e] = 0.f; }
            if (t < seqlen - 1) unpack8(*(const v4u*)(P + (row + 1) * NINP + col), n); else { for (int e = 0; e < 8; ++e) n[e] = 0.f; }
#pragma unroll
            for (int e = 0; e < 8; ++e) { const int rc = col - C_R + e; const float s = c[e] + mu[rc] * (p[e] - c[e]) + mu[3360 + rc] * (n[e] - c[e]);
                o[e] = gq < 8 ? 1.0f - 2.0f * __builtin_amdgcn_rcpf(1.0f + __expf(2.0f * s)) : (gq < 16 ? s : sigmoidf_(s)); }
            bf16* dst = gq < 8 ? XW + tk * 72 + gq * 8 : (gq < 16 ? XA + tk * 72 + (gq - 8) * 8 : XGt + tk * 168 + (gq - 16) * 8);
            *(v4u*)dst = pack8f(o);
        } else {
            const int g8 = gq - 36, half = g8 >> 2, j0 = (g8 & 3) * 8;
            float x[8], y[8], o[8];
            unpack8(*(const v4u*)(P + row * NINP + C_KR + half * 32 + j0), x);
            unpack8(*(const v4u*)(P + row * NINP + C_KR + half * 32 + (j0 ^ 16)), y);
            if (isctx) { for (int e = 0; e < 8; ++e) o[e] = x[e]; }
            else { const float pos = half == 0 ? (float)(t >> 6) : (float)(t & 63);
#pragma unroll
                for (int e = 0; e < 8; ++e) { const int jf = (j0 & 15) + e; float r = pos * (__builtin_amdgcn_exp2f(-(float)jf * 0.83048202372184059f) * 0.15915494309189535f); r = r - __builtin_floorf(r);
                    const float sn = __builtin_amdgcn_sinf(r), cs = __builtin_amdgcn_cosf(r);
                    o[e] = j0 < 16 ? x[e] * cs - y[e] * sn : y[e] * sn + x[e] * cs; } }
            *(v4u*)((bf16*)(F.ws + WS_KR) + ((size_t)b * NKEY + pos0 + tk) * 64 + half * 32 + j0) = pack8f(o);
        }
    }
    __syncthreads();
    const float* w0 = F.in[14]; const float* a0 = F.in[16]; const float* keyk = F.in[19]; const float* keya = F.in[20];
    const bf16* LW = (const bf16*)(F.ws + WS_LORA); const bf16* LA = LW + 2 * RW * 64; const bf16* LG = LW + 4 * RW * 64;
    const int fr = F.lane & 15, fq = F.lane >> 4;
    for (int h = 0; h < RH; ++h) {
        const size_t hb = ((size_t)(b * RH + h) * NKEY + pos0) * RN;
        float rs8[8];
        {
            const int tk = F.tid >> 3, c8 = (F.tid & 7) * 8; const int t = t0 + tk; const size_t row = (size_t)(m0 + tk);
            float sh[3][8];
#pragma unroll
            for (int a = 0; a < 3; ++a) { const int col = (a == 0 ? C_R : (a == 1 ? C_K : C_V)) + h * 64 + c8; float c[8], p[8], n[8];
                unpack8(*(const v4u*)(P + row * NINP + col), c);
                if (t > 0) unpack8(*(const v4u*)(P + (row - 1) * NINP + col), p); else { for (int e = 0; e < 8; ++e) p[e] = 0.f; }
                if (t < seqlen - 1) unpack8(*(const v4u*)(P + (row + 1) * NINP + col), n); else { for (int e = 0; e < 8; ++e) n[e] = 0.f; }
#pragma unroll
                for (int e = 0; e < 8; ++e) { const int rc = col - C_R + e; sh[a][e] = c[e] + mu[rc] * (p[e] - c[e]) + mu[3360 + rc] * (n[e] - c[e]); } }
            *(v4u*)((bf16*)(F.ws + WS_SCAN + A_R * SCAN_ARR) + hb + tk * 64 + c8) = pack8f(sh[0]);
            *(v4u*)((bf16*)(F.ws + WS_SCAN + A_V * SCAN_ARR) + hb + tk * 64 + c8) = pack8f(sh[2]);
#pragma unroll
            for (int e = 0; e < 8; ++e) rs8[e] = sh[0][e];
            float kk[8], ss = 0.f;
#pragma unroll
            for (int e = 0; e < 8; ++e) { kk[e] = sh[1][e] * keyk[h * 64 + c8 + e]; ss += kk[e] * kk[e]; }
            ss += __shfl_xor(ss, 1); ss += __shfl_xor(ss, 2); ss += __shfl_xor(ss, 4);
            const float rn = __builtin_amdgcn_rsqf(ss + 1e-12f);
#pragma unroll
            for (int e = 0; e < 8; ++e) { kk[e] *= rn; KS[tk * 64 + c8 + e] = sh[1][e]; KKS[tk * 64 + c8 + e] = kk[e]; }
            *(v4u*)((bf16*)(F.ws + WS_SCAN + A_KK * SCAN_ARR) + hb + tk * 64 + c8) = pack8f(kk);
        }
        __syncthreads();
        {
            const int tb = F.wave & 3, cbp = F.wave >> 2;
            pg8::bf16x8 xw[2], xa[2], xg[5];
#pragma unroll
            for (int kb = 0; kb < 2; ++kb) { xw[kb] = *(const pg8::bf16x8*)(XW + (tb * 16 + fr) * 72 + kb * 32 + fq * 8); xa[kb] = *(const pg8::bf16x8*)(XA + (tb * 16 + fr) * 72 + kb * 32 + fq * 8); }
#pragma unroll
            for (int kb = 0; kb < 5; ++kb) xg[kb] = *(const pg8::bf16x8*)(XGt + (tb * 16 + fr) * 168 + kb * 32 + fq * 8);
#pragma unroll
            for (int cbi = 0; cbi < 2; ++cbi) {
                const int cb = cbp * 2 + cbi, chl = cb * 16 + fr, chg = h * 64 + chl;
                pg8::f32x4 dw[2], da[2], dg = {0.f, 0.f, 0.f, 0.f};
#pragma unroll
                for (int d = 0; d < 2; ++d) { dw[d] = (pg8::f32x4){0.f, 0.f, 0.f, 0.f}; da[d] = dw[d];
#pragma unroll
                    for (int kb = 0; kb < 2; ++kb) {
                        const pg8::bf16x8 fw = *(const pg8::bf16x8*)(LW + ((size_t)(d * RW + chg)) * 64 + kb * 32 + fq * 8);
                        const pg8::bf16x8 fa = *(const pg8::bf16x8*)(LA + ((size_t)(d * RW + chg)) * 64 + kb * 32 + fq * 8);
                        dw[d] = __builtin_amdgcn_mfma_f32_16x16x32_bf16(fw, xw[kb], dw[d], 0, 0, 0);
                        da[d] = __builtin_amdgcn_mfma_f32_16x16x32_bf16(fa, xa[kb], da[d], 0, 0, 0); } }
#pragma unroll
                for (int kb = 0; kb < 5; ++kb) { const pg8::bf16x8 fg = *(const pg8::bf16x8*)(LG + (size_t)chg * 160 + kb * 32 + fq * 8); dg = __builtin_amdgcn_mfma_f32_16x16x32_bf16(fg, xg[kb], dg, 0, 0, 0); }
                asm volatile("s_nop 15\n\ts_nop 15" : "+v"(dw[0]), "+v"(dw[1]), "+v"(da[0]), "+v"(da[1]), "+v"(dg));
                const int tk = tb * 16 + fr, c4 = cb * 16 + 4 * fq, cg = h * 64 + c4;
                const pg8::f32x4 ks = *(const pg8::f32x4*)(KS + tk * 64 + c4), kk = *(const pg8::f32x4*)(KKS + tk * 64 + c4);
                const pg8::f32x4 ka = *(const pg8::f32x4*)(keya + cg);
                pg8::f32x4 ksum = {0.f, 0.f, 0.f, 0.f};
#pragma unroll
                for (int d = 0; d < 2; ++d) { const pg8::f32x4 w0v = *(const pg8::f32x4*)(w0 + d * RW + cg), a0v = *(const pg8::f32x4*)(a0 + d * RW + cg);
                    float dec[4], kd[4], bd[4];
#pragma unroll
                                        for (int j = 0; j < 4; ++j) { const float wr = w0v[j] + dw[d][j]; dec[j] = __expf(-0.60653065971263342f * sigmoidf_(wr));
                        const float eta = sigmoidf_(a0v[j] + da[d][j]); kd[j] = ks[j] * (1.0f + (eta - 1.0f) * ka[j]); bd[j] = kk[j] * eta; ksum[j] += kd[j]; }
                    v2u w; w.x = pk2(dec[0], dec[1]); w.y = pk2(dec[2], dec[3]); *(v2u*)((bf16*)(F.ws + WS_SCAN + (A_W + d) * SCAN_ARR) + hb + tk * 64 + c4) = w;
                    w.x = pk2(kd[0], kd[1]); w.y = pk2(kd[2], kd[3]); *(v2u*)((bf16*)(F.ws + WS_SCAN + (A_K + d) * SCAN_ARR) + hb + tk * 64 + c4) = w;
                    w.x = pk2(bd[0], bd[1]); w.y = pk2(bd[2], bd[3]); *(v2u*)((bf16*)(F.ws + WS_SCAN + (A_B + d) * SCAN_ARR) + hb + tk * 64 + c4) = w; }
                *(pg8::f32x4*)(KSUM + tk * 64 + c4) = ksum;
                if (!isctx) { v2u w; w.x = pk2(dg[0], dg[1]); w.y = pk2(dg[2], dg[3]); *(v2u*)((bf16*)(F.ws + WS_G) + ((size_t)(b * RH + h) * T + t0 + tk) * RN + c4) = w; }
            }
        }
        __syncthreads();
        if (!isctx) { const int tk = F.tid >> 3, c8 = (F.tid & 7) * 8; const float* rk = F.in[21] + h * 64 + c8; float bon = 0.f;
#pragma unroll
            for (int e = 0; e < 8; ++e) bon += rs8[e] * KSUM[tk * 64 + c8 + e] * rk[e];
            bon += __shfl_xor(bon, 1); bon += __shfl_xor(bon, 2); bon += __shfl_xor(bon, 4);
            if ((F.tid & 7) == 0) ((float*)(F.ws + WS_BON))[(size_t)(b * RH + h) * T + t0 + tk] = bon; }
        __syncthreads();
    }
}

constexpr int CB_AT = 0, CB_BT = 9216, CB_KT = 18432, CB_RT = 27648, CB_AC = 36864, CB_VC = 46080, CB_BHC = 55296, CB_KHC = 64512, CB_AAB = 73728  ,
              CB_AAK = 90112, CB_BRB = 99328, CB_BRK = 108544, CB_TT = 117760, CB_T1T = EXTRA_OFF + 1024  , CB_P1T = CB_T1T + 2560, CB_GC = CB_P1T + 2560  ;
constexpr int CB_W1T = CB_AT, CB_G1T = CB_BT, CB_W2T = CB_KT;
static_assert(CB_TT + 9216 <= RING_BYTES && CB_GC + 256 <= LDS_BYTES, "chunk builder LDS map");
#define MFMA_PAD1(a) asm volatile("s_nop 15\n\ts_nop 7" : "+v"(a))
__device__ __forceinline__ bf16 tobf(float x) { return (bf16)(pk2(x, x) & 0xffffu); }
__device__ __forceinline__ pg8::f32x4 mm64(const char* A, const char* B, int arow, int brow, int fq, pg8::f32x4 acc) {
#pragma unroll
    for (int kb = 0; kb < 2; ++kb) acc = __builtin_amdgcn_mfma_f32_16x16x32_bf16(*(const pg8::bf16x8*)(A + arow * 144 + kb * 64 + fq * 16), *(const pg8::bf16x8*)(B + brow * 144 + kb * 64 + fq * 16), acc, 0, 0, 0);
    return acc;
}
__device__ __forceinline__ void chunk_build_item(Frame& F, int it) {
    const int dir = it & 1, qq = it >> 1, cg = qq % NCHUNK, bh = qq / NCHUNK; const bool fwd = dir == 0;
    int lane_ = F.lane; asm volatile("" : "+v"(lane_));
    char* L = F.lds; const int lane = lane_, wave = F.wave, fr = lane & 15, fq = lane >> 4;
    const pg8::f32x4 zero4 = {0.f, 0.f, 0.f, 0.f};
#ifndef NO_S1
    {
        const int tau = lane, cw = wave * 8, nat = fwd ? tau : 63 - tau;
        const size_t off = ((size_t)bh * NKEY + cg * 64 + nat) * RN + cw;
        float r[8], kk[8], w[8], k[8], be[8], v[8], lw[8], lin[8];
        unpack8(*(const v4u*)((const bf16*)(F.ws + WS_SCAN + A_R * SCAN_ARR) + off), r); unpack8(*(const v4u*)((const bf16*)(F.ws + WS_SCAN + A_KK * SCAN_ARR) + off), kk);
        unpack8(*(const v4u*)((const bf16*)(F.ws + WS_SCAN + (A_W + dir) * SCAN_ARR) + off), w); unpack8(*(const v4u*)((const bf16*)(F.ws + WS_SCAN + (A_K + dir) * SCAN_ARR) + off), k);
        unpack8(*(const v4u*)((const bf16*)(F.ws + WS_SCAN + (A_B + dir) * SCAN_ARR) + off), be); unpack8(*(const v4u*)((const bf16*)(F.ws + WS_SCAN + A_V * SCAN_ARR) + off), v);
#pragma unroll
        for (int e = 0; e < 8; ++e) { lw[e] = __logf(w[e]); lin[e] = lw[e]; }
#pragma unroll
        for (int d = 1; d < 64; d <<= 1)
#pragma unroll
            for (int e = 0; e < 8; ++e) { const float t = __shfl_up(lin[e], d); if (lane >= d) lin[e] += t; }
        float at[8], bt[8], kt[8], rt[8], bhh[8], khh[8];
#pragma unroll
        for (int e = 0; e < 8; ++e) { const float gcl = __shfl(lin[e], 63); const float ea = __expf(lin[e] - lw[e]), ei = __expf(-lin[e]), eg = __expf(lin[e]), gr = __expf(gcl - lin[e]);
            at[e] = -kk[e] * ea; bt[e] = be[e] * ei; kt[e] = k[e] * ei; rt[e] = r[e] * eg; bhh[e] = be[e] * gr; khh[e] = k[e] * gr;
            if (lane == 63) ((float*)(L + CB_GC))[cw + e] = __expf(gcl); }
        *(v4u*)(L + CB_AT + tau * 144 + cw * 2) = pack8f(at); *(v4u*)(L + CB_BT + tau * 144 + cw * 2) = pack8f(bt);
        *(v4u*)(L + CB_KT + tau * 144 + cw * 2) = pack8f(kt); *(v4u*)(L + CB_RT + tau * 144 + cw * 2) = pack8f(rt);
#pragma unroll
        for (int e = 0; e < 8; ++e) { const int o = ((cw + e) * 72 + tau) * 2;
            *(bf16*)(L + CB_AC + o) = tobf(at[e]); *(bf16*)(L + CB_VC + o) = tobf(v[e]); *(bf16*)(L + CB_BHC + o) = tobf(bhh[e]); *(bf16*)(L + CB_KHC + o) = tobf(khh[e]); }
    }
#endif
    __syncthreads();
#ifndef NO_S2
    {
        const int m = wave >> 1, jh = wave & 1;
        const char* X = L + (m < 2 ? CB_AT : CB_RT); const char* Y = L + ((m & 1) ? CB_KT : CB_BT);
        char* dst = L + (m == 1 ? CB_AAK : (m == 2 ? CB_BRB : CB_BRK));
#pragma unroll
        for (int ib = 0; ib < 4; ++ib)
#pragma unroll
            for (int jj = 0; jj < 2; ++jj) { const int jb = 2 * jh + jj; pg8::f32x4 acc = zero4;
                if (ib >= jb) { acc = mm64(X, Y, ib * 16 + fr, jb * 16 + fr, fq, acc); MFMA_PAD1(acc); }
                const int j = jb * 16 + fr;
#pragma unroll
                for (int rr = 0; rr < 4; ++rr) { const int i = ib * 16 + 4 * fq + rr; const bool keep = m < 2 ? (i > j) : (i >= j); const float val = keep ? acc[rr] : 0.f;
                    if (m == 0) ((float*)(L + CB_AAB))[i * 64 + j] = val; else *(bf16*)(dst + (i * 72 + j) * 2) = tobf(val); } }
    }
#endif
    __syncthreads();
#ifndef NO_S3
    if (wave == 0) {
        const int blk = lane >> 5, n = lane & 31; const float* A = (const float*)(L + CB_AAB) + (blk * 32) * 64 + blk * 32;
        float* Tc = (float*)(L + CB_AT) + lane * 36;
#pragma unroll
        for (int j4 = 0; j4 < 8; ++j4) *(pg8::f32x4*)(Tc + 4 * j4) = zero4;
        for (int i = 0; i < 32; ++i) { float s = (i == n) ? 1.f : 0.f;
            for (int j4 = 0; j4 < i; j4 += 4) { const pg8::f32x4 a = *(const pg8::f32x4*)(A + i * 64 + j4), tv = *(const pg8::f32x4*)(Tc + j4); s += (a[0] * tv[0] + a[1] * tv[1]) + (a[2] * tv[2] + a[3] * tv[3]); }
            Tc[i] = s; }
        for (int j4 = 0; j4 < 8; ++j4) { const pg8::f32x4 tv = *(const pg8::f32x4*)(Tc + 4 * j4);
#pragma unroll
            for (int e = 0; e < 4; ++e) { const int j = 4 * j4 + e; *(bf16*)(L + CB_TT + ((blk * 32 + j) * 72 + blk * 32 + n) * 2) = tobf(tv[e]); if (blk == 0) *(bf16*)(L + CB_TT + (j * 72 + 32 + n) * 2) = (bf16)0; }
            if (blk == 0) { v2u w; w.x = pk2(tv[0], tv[1]); w.y = pk2(tv[2], tv[3]); *(v2u*)(L + CB_T1T + n * 80 + j4 * 8) = w; } }
        LDS_WAIT();
#ifndef NO_S3B
#pragma unroll
        for (int ib2 = 0; ib2 < 2; ++ib2)
#pragma unroll
            for (int nb = 0; nb < 2; ++nb) { const float* ar = (const float*)(L + CB_AAB) + (32 + ib2 * 16 + fr) * 64 + 8 * fq;
                const pg8::f32x4 a0 = *(const pg8::f32x4*)ar, a1 = *(const pg8::f32x4*)(ar + 4);
                const pg8::bf16x8 af = __builtin_bit_cast(pg8::bf16x8, pg8::pack8(a0, a1));
                pg8::f32x4 acc = __builtin_amdgcn_mfma_f32_16x16x32_bf16(af, *(const pg8::bf16x8*)(L + CB_T1T + (nb * 16 + fr) * 80 + fq * 16), zero4, 0, 0, 0); MFMA_PAD1(acc);
                v2u w; w.x = pk2(acc[0], acc[1]); w.y = pk2(acc[2], acc[3]); *(v2u*)(L + CB_P1T + (nb * 16 + fr) * 80 + (ib2 * 16 + 4 * fq) * 2) = w; }
        LDS_WAIT();
#pragma unroll
        for (int ib2 = 0; ib2 < 2; ++ib2)
#pragma unroll
            for (int nb = 0; nb < 2; ++nb) {
                pg8::f32x4 acc = __builtin_amdgcn_mfma_f32_16x16x32_bf16(*(const pg8::bf16x8*)(L + CB_TT + (32 + ib2 * 16 + fr) * 144 + (32 + 8 * fq) * 2),
                                                                         *(const pg8::bf16x8*)(L + CB_P1T + (nb * 16 + fr) * 80 + fq * 16), zero4, 0, 0, 0); MFMA_PAD1(acc);
#pragma unroll
                for (int rr = 0; rr < 4; ++rr) *(bf16*)(L + CB_TT + ((32 + ib2 * 16 + 4 * fq + rr) * 72 + nb * 16 + fr) * 2) = tobf(acc[rr]); }
#endif
    } else {
        for (int tt = wave - 1; tt < 16; tt += 7) { const int vb = tt >> 2, ib = tt & 3;
            pg8::f32x4 acc = mm64(L + CB_VC, L + CB_AAK, vb * 16 + fr, ib * 16 + fr, fq, zero4); MFMA_PAD1(acc);
#pragma unroll
            for (int rr = 0; rr < 4; ++rr) *(bf16*)(L + CB_G1T + ((vb * 16 + 4 * fq + rr) * 72 + ib * 16 + fr) * 2) = tobf(acc[rr]); }
    }
#endif
    __syncthreads();
#ifndef NO_S4
#pragma unroll
    for (int q4 = 0; q4 < 4; ++q4) { const int tt = wave * 4 + q4, second = tt >> 4, xb = (tt >> 2) & 3, ib = tt & 3;
        pg8::f32x4 acc = mm64(L + (second ? CB_G1T : CB_AC), L + CB_TT, xb * 16 + fr, ib * 16 + fr, fq, zero4); MFMA_PAD1(acc);
#pragma unroll
        for (int rr = 0; rr < 4; ++rr) *(bf16*)(L + (second ? CB_W2T : CB_W1T) + ((xb * 16 + 4 * fq + rr) * 72 + ib * 16 + fr) * 2) = tobf(acc[rr]); }
#endif
    __syncthreads();
#ifndef NO_S5
    {
        const int mat = wave >> 1, nh = wave & 1; const bool latent = cg < 128;
        bf16* mn = (bf16*)(F.ws + WS_MN) + ((size_t)(bh * NCHUNK + cg) * 2 + dir) * 8192;
        bf16* pq = (bf16*)F.out + ((size_t)(bh * 128 + (cg & 127)) * 2 + dir) * 8192;
        if (mat < 2 || latent) {
            bf16* out = mat == 0 ? mn : (mat == 1 ? mn + 4096 : (mat == 2 ? pq : pq + 4096));
            const char* A1 = L + ((mat & 1) ? CB_W2T : CB_W1T); const char* B1 = L + (mat < 2 ? CB_BHC : CB_BRB); const char* B2 = L + (mat == 1 ? CB_KHC : CB_BRK);
#pragma unroll
            for (int mb = 0; mb < 4; ++mb)
#pragma unroll
                for (int nn = 0; nn < 2; ++nn) { const int nb = 2 * nh + nn, ncol = nb * 16 + fr, m0r = mb * 16 + 4 * fq;
                    pg8::f32x4 acc = mm64(A1, B1, mb * 16 + fr, ncol, fq, zero4);
                    if (mat & 1) acc = mm64(L + CB_VC, B2, mb * 16 + fr, ncol, fq, acc);
                    MFMA_PAD1(acc);
                    if (mat == 0) { const float g = ((const float*)(L + CB_GC))[ncol];
#pragma unroll
                        for (int rr = 0; rr < 4; ++rr) if (m0r + rr == ncol) acc[rr] += g; }
                    if (mat == 2) { const v2u rw = *(const v2u*)(L + CB_RT + ncol * 144 + m0r * 2); acc[0] += bflo(rw.x); acc[1] += bfhi(rw.x); acc[2] += bflo(rw.y); acc[3] += bfhi(rw.y); }
                    v2u w; w.x = pk2(acc[0], acc[1]); w.y = pk2(acc[2], acc[3]); *(v2u*)(out + ncol * 64 + m0r) = w; }
        }
    }
#endif
    __syncthreads();
}
__device__ __forceinline__ void phase_build(Frame& F) {
    for (int it = F.bid; it < NB * RH * NCHUNK * 2; it += F.G) chunk_build_item(F, it);
}

__device__ __forceinline__ void scan2_unit(Frame& F, int sc) {
    const int dir = sc & 1, bh = sc >> 1; const bool fwd = dir == 0;
    char* L = F.lds; constexpr int SB = 4 * 9216, OFF_ZT = 2 * SB; constexpr int NS = NCHUNK + 0;
    const int lane = F.lane, wave = F.wave, fr = lane & 15, fq = lane >> 4, tid = F.tid;
    const bf16* MNb = (const bf16*)(F.ws + WS_MN); const bf16* PQb = (const bf16*)F.out;
    float* Yg = (float*)(F.ws + WS_YS) + (size_t)dir * MROWS * RW + (size_t)bh * T * RN;
    auto chunk_of = [&](int s) { return s < 4 ? (fwd ? 128 + s : 131 - s) : (fwd ? s - 4 : 131 - s); };
    v4u st[4];
    auto gload = [&](int s) { const int cg = chunk_of(s); const bf16* mn = MNb + ((size_t)(bh * NCHUNK + cg) * 2 + dir) * 8192; const bf16* pq = PQb + ((size_t)(bh * 128 + (cg & 127)) * 2 + dir) * 8192;
#pragma unroll
        for (int k = 0; k < 4; ++k) st[k] = *(const v4u*)((k < 2 ? mn + k * 4096 : pq + (k - 2) * 4096) + (tid >> 3) * 64 + (tid & 7) * 8); };
    auto lstore = [&](int buf) {
#pragma unroll
        for (int k = 0; k < 4; ++k) *(v4u*)(L + buf * SB + k * 9216 + (tid >> 3) * 144 + (tid & 7) * 16) = st[k]; };
    for (int i = tid; i < 9216 / 4; i += NTHR) ((unsigned*)(L + OFF_ZT))[i] = 0u;
    gload(0); lstore(0); __syncthreads();
    const int vb = wave >> 1, nh = wave & 1;
    for (int s = 0; s < NS; ++s) {
        const int cg = chunk_of(s); const bool latent = cg < 128; const char* B = L + (s & 1) * SB;
        if (s + 1 < NS) gload(s + 1);
        pg8::bf16x8 za[2];
#pragma unroll
        for (int kb = 0; kb < 2; ++kb) za[kb] = *(const pg8::bf16x8*)(L + OFF_ZT + (vb * 16 + fr) * 144 + kb * 64 + fq * 16);
        pg8::f32x4 zn[2], yy[2];
#pragma unroll
        for (int nn = 0; nn < 2; ++nn) { const int nrow = (2 * nh + nn) * 16 + fr;
            const v2u nw = *(const v2u*)(B + 9216 + nrow * 144 + (vb * 16 + 4 * fq) * 2); zn[nn] = (pg8::f32x4){bflo(nw.x), bfhi(nw.x), bflo(nw.y), bfhi(nw.y)};
#pragma unroll
            for (int kb = 0; kb < 2; ++kb) zn[nn] = __builtin_amdgcn_mfma_f32_16x16x32_bf16(za[kb], *(const pg8::bf16x8*)(B + nrow * 144 + kb * 64 + fq * 16), zn[nn], 0, 0, 0);
            const v2u qw = *(const v2u*)(B + 3 * 9216 + nrow * 144 + (vb * 16 + 4 * fq) * 2); yy[nn] = (pg8::f32x4){bflo(qw.x), bfhi(qw.x), bflo(qw.y), bfhi(qw.y)};
#pragma unroll
            for (int kb = 0; kb < 2; ++kb) yy[nn] = __builtin_amdgcn_mfma_f32_16x16x32_bf16(za[kb], *(const pg8::bf16x8*)(B + 2 * 9216 + nrow * 144 + kb * 64 + fq * 16), yy[nn], 0, 0, 0); }
        asm volatile("s_nop 15\n\ts_nop 7" : "+v"(zn[0]), "+v"(zn[1]), "+v"(yy[0]), "+v"(yy[1]));
        if (latent) {
#pragma unroll
            for (int nn = 0; nn < 2; ++nn) { const int i = (2 * nh + nn) * 16 + fr, nat = fwd ? i : 63 - i; *(pg8::f32x4*)(Yg + ((size_t)(cg * 64 + nat)) * RN + vb * 16 + 4 * fq) = yy[nn]; }
        }
        __syncthreads();
#pragma unroll
        for (int nn = 0; nn < 2; ++nn)
#pragma unroll
            for (int rr = 0; rr < 4; ++rr) *(bf16*)(L + OFF_ZT + ((vb * 16 + 4 * fq + rr) * 72 + (2 * nh + nn) * 16 + fr) * 2) = tobf(zn[nn][rr]);
        if (s + 1 < NS) lstore((s + 1) & 1);
        __syncthreads();
    }
}

template <int CTRL> __device__ __forceinline__ float dpp_add(float x) { return x + __builtin_bit_cast(float, __builtin_amdgcn_update_dpp(0, __builtin_bit_cast(int, x), CTRL, 0xf, 0xf, false)); }
__device__ __forceinline__ float red16(float x) { x = dpp_add<0xB1>(x); x = dpp_add<0x4E>(x); x = dpp_add<0x141>(x); x = dpp_add<0x140>(x); return x; }

__device__ __forceinline__ void scan_unit(Frame& F, int sc) {
    const int dir = sc & 1, bh = sc >> 1; const bool fwd = dir == 0;
    const size_t hb = (size_t)bh * NKEY * RN;
    const bf16* src0 = (const bf16*)(F.ws + WS_SCAN) + hb;
    float* Yg = (float*)(F.ws + WS_YS) + (size_t)dir * MROWS * RW + (size_t)bh * T * RN;
    float* buf = (float*)F.lds;
    float* ybuf = buf + 2 * 6 * 2048;
    constexpr int NCH = (TC + T) / 32;
    auto chunk_pos = [&](int c) { if (c < 8) { const int cn = fwd ? c : 7 - c; return T + 32 * cn; } const int cl = c - 8, cn = fwd ? cl : 255 - cl; return 32 * cn; };
    auto load_chunk = [&](int c, int nthreads, int t0) {
        const int pos = chunk_pos(c); float* dst = buf + (c & 1) * 6 * 2048;
        for (int i = F.tid - t0; i < 6 * 256; i += nthreads) { const int a = i >> 8, e8 = (i & 255) * 8; float f[8]; const int ai = a == 0 ? A_R : (a == 1 ? A_V : (a == 2 ? A_KK : (a == 3 ? A_W + dir : (a == 4 ? A_K + dir : A_B + dir)))); unpack8(*(const v4u*)(src0 + (size_t)ai * (SCAN_ARR / 2) + (size_t)pos * RN + e8), f);
            *(pg8::f32x4*)(dst + a * 2048 + e8) = (pg8::f32x4){f[0], f[1], f[2], f[3]}; *(pg8::f32x4*)(dst + a * 2048 + e8 + 4) = (pg8::f32x4){f[4], f[5], f[6], f[7]}; }
    };
    constexpr int C0 = 0;
    load_chunk(C0, NTHR, 0);
    __syncthreads();
    const int vg = F.lane >> 4, kl = F.lane & 15, vrow = 16 * F.wave + 4 * vg;
    float S[4][4];
#pragma unroll
    for (int i = 0; i < 4; ++i)
#pragma unroll
        for (int j = 0; j < 4; ++j) S[i][j] = 0.f;
    for (int c = C0; c < NCH; ++c) {
        const bool latent = c >= 8;
        if (F.wave >= 4) { if (c + 1 < NCH) load_chunk(c + 1, 256, 256); }
        else {
            const float* cb = buf + (c & 1) * 6 * 2048;
            for (int s = 0; s < 32; ++s) {
                const int sn = fwd ? s : 31 - s;
                const pg8::f32x4 rv = *(const pg8::f32x4*)(cb + 0 * 2048 + sn * 64 + 4 * kl), vv = *(const pg8::f32x4*)(cb + 1 * 2048 + sn * 64 + vrow);
                const pg8::f32x4 kk = *(const pg8::f32x4*)(cb + 2 * 2048 + sn * 64 + 4 * kl), w = *(const pg8::f32x4*)(cb + 3 * 2048 + sn * 64 + 4 * kl);
                const pg8::f32x4 kv = *(const pg8::f32x4*)(cb + 4 * 2048 + sn * 64 + 4 * kl), bt = *(const pg8::f32x4*)(cb + 5 * 2048 + sn * 64 + 4 * kl);
                float sa[4];
#pragma unroll
                for (int i = 0; i < 4; ++i) sa[i] = -red16((S[i][0] * kk[0] + S[i][1] * kk[1]) + (S[i][2] * kk[2] + S[i][3] * kk[3]));
#pragma unroll
                for (int i = 0; i < 4; ++i)
#pragma unroll
                    for (int j = 0; j < 4; ++j) S[i][j] = S[i][j] * w[j] + sa[i] * bt[j] + vv[i] * kv[j];
                if (latent) {
                    float y[4];
#pragma unroll
                    for (int i = 0; i < 4; ++i) y[i] = red16((S[i][0] * rv[0] + S[i][1] * rv[1]) + (S[i][2] * rv[2] + S[i][3] * rv[3]));
                    if (kl == 0) *(pg8::f32x4*)(ybuf + sn * 64 + vrow) = (pg8::f32x4){y[0], y[1], y[2], y[3]};
                }
            }
        }
        __syncthreads();
        if (latent) { const int pos = chunk_pos(c); *(pg8::f32x4*)(Yg + (size_t)pos * RN + F.tid * 4) = *(const pg8::f32x4*)(ybuf + F.tid * 4); }
        __syncthreads();
    }
}
__device__ __forceinline__ void phase_scan(Frame& F) {
    if (F.bid < 64) { scan2_unit(F, F.bid); return; }
    float* scr = (float*)(F.lds + F.wave * 8448);
    const int gw = (F.bid - 64) * NWAVES + F.wave, NGW = (F.G - 64) * NWAVES;
    constexpr int I13 = (DM / 64) * (DEXP / 32), I2 = (DEXP / 64) * (DM / 32);
    for (int it = gw; it < NEXP * (2 * I13 + I2); it += NGW) {
        const int e = it / (2 * I13 + I2); int r = it - e * (2 * I13 + I2);
        if (r < 2 * I13) { const int is3 = r >= I13; if (is3) r -= I13; const int n0 = 32 * (r % (DEXP / 32));
            transpose_item(F.in[is3 ? 30 : 29] + (size_t)e * DM * DEXP, DM, DEXP, (bf16*)(F.ws + WS_W13T), e * 1024 + (n0 / 128) * 128 + 128 * is3, nullptr, scr, r, F.lane); }
        else transpose_item(F.in[31] + (size_t)e * DEXP * DM, DEXP, DM, (bf16*)(F.ws + WS_W2T), e * DM, nullptr, scr, r - 2 * I13, F.lane);
    }
}

__device__ __forceinline__ void phase_readout(Frame& F) {
    const float* lg = F.in[22]; const float* lb = F.in[23]; const float* Ysrc = (const float*)(F.ws + WS_YS); const float* bonp = (const float*)(F.ws + WS_BON);
    bf16* MIX = (bf16*)(F.ws + WS_MIX);
    const int tk = F.tid >> 3, c8 = (F.tid & 7) * 8;
    for (int it = F.bid; it < NB * RH * (T / 64); it += F.G) {
        const int bh = it >> 7, tt = (it & 127) * 64 + tk, b = bh >> 4, h = bh & 15;
        const size_t ys = ((size_t)bh * T + tt) * RN + c8, ss = ((size_t)bh * NKEY + tt) * RN + c8;
        const pg8::f32x4 f0 = *(const pg8::f32x4*)(Ysrc + ys), f1 = *(const pg8::f32x4*)(Ysrc + ys + 4);
        const pg8::f32x4 b0 = *(const pg8::f32x4*)(Ysrc + (size_t)MROWS * RW + ys), b1 = *(const pg8::f32x4*)(Ysrc + (size_t)MROWS * RW + ys + 4);
        float y[8] = {f0[0] + b0[0], f0[1] + b0[1], f0[2] + b0[2], f0[3] + b0[3], f1[0] + b1[0], f1[1] + b1[1], f1[2] + b1[2], f1[3] + b1[3]};
        float v[8], g[8];
        unpack8(*(const v4u*)((const bf16*)(F.ws + WS_SCAN + A_V * SCAN_ARR) + ss), v);
        unpack8(*(const v4u*)((const bf16*)(F.ws + WS_G) + ys), g);
        const float bon = bonp[(size_t)bh * T + tt];
        float s = 0.f;
#pragma unroll
        for (int e = 0; e < 8; ++e) s += y[e];
        s += __shfl_xor(s, 1); s += __shfl_xor(s, 2); s += __shfl_xor(s, 4);
        const float mean = s * (1.0f / 64.0f); float q = 0.f;
#pragma unroll
        for (int e = 0; e < 8; ++e) { y[e] -= mean; q += y[e] * y[e]; }
        q += __shfl_xor(q, 1); q += __shfl_xor(q, 2); q += __shfl_xor(q, 4);
        const float rstd = __builtin_amdgcn_rsqf(q * (1.0f / 64.0f) + 64e-5f);
        float o[8];
#pragma unroll
        for (int e = 0; e < 8; ++e) { const int ch = h * 64 + c8 + e; o[e] = (y[e] * rstd * lg[ch] + lb[ch] + bon * v[e]) * g[e]; }
        *(v4u*)(MIX + ((size_t)b * T + tt) * DM + RW + h * 64 + c8) = pack8f(o);
    }
}

__device__ __forceinline__ void phase_route(Frame& F) {
    const float* X1 = F.out; const float* modf = (const float*)(F.ws + WS_MODF); const float* gf = F.in[7];
    const bf16* WR = (const bf16*)(F.ws + WS_WRT); bf16* H2 = (bf16*)(F.ws + WS_H2);
    int* rte = (int*)(F.ws + WS_ROUTE + RT_E); int* rtp = (int*)(F.ws + WS_ROUTE + RT_POS); float* rtg = (float*)(F.ws + WS_ROUTE + RT_GATE);
    float* lg = (float*)(F.lds) + F.wave * (16 * 48);
    const int fr = F.lane & 15, fq = F.lane >> 4;
    const int gw = F.bid * NWAVES + F.wave, NGW = F.G * NWAVES;
    for (int it = gw; it < MROWS / 16; it += NGW) {
        const int row = it * 16 + fr, b = row >> 13; const float* xr = X1 + (size_t)row * DM + fq * 8;
        float ss = 0.f;
#pragma unroll 8
        for (int k = 0; k < 64; ++k) { const pg8::f32x4 a = *(const pg8::f32x4*)(xr + k * 32), c = *(const pg8::f32x4*)(xr + k * 32 + 4); ss += pg8::dot4(a) + pg8::dot4(c); }
        ss += __shfl_xor(ss, 16); ss += __shfl_xor(ss, 32);
        const float rstd = __builtin_amdgcn_rsqf(ss * (1.0f / DM) + 1e-6f);
        const float* sh2 = modf + (size_t)b * 6 * DM + 3 * DM + fq * 8; const float* sc2 = modf + (size_t)b * 6 * DM + 4 * DM + fq * 8;
        pg8::f32x4 acc[3] = {{0.f, 0.f, 0.f, 0.f}, {0.f, 0.f, 0.f, 0.f}, {0.f, 0.f, 0.f, 0.f}};
#pragma unroll 4
        for (int k = 0; k < 64; ++k) {
            const pg8::f32x4 a = *(const pg8::f32x4*)(xr + k * 32), c = *(const pg8::f32x4*)(xr + k * 32 + 4);
            const pg8::f32x4 g0 = *(const pg8::f32x4*)(gf + fq * 8 + k * 32), g1 = *(const pg8::f32x4*)(gf + fq * 8 + k * 32 + 4);
            const pg8::f32x4 s0 = *(const pg8::f32x4*)(sc2 + k * 32), s1 = *(const pg8::f32x4*)(sc2 + k * 32 + 4), h0 = *(const pg8::f32x4*)(sh2 + k * 32), h1 = *(const pg8::f32x4*)(sh2 + k * 32 + 4);
            const pg8::f32x4 o0 = a * rstd * g0 * (s0 + 1.0f) + h0, o1 = c * rstd * g1 * (s1 + 1.0f) + h1;
            const pg8::u32x4 w = pg8::pack8(o0, o1);
            *(pg8::u32x4*)(H2 + (size_t)row * DM + fq * 8 + k * 32) = w;
            const pg8::bf16x8 xb = __builtin_bit_cast(pg8::bf16x8, w);
#pragma unroll
            for (int nb = 0; nb < 3; ++nb) { const pg8::bf16x8 wf = *(const pg8::bf16x8*)(WR + (size_t)(nb * 16 + fr) * DM + k * 32 + fq * 8); acc[nb] = __builtin_amdgcn_mfma_f32_16x16x32_bf16(wf, xb, acc[nb], 0, 0, 0); }
        }
        asm volatile("s_nop 15\n\ts_nop 15" : "+v"(acc[0]), "+v"(acc[1]), "+v"(acc[2]));
#pragma unroll
        for (int nb = 0; nb < 3; ++nb)
#pragma unroll
            for (int j = 0; j < 4; ++j) lg[fr * 48 + nb * 16 + 4 * fq + j] = acc[nb][j];
        LDS_WAIT(); asm volatile("" ::: "memory");
        if (F.lane < 16) {
            const float* l = lg + F.lane * 48; const float* bg = F.in[26]; const float* be = F.in[28];
            int g = 0; float gm = l[0] + bg[0]; float gl[4]; gl[0] = gm;
#pragma unroll
            for (int i = 1; i < 4; ++i) { gl[i] = l[i] + bg[i]; if (gl[i] > gm) { gm = gl[i]; g = i; } }
            float gs = 0.f;
#pragma unroll
            for (int i = 0; i < 4; ++i) gs += __expf(gl[i] - gm);
            const float gval = 1.0f / gs;
            float w8[8]; int i1 = 0; float m1 = -3.0e38f;
#pragma unroll
            for (int i = 0; i < 8; ++i) { w8[i] = l[4 + 8 * g + i] + be[8 * g + i]; if (w8[i] > m1) { m1 = w8[i]; i1 = i; } }
            int i2 = 0; float m2 = -3.0e38f;
#pragma unroll
            for (int i = 0; i < 8; ++i) { if (i != i1 && w8[i] > m2) { m2 = w8[i]; i2 = i; } }
            const float e2 = __expf(m2 - m1), inv = 1.0f / (1.0f + e2);
            const int ea = 8 * g + i1, eb = 8 * g + i2; const int t = it * 16 + F.lane;
            const int pa = (int)atomicAdd(F.ctl + CW_CNT + ea, 1u), pb = (int)atomicAdd(F.ctl + CW_CNT + eb, 1u);
            rte[2 * t] = ea; rte[2 * t + 1] = eb; rtp[2 * t] = pa; rtp[2 * t + 1] = pb; rtg[2 * t] = gval * inv; rtg[2 * t + 1] = gval * e2 * inv;
        }
        LDS_WAIT(); asm volatile("" ::: "memory");
    }
}

__device__ __forceinline__ void build_tiles(Frame& F) {
    int* tab = (int*)(F.lds + EXTRA_OFF);
    if (F.tid == 0) { int tb = 0;
        for (int e = 0; e < NEXP; ++e) { const int c = (int)__hip_atomic_load(F.ctl + CW_CNT + e, __ATOMIC_RELAXED, __HIP_MEMORY_SCOPE_AGENT); const int nt = (c + 255) >> 8; tab[e] = tb * 256;
            for (int i = 0; i < nt && tb + i < MAXTILES; ++i) tab[64 + tb + i] = e; tb += nt; }
        tab[32] = tb < MAXTILES ? tb : MAXTILES; }
    __syncthreads();
}
__device__ __forceinline__ void phase_gather(Frame& F) {
    build_tiles(F);
    const int* tab = (const int*)(F.lds + EXTRA_OFF);
    const int* rte = (const int*)(F.ws + WS_ROUTE + RT_E); const int* rtp = (const int*)(F.ws + WS_ROUTE + RT_POS); const float* rtg = (const float*)(F.ws + WS_ROUTE + RT_GATE);
    int* rtr = (int*)(F.ws + WS_ROUTE + RT_ROW); float* rgate = (float*)(F.ws + WS_ROUTE + RT_RGATE);
    const bf16* H2 = (const bf16*)(F.ws + WS_H2); bf16* XG = (bf16*)(F.ws + WS_XG);
    const int gw = F.bid * NWAVES + F.wave, NGW = F.G * NWAVES;
    for (int p = gw; p < 2 * MROWS; p += NGW) {
        const int t = p >> 1; const int row = tab[rte[p]] + rtp[p];
        const v4u* s = (const v4u*)(H2 + (size_t)t * DM) + F.lane; v4u* d = (v4u*)(XG + (size_t)row * DM) + F.lane;
#pragma unroll
        for (int q = 0; q < 4; ++q) d[64 * q] = s[64 * q];
        if (F.lane == 0) { rtr[p] = row; rgate[row] = rtg[p]; }
    }
}
__device__ __forceinline__ void phase_final(Frame& F) {
    const float* modf = (const float*)(F.ws + WS_MODF); const float* fg = F.in[32]; const bf16* Y = (const bf16*)(F.ws + WS_Y); const int* rtr = (const int*)(F.ws + WS_ROUTE + RT_ROW);
    const int gw = F.bid * NWAVES + F.wave, NGW = F.G * NWAVES;
    for (int m = gw; m < MROWS; m += NGW) {
        const int b = m >> 13, ra = rtr[2 * m], rb = rtr[2 * m + 1]; const float* g2 = modf + (size_t)b * 6 * DM + 5 * DM;
        float* xr = F.out + (size_t)m * DM; pg8::f32x4 v[8]; float s = 0.f;
#pragma unroll
        for (int q = 0; q < 8; ++q) { const int c = q * 256 + F.lane * 4; const pg8::f32x4 x = *(const pg8::f32x4*)(xr + c), g = *(const pg8::f32x4*)(g2 + c);
            const v2u ya = *(const v2u*)(Y + (size_t)ra * DM + c), yb = *(const v2u*)(Y + (size_t)rb * DM + c);
            const pg8::f32x4 ys = {bflo(ya.x) + bflo(yb.x), bfhi(ya.x) + bfhi(yb.x), bflo(ya.y) + bflo(yb.y), bfhi(ya.y) + bfhi(yb.y)};
            v[q] = x + g * ys; s += pg8::dot4(v[q]); }
        const float rstd = __builtin_amdgcn_rsqf(wave_sum(s) * (1.0f / DM) + 1e-6f);
#pragma unroll
        for (int q = 0; q < 8; ++q) { const int c = q * 256 + F.lane * 4; *(pg8::f32x4*)(xr + c) = v[q] * rstd * *(const pg8::f32x4*)(fg + c); }
    }
}

struct Args { const float* in[33]; float* out; unsigned char* ws; int ph_lo, ph_hi; };
__global__ void __launch_bounds__(NTHR, 2) fwd_kernel(Args args) {
    extern __shared__ __attribute__((aligned(16))) unsigned char lds_raw[];
    Frame F;
    F.lds = (char*)lds_raw; F.MISC = (volatile LAS unsigned*)((LAS unsigned char*)lds_raw + MISC_OFF);
    F.tid = threadIdx.x; F.lane = F.tid & 63; F.wave = __builtin_amdgcn_readfirstlane(F.tid >> 6); F.G = gridDim.x; F.bid = blockIdx.x;
    F.ws = args.ws; F.ctl = (unsigned*)(args.ws + WS_CTL); F.out = args.out;
    F.in = (const float* const __attribute__((address_space(4)))*)__builtin_amdgcn_kernarg_segment_ptr();
    if (F.tid < 128) ((LAS unsigned*)((LAS unsigned char*)lds_raw + MISC_OFF))[F.tid] = 0u;
    __syncthreads();
    XcdBarrier bar; bar.bar = F.ctl + CW_BAR; bar.x = 0; bar.st = nullptr;
    if (N_LAUNCHES == 1) bar = xcd_barrier_post(F.ctl + CW_BAR, F.MISC + 8);
    const int lo = args.ph_lo, hi = args.ph_hi;
#ifndef PH_MASK
#define PH_MASK 0xffff
#endif
#define IN(k) (((PH_MASK >> (k)) & 1) && lo <= (k) && (k) < hi)
#define SEAM(k) do { if (IN(k) && IN((k) + 1)) xcd_barrier(bar); } while (0)
    LAS unsigned char* ring = (LAS unsigned char*)lds_raw;

    if (IN(0)) { phase0(F); } SEAM(0);
    if (IN(1)) { phase1(F); } SEAM(1);
    if (IN(2)) {
        pg8::Gemm g{(const bf16*)(F.ws + WS_H), (const bf16*)(F.ws + WS_WTIN), MALL, NINP, DM, DM}; pg8::StaticOrder S; S.init(MALL, NINP, F.G, F.bid);
        pg8::EpiP E{(bf16*)(F.ws + WS_P), NINP, (float*)(F.ws + WS_RSS)};
        pg8::gemm_phase<pg8::EpiP, pg8::StaticOrder, true, true>(ring, g, S, E);
    } SEAM(2);
    if (IN(3)) {
        for (int tl = F.bid; tl < MALL / 64; tl += F.G) rwkv_prep_tile(F, tl);
        { pg8::Gemm g{(const bf16*)(F.ws + WS_P) + C_CQ, (const bf16*)(F.ws + WS_WTUQ), MROWS, 1536, 512, NINP}; pg8::StaticOrder S; S.init(MROWS, 1536, F.G, F.bid);
          pg8::EpiQ E{(bf16*)(F.ws + WS_Q), (const float*)(F.ws + WS_RSS)};
          pg8::gemm_phase<pg8::EpiQ, pg8::StaticOrder, true, true>(ring, g, S, E); }
        { pg8::Gemm g{(const bf16*)(F.ws + WS_P) + C_CKV, (const bf16*)(F.ws + WS_WTUKV), MALL, 2048, 256, NINP}; pg8::StaticOrder S; S.init(MALL, 2048, F.G, F.bid);
          pg8::EpiKV E{(bf16*)(F.ws + WS_KN), (bf16*)(F.ws + WS_V), (const float*)(F.ws + WS_RSS)};
          pg8::gemm_phase<pg8::EpiKV, pg8::StaticOrder, true, true>(ring, g, S, E); }
    } SEAM(3);
    if (IN(4)) {
        for (int u = F.bid; u < NB * 8 * (T / 256); u += F.G) {
            const int qb = u & 31, bh = u >> 5, b = bh >> 3, h = bh & 7;
            att::attn_dense_body((const bf16*)(F.ws + WS_Q) + ((size_t)(b * T + qb * 256)) * 1536 + h * 192,
                                 (const bf16*)(F.ws + WS_KN) + (size_t)bh * NKEY * 128, (const bf16*)(F.ws + WS_V) + (size_t)bh * NKEY * 128,
                                 (const bf16*)(F.ws + WS_KR) + (size_t)b * NKEY * 64,
                                 (bf16*)(F.ws + WS_MIX) + ((size_t)(b * T + qb * 256)) * DM + h * 128, NKEY, F.lds);
        }
    } SEAM(4);
    if (IN(5)) { phase_build(F); } SEAM(5);
    if (IN(6)) { phase_scan(F); } SEAM(6);
    if (IN(7)) { phase_readout(F); } SEAM(7);
    if (IN(8)) {
        pg8::Gemm g{(const bf16*)(F.ws + WS_MIX), (const bf16*)(F.ws + WS_WTOUT), MROWS, DM, DM, DM}; pg8::StaticOrder S; S.init(MROWS, DM, F.G, F.bid);
        pg8::EpiOut E{F.in[0], F.out, (const float*)(F.ws + WS_MODF) + 2 * DM};
        pg8::gemm_phase<pg8::EpiOut, pg8::StaticOrder, true, true>(ring, g, S, E);
    } SEAM(8);
    if (IN(9)) { phase_route(F); } SEAM(9);
    if (IN(10)) { phase_gather(F); } SEAM(10);
    if (IN(11)) {
        build_tiles(F); const int* tab = (const int*)(F.lds + EXTRA_OFF);
        pg8::Gemm g{(const bf16*)(F.ws + WS_XG), (const bf16*)(F.ws + WS_W13T), MAXTILES * 256, NEXP * 1024, DM, DM};
        pg8::MoeOrder S{(const LAS int*)((LAS unsigned char*)lds_raw + EXTRA_OFF) + 64, tab[32], 4, F.G, F.bid};
        pg8::EpiMoe1 E{(bf16*)(F.ws + WS_HM)};
        pg8::gemm_phase<pg8::EpiMoe1, pg8::MoeOrder, true, true>(ring, g, S, E);
    } SEAM(11);
    if (IN(12)) {
        build_tiles(F); const int* tab = (const int*)(F.lds + EXTRA_OFF);
        pg8::Gemm g{(const bf16*)(F.ws + WS_HM), (const bf16*)(F.ws + WS_W2T), MAXTILES * 256, NEXP * DM, DEXP, DEXP};
        pg8::MoeOrder S{(const LAS int*)((LAS unsigned char*)lds_raw + EXTRA_OFF) + 64, tab[32], 8, F.G, F.bid};
        pg8::EpiMoe2 E{(bf16*)(F.ws + WS_Y), (const float*)(F.ws + WS_ROUTE + RT_RGATE)};
        pg8::gemm_phase<pg8::EpiMoe2, pg8::MoeOrder, true, true>(ring, g, S, E);
    } SEAM(12);
    if (IN(13)) { phase_final(F); }
#undef IN
#undef SEAM
}

extern "C" void kernel_launch(void* const* d_in, const int* in_sizes, int n_in, void* d_out, int out_size, void* d_ws, size_t ws_size, hipStream_t stream) {
    static int grid = 0;
    if (grid == 0) {
        if (n_in != 33 || in_sizes[0] != MROWS * DM || out_size != MROWS * DM || ws_size < WS_END) {
            fprintf(stderr, "kernel_launch: shape mismatch: n_in %d in0 %d out %d ws %zu (need %zu); nothing launched\n", n_in, n_in > 0 ? in_sizes[0] : -1, out_size, ws_size, (size_t)WS_END); grid = -1; return; }
        int dev = 0, cus = 0, per_cu = 0;
        if (hipGetDevice(&dev) != hipSuccess || hipDeviceGetAttribute(&cus, hipDeviceAttributeMultiprocessorCount, dev) != hipSuccess) { grid = -1; return; }
        if (hipFuncSetAttribute((const void*)fwd_kernel, hipFuncAttributeMaxDynamicSharedMemorySize, LDS_BYTES) != hipSuccess) { fprintf(stderr, "kernel_launch: hipFuncSetAttribute failed\n"); grid = -1; return; }
        if (hipOccupancyMaxActiveBlocksPerMultiprocessor(&per_cu, (const void*)fwd_kernel, NTHR, LDS_BYTES) != hipSuccess || per_cu < 1)
            fprintf(stderr, "kernel_launch: occupancy query reports %d workgroups per CU\n", per_cu);
        (void)hipGetLastError();
        grid = cus;
    }
    if (grid < 0) return;
    if (hipMemsetAsync((char*)d_ws + WS_CTL, 0, CTL_ZERO_BYTES, stream) != hipSuccess) return;
    Args a{};
    for (int i = 0; i < 33; ++i) a.in[i] = (const float*)d_in[i];
    a.out = (float*)d_out; a.ws = (unsigned char*)d_ws;
    for (int li = 0; li < N_LAUNCHES; ++li) {
        a.ph_lo = (N_LAUNCHES == 1) ? 0 : li; a.ph_hi = (N_LAUNCHES == 1) ? N_PHASES : li + 1;
        hipLaunchKernelGGL(fwd_kernel, dim3(grid), dim3(NTHR), LDS_BYTES, stream, a);
        const hipError_t le = hipPeekAtLastError();
        if (le != hipSuccess) { fprintf(stderr, "kernel_launch: launch %d failed: %s\n", li, hipGetErrorName(le)); break; }
    }
}
```

```cpp
#include <hip/hip_runtime.h>
#include <cstdio>
#include <cstdint>

#define GAS __attribute__((address_space(1)))
#define LAS __attribute__((address_space(3)))
typedef unsigned short bf16;
typedef unsigned v4u __attribute__((ext_vector_type(4)));
typedef unsigned v2u __attribute__((ext_vector_type(2)));
typedef float f32x2 __attribute__((ext_vector_type(2)));
typedef float f32x16 __attribute__((ext_vector_type(16)));
typedef short s16x4 __attribute__((ext_vector_type(4)));

constexpr int DM = 2048, NB = 2, T = 8192, TC = 256, MROWS = NB * T;
constexpr int MALL = MROWS + NB * TC;
constexpr int NIN = 4192, NINP = 4352;
constexpr int C_CQ = 0, C_CKV = 512, C_KR = 768, C_R = 832, C_K = 1856, C_V = 2880, C_WL = 3904, C_AL = 3968, C_GL = 4032;
constexpr int NKEY = T + TC;
constexpr int RH = 16, RN = 64, RW = 1024;
constexpr int NEXP = 32, DEXP = 512, MAXTILES = 160;

namespace pg8 {
#define PG8_LAS __attribute__((address_space(3)))
typedef unsigned short bf16_t;
typedef short bf16x8 __attribute__((ext_vector_type(8)));
typedef float f32x4 __attribute__((ext_vector_type(4)));
typedef unsigned u32x4 __attribute__((ext_vector_type(4)));
constexpr int BM = 256, BK = 64, HALF = 128, HTB = HALF * BK * 2  , STAGE_BYTES = 8 * HTB, NXCD = 8, WGM = 8;

__host__ __device__ __forceinline__ int lds_byte(int r, int c) { const int st = (r >> 4) * 2 + (c >> 5), rr = r & 15, cc = c & 31, ob = rr * 64 + cc * 2; return st * 1024 + (ob ^ (((ob >> 9) & 1) << 5)); }
__host__ __device__ __forceinline__ void stage_rc(int b, int& R, int& C) { const int st = b / 1024, sb = b % 1024, swz = sb ^ (((sb >> 9) & 1) << 5); R = (st >> 1) * 16 + swz / 64; C = (st & 1) * 32 + (swz % 64) / 2; }
__host__ __device__ __forceinline__ int perm32(int rho) { const int n = rho >> 4, i = rho & 15; return 8 * (i >> 2) + 4 * n + (i & 3); }

struct Unit { int pm, pn; };
struct Gemm { const bf16_t* A; const bf16_t* Bt; int M, N, K, lda; };

struct StaticOrder {
    int nM, nN, nwg, G, c;
    __host__ __device__ void init(int M, int N, int G_, int c_) { nM = M / BM; nN = N / BM; nwg = nM * nN; G = G_; c = c_; }
    __host__ __device__ bool next(int i, Unit& u) const {
        const long L = (long)i * G + c; if (L >= nwg) return false;
        int wgid = (int)L; { const int q = nwg / NXCD, r = nwg % NXCD, xcd = wgid % NXCD, off = wgid / NXCD; wgid = (xcd < r ? xcd * (q + 1) : r * (q + 1) + (xcd - r) * q) + off; }
        const int nig = WGM * nN, gid = wgid / nig, fm = gid * WGM, gsz = (nM - fm) < WGM ? (nM - fm) : WGM;
        u.pm = fm + ((wgid % nig) % gsz); u.pn = (wgid % nig) / gsz; return true;
    }
    __device__ __forceinline__ void a_ready(const Unit&) const {}
    __device__ __forceinline__ void done(const Unit&) const {}
};


__device__ __forceinline__ unsigned cvt_pk_bf16(float lo, float hi) { unsigned r; asm volatile("v_cvt_pk_bf16_f32 %0, %1, %2" : "=v"(r) : "v"(lo), "v"(hi)); return r; }
typedef unsigned u32x2 __attribute__((ext_vector_type(2)));
__device__ __forceinline__ u32x4 pack8(const f32x4 a, const f32x4 b) { u32x4 w; w.x = cvt_pk_bf16(a[0], a[1]); w.y = cvt_pk_bf16(a[2], a[3]); w.z = cvt_pk_bf16(b[0], b[1]); w.w = cvt_pk_bf16(b[2], b[3]); return w; }
__device__ __forceinline__ float dot4(const f32x4 a) { return (a[0] * a[0] + a[1] * a[1]) + (a[2] * a[2] + a[3] * a[3]); }

struct EpiP {
    static constexpr bool PERM = true, AFTER_DRAIN = false;
    bf16_t* O; int ldc; float* rss;
    __device__ __forceinline__ void operator()(const f32x4 (&acc)[2][2][4][2], const Unit& u, int wr, int wc, int fr, int fq) const {
        const int row0 = u.pm * BM + wr * 64 + fr, col0 = u.pn * BM + wc * 32 + 8 * fq;
#pragma unroll
        for (int ai = 0; ai < 2; ++ai)
#pragma unroll
            for (int m = 0; m < 4; ++m) { const int row = row0 + ai * HALF + m * 16; bf16_t* rowp = O + (size_t)row * ldc + col0; float ss = 0.f;
#pragma unroll
                for (int bj = 0; bj < 2; ++bj) { const f32x4 v0 = acc[ai][bj][m][0], v1 = acc[ai][bj][m][1]; ss += dot4(v0) + dot4(v1); *(u32x4*)(rowp + bj * HALF) = pack8(v0, v1); }
                if (u.pn < 3) { ss += __shfl_xor(ss, 16); ss += __shfl_xor(ss, 32); if (fq == 0) rss[(size_t)row * 12 + u.pn * 4 + wc] = ss; } }
    }
};
struct EpiQ {
    static constexpr bool PERM = false, AFTER_DRAIN = false;
    bf16_t* Q; const float* rss;
    __device__ __forceinline__ void operator()(const f32x4 (&acc)[2][2][4][2], const Unit& u, int wr, int wc, int fr, int fq) const {
        const int row0 = u.pm * BM + wr * 64 + fr;
        float rev[4];
#pragma unroll
        for (int e = 0; e < 4; ++e) rev[e] = __builtin_amdgcn_exp2f(-(float)(4 * fq + e) * 0.83048202372184059f) * 0.15915494309189535f;
#pragma unroll
        for (int ai = 0; ai < 2; ++ai)
#pragma unroll
            for (int m = 0; m < 4; ++m) { const int row = row0 + ai * HALF + m * 16;
                const f32x4 s0 = *(const f32x4*)(rss + (size_t)row * 12), s1 = *(const f32x4*)(rss + (size_t)row * 12 + 4);
                const float ss = ((s0[0] + s0[1]) + (s0[2] + s0[3])) + ((s1[0] + s1[1]) + (s1[2] + s1[3]));
                const float rstd = __builtin_amdgcn_rsqf(ss * (1.0f / 512.0f) + 1e-6f);
                const int t = row & (T - 1); const float pr = (float)(t >> 6), pc = (float)(t & 63);
#pragma unroll
                for (int bj = 0; bj < 2; ++bj) { const int g32 = 8 * u.pn + 4 * bj + wc, gi = g32 % 6; const int col = 256 * u.pn + 128 * bj + 32 * wc + 4 * fq;
                    f32x4 v0 = acc[ai][bj][m][0] * rstd, v1 = acc[ai][bj][m][1] * rstd;
                    if (gi >= 4) { const float pos = gi == 4 ? pr : pc;
#pragma unroll
                        for (int e = 0; e < 4; ++e) { float r = pos * rev[e]; r = r - __builtin_floorf(r); const float sn = __builtin_amdgcn_sinf(r), cs = __builtin_amdgcn_cosf(r);
                            const float x1 = v0[e], x2 = v1[e]; v0[e] = x1 * cs - x2 * sn; v1[e] = x1 * sn + x2 * cs; } }
                    u32x2 w0, w1; w0.x = cvt_pk_bf16(v0[0], v0[1]); w0.y = cvt_pk_bf16(v0[2], v0[3]); w1.x = cvt_pk_bf16(v1[0], v1[1]); w1.y = cvt_pk_bf16(v1[2], v1[3]);
                    bf16_t* p = Q + (size_t)row * 1536 + col; *(u32x2*)p = w0; *(u32x2*)(p + 16) = w1; } }
    }
};
struct EpiKV {
    static constexpr bool PERM = true, AFTER_DRAIN = false;
    bf16_t* KN; bf16_t* V; const float* rss;
    __device__ __forceinline__ void operator()(const f32x4 (&acc)[2][2][4][2], const Unit& u, int wr, int wc, int fr, int fq) const {
        const int row0 = u.pm * BM + wr * 64 + fr;
#pragma unroll
        for (int ai = 0; ai < 2; ++ai)
#pragma unroll
            for (int m = 0; m < 4; ++m) { const int row = row0 + ai * HALF + m * 16;
                const f32x4 s0 = *(const f32x4*)(rss + (size_t)row * 12 + 8);
                const float rstd = __builtin_amdgcn_rsqf(((s0[0] + s0[1]) + (s0[2] + s0[3])) * (1.0f / 256.0f) + 1e-6f);
                int b, key; if (row < MROWS) { b = row >> 13; key = row & (T - 1); } else { const int r2 = row - MROWS; b = r2 >> 8; key = T + (r2 & 255); }
                const size_t off = ((size_t)(b * 8 + u.pn) * NKEY + key) * 128 + wc * 32 + 8 * fq;
                *(u32x4*)(KN + off) = pack8(acc[ai][0][m][0] * rstd, acc[ai][0][m][1] * rstd);
                *(u32x4*)(V + off) = pack8(acc[ai][1][m][0] * rstd, acc[ai][1][m][1] * rstd); }
    }
};
struct EpiOut {
    static constexpr bool PERM = false, AFTER_DRAIN = false;
    const float* x; float* X1; const float* g1;
    __device__ __forceinline__ void operator()(const f32x4 (&acc)[2][2][4][2], const Unit& u, int wr, int wc, int fr, int fq) const {
        const int row0 = u.pm * BM + wr * 64 + fr, col0 = u.pn * BM + wc * 32 + 4 * fq; const int b = (u.pm * BM) >> 13;
        f32x4 gv[2][2];
#pragma unroll
        for (int bj = 0; bj < 2; ++bj)
#pragma unroll
            for (int n = 0; n < 2; ++n) gv[bj][n] = *(const f32x4*)(g1 + (size_t)b * 6 * DM + col0 + bj * HALF + n * 16);
#pragma unroll
        for (int ai = 0; ai < 2; ++ai)
#pragma unroll
            for (int m = 0; m < 4; ++m) { const size_t off = (size_t)(row0 + ai * HALF + m * 16) * DM + col0;
#pragma unroll
                for (int bj = 0; bj < 2; ++bj)
#pragma unroll
                    for (int n = 0; n < 2; ++n) { const f32x4 xv = *(const f32x4*)(x + off + bj * HALF + n * 16); *(f32x4*)(X1 + off + bj * HALF + n * 16) = xv + gv[bj][n] * acc[ai][bj][m][n]; }
                if (m & 1) asm volatile("" ::: "memory"); }
    }
};
struct EpiMoe1 {
    static constexpr bool PERM = true, AFTER_DRAIN = false;
    bf16_t* HM;
    __device__ __forceinline__ void operator()(const f32x4 (&acc)[2][2][4][2], const Unit& u, int wr, int wc, int fr, int fq) const {
        const int row0 = u.pm * BM + wr * 64 + fr, col0 = (u.pn & 3) * 128 + wc * 32 + 8 * fq;
#pragma unroll
        for (int ai = 0; ai < 2; ++ai)
#pragma unroll
            for (int m = 0; m < 4; ++m) { f32x4 h[2];
#pragma unroll
                for (int n = 0; n < 2; ++n)
#pragma unroll
                    for (int e = 0; e < 4; ++e) { const float a = acc[ai][0][m][n][e], b = acc[ai][1][m][n][e]; h[n][e] = a * __builtin_amdgcn_rcpf(1.0f + __expf(-a)) * b; }
                *(u32x4*)(HM + (size_t)(row0 + ai * HALF + m * 16) * DEXP + col0) = pack8(h[0], h[1]); }
    }
};
struct EpiMoe2 {
    static constexpr bool PERM = true, AFTER_DRAIN = false;
    bf16_t* Y; const float* rowgate;
    __device__ __forceinline__ void operator()(const f32x4 (&acc)[2][2][4][2], const Unit& u, int wr, int wc, int fr, int fq) const {
        const int row0 = u.pm * BM + wr * 64 + fr, col0 = (u.pn & 7) * 256 + wc * 32 + 8 * fq;
#pragma unroll
        for (int ai = 0; ai < 2; ++ai)
#pragma unroll
            for (int m = 0; m < 4; ++m) { const int row = row0 + ai * HALF + m * 16; const float gt = rowgate[row];
#pragma unroll
                for (int bj = 0; bj < 2; ++bj) *(u32x4*)(Y + (size_t)row * DM + col0 + bj * HALF) = pack8(acc[ai][bj][m][0] * gt, acc[ai][bj][m][1] * gt); }
    }
};
struct MoeOrder {
    const PG8_LAS int* tile_e; int ntiles, NJ, G, c;
    __device__ __forceinline__ bool next(int i, Unit& u) const { const int L = i * G + c; if (L >= ntiles * NJ) return false; const int rt = L / NJ, j = L - rt * NJ; u.pm = rt; u.pn = tile_e[rt] * NJ + j; return true; }
    __device__ __forceinline__ void a_ready(const Unit&) const {}
    __device__ __forceinline__ void done(const Unit&) const {}
};

template <class Epi, class Sched, bool ALIGN_EPI = false, bool SP2 = false>
__device__ __forceinline__ void gemm_phase(PG8_LAS unsigned char* lds, const Gemm g, const Sched& S, const Epi& E) {
    const int tid = threadIdx.x, wid = __builtin_amdgcn_readfirstlane(tid >> 6), lane = tid & 63, wr = wid >> 2, wc = wid & 3, fr = lane & 15, fq = lane >> 4;
    const int K = g.K, nt = K / BK;
    unsigned voffA[2], voffB[2];
#pragma unroll
    for (int i = 0; i < 2; ++i) { int R, C; stage_rc(tid * 16 + i * 8192, R, C); const int Rb = Epi::PERM ? ((R & ~31) + perm32(R & 31)) : R;
        voffA[i] = (unsigned)(R * g.lda + C) * 2u; voffB[i] = (unsigned)(Rb * K + C) * 2u; }
    const size_t kstep = (size_t)(BK * 2);
    const size_t hstepA = (size_t)HALF * g.lda * 2, hstepB = (size_t)HALF * K * 2;
    const size_t tstepA = 2 * hstepA, tstepB = 2 * hstepB;
    const unsigned ldsw = (unsigned)wid * 1024u;
    const int aoff = lds_byte(wr * 64 + fr, fq * 8), boff = lds_byte(wc * 32 + fr, fq * 8);
#define PG8_SA(b, h) (((b) * 2 + (h)) * HTB)
#define PG8_SB(b, h) ((4 + (b) * 2 + (h)) * HTB)
#define PG8_STAGE(bufoff, gbase, voff) do { _Pragma("unroll") for (int _i = 0; _i < 2; ++_i) \
        __builtin_amdgcn_global_load_lds((const unsigned*)((const char*)(gbase) + (voff)[_i]), (PG8_LAS unsigned*)(lds + (bufoff) + ldsw + _i * 8192), 16, 0, 0); } while (0)
#define PG8_LDA(dst, b, h) do { _Pragma("unroll") for (int m = 0; m < 4; ++m) _Pragma("unroll") for (int k = 0; k < 2; ++k) dst[m][k] = *(const PG8_LAS bf16x8*)(lds + PG8_SA(b, h) + aoff + m * 2048 + k * 1024); } while (0)
#define PG8_LDB(dst, b, h) do { _Pragma("unroll") for (int n = 0; n < 2; ++n) _Pragma("unroll") for (int k = 0; k < 2; ++k) dst[n][k] = *(const PG8_LAS bf16x8*)(lds + PG8_SB(b, h) + boff + n * 2048 + k * 1024); } while (0)
#define PG8_MMA(ai, bj, At, Bt) do { __builtin_amdgcn_s_setprio(1); _Pragma("unroll") for (int m = 0; m < 4; ++m) _Pragma("unroll") for (int n = 0; n < 2; ++n) _Pragma("unroll") for (int k = 0; k < 2; ++k) \
        acc[ai][bj][m][n] = __builtin_amdgcn_mfma_f32_16x16x32_bf16(Bt[n][k], At[m][k], acc[ai][bj][m][n], 0, 0, 0); __builtin_amdgcn_s_setprio(0); } while (0)
#define PG8_WAIT_V(n) asm volatile("s_waitcnt vmcnt(" #n ")" ::: "memory")
#define PG8_WAIT_L(n) asm volatile("s_waitcnt lgkmcnt(" #n ")" ::: "memory")
#define PG8_BAR __builtin_amdgcn_s_barrier()
#define PG8_SCHED __builtin_amdgcn_sched_barrier(0)
    Unit cur, nxt; int ui = 0;
    if (!S.next(0, cur)) return;
    f32x4 acc[2][2][4][2];
#pragma unroll
    for (int a = 0; a < 2; ++a)
#pragma unroll
        for (int b = 0; b < 2; ++b)
#pragma unroll
            for (int m = 0; m < 4; ++m)
#pragma unroll
                for (int n = 0; n < 2; ++n) acc[a][b][m][n] = (f32x4){0.f, 0.f, 0.f, 0.f};
    bf16x8 At[4][2], B0[2][2], B1[2][2];
    const char* cA = (const char*)g.A + (size_t)cur.pm * tstepA; const char* cB = (const char*)g.Bt + (size_t)cur.pn * tstepB;
    S.a_ready(cur);
    if constexpr (SP2) {
        PG8_STAGE(PG8_SB(0, 0), cB, voffB); PG8_STAGE(PG8_SB(0, 1), cB + hstepB, voffB); PG8_STAGE(PG8_SA(0, 0), cA, voffA); PG8_STAGE(PG8_SA(0, 1), cA + hstepA, voffA);
        if (wr == 1) PG8_BAR;
        PG8_WAIT_V(2); PG8_BAR;
        PG8_STAGE(PG8_SB(1, 0), cB + kstep, voffB); PG8_STAGE(PG8_SA(1, 0), cA + kstep, voffA); PG8_STAGE(PG8_SB(1, 1), cB + hstepB + kstep, voffB);
        PG8_WAIT_V(6); PG8_BAR;
    } else {
        PG8_STAGE(PG8_SB(0, 0), cB, voffB); PG8_STAGE(PG8_SA(0, 0), cA, voffA); PG8_STAGE(PG8_SB(0, 1), cB + hstepB, voffB); PG8_STAGE(PG8_SA(0, 1), cA + hstepA, voffA);
        if (wr == 1) PG8_BAR;
        PG8_WAIT_V(4); PG8_BAR;
        PG8_STAGE(PG8_SB(1, 0), cB + kstep, voffB); PG8_STAGE(PG8_SA(1, 0), cA + kstep, voffA); PG8_STAGE(PG8_SB(1, 1), cB + hstepB + kstep, voffB);
        PG8_WAIT_V(6); PG8_BAR;
    }
    for (;;) {
        const bool has_next = S.next(ui + 1, nxt);
        const char* nA = has_next ? (const char*)g.A + (size_t)nxt.pm * tstepA : cA; const char* nB = has_next ? (const char*)g.Bt + (size_t)nxt.pn * tstepB : cB;
        for (int t = 0; t < nt; t += 2) {
            const bool last = (t == nt - 2);
            const char* a1 = cA + (size_t)(t + 1) * kstep;
            const char* a2 = last ? nA : cA + (size_t)(t + 2) * kstep; const char* b2 = last ? nB : cB + (size_t)(t + 2) * kstep;
            const char* a3 = a2 + kstep; const char* b3 = b2 + kstep;
            if (last && has_next) S.a_ready(nxt);
            if constexpr (SP2) {
            PG8_LDB(B0, 0, 0); PG8_LDB(B1, 0, 1); PG8_SCHED; PG8_LDA(At, 0, 0); PG8_STAGE(PG8_SA(1, 1), a1 + hstepA, voffA);
            PG8_WAIT_V(8); PG8_WAIT_L(0); PG8_BAR; PG8_MMA(0, 0, At, B0); PG8_MMA(0, 1, At, B1); PG8_BAR; PG8_SCHED;
            PG8_LDA(At, 0, 1); PG8_STAGE(PG8_SB(0, 0), b2, voffB); PG8_STAGE(PG8_SB(0, 1), b2 + hstepB, voffB); PG8_STAGE(PG8_SA(0, 0), a2, voffA);
            PG8_WAIT_V(8); PG8_WAIT_L(0); PG8_BAR; PG8_MMA(1, 0, At, B0); PG8_MMA(1, 1, At, B1); PG8_BAR; PG8_SCHED;
            PG8_LDB(B0, 1, 0); PG8_LDB(B1, 1, 1); PG8_SCHED; PG8_LDA(At, 1, 0); PG8_STAGE(PG8_SA(0, 1), a2 + hstepA, voffA);
            PG8_WAIT_V(8); PG8_WAIT_L(0); PG8_BAR; PG8_MMA(0, 0, At, B0); PG8_MMA(0, 1, At, B1); PG8_BAR; PG8_SCHED;
            PG8_LDA(At, 1, 1); PG8_STAGE(PG8_SB(1, 0), b3, voffB); PG8_STAGE(PG8_SB(1, 1), b3 + hstepB, voffB); PG8_STAGE(PG8_SA(1, 0), a3, voffA);
            PG8_WAIT_V(8); PG8_WAIT_L(0); PG8_BAR; PG8_MMA(1, 0, At, B0); PG8_MMA(1, 1, At, B1); PG8_BAR; PG8_SCHED;
            } else {
            PG8_LDB(B0, 0, 0); PG8_SCHED; PG8_LDA(At, 0, 0); PG8_STAGE(PG8_SA(1, 1), a1 + hstepA, voffA);
            PG8_WAIT_L(8); PG8_BAR; PG8_WAIT_L(0); PG8_MMA(0, 0, At, B0); PG8_BAR; PG8_SCHED;
            PG8_LDB(B1, 0, 1); PG8_STAGE(PG8_SB(0, 0), b2, voffB);
            PG8_BAR; PG8_WAIT_L(0); PG8_MMA(0, 1, At, B1); PG8_BAR;
            PG8_LDA(At, 0, 1); PG8_STAGE(PG8_SA(0, 0), a2, voffA);
            PG8_BAR; PG8_WAIT_L(0); PG8_MMA(1, 0, At, B0); PG8_BAR; PG8_SCHED;
            PG8_STAGE(PG8_SB(0, 1), b2 + hstepB, voffB);
            PG8_WAIT_V(6); PG8_BAR; PG8_MMA(1, 1, At, B1); PG8_BAR;
            PG8_LDB(B0, 1, 0); PG8_SCHED; PG8_LDA(At, 1, 0); PG8_STAGE(PG8_SA(0, 1), a2 + hstepA, voffA);
            PG8_WAIT_L(8); PG8_BAR; PG8_WAIT_L(0); PG8_MMA(0, 0, At, B0); PG8_BAR; PG8_SCHED;
            PG8_LDB(B1, 1, 1); PG8_STAGE(PG8_SB(1, 0), b3, voffB);
            PG8_BAR; PG8_WAIT_L(0); PG8_MMA(0, 1, At, B1); PG8_BAR;
            PG8_LDA(At, 1, 1); PG8_STAGE(PG8_SA(1, 0), a3, voffA);
            PG8_BAR; PG8_WAIT_L(0); PG8_MMA(1, 0, At, B0); PG8_BAR; PG8_SCHED;
            PG8_STAGE(PG8_SB(1, 1), b3 + hstepB, voffB);
            PG8_WAIT_V(6); PG8_BAR; PG8_MMA(1, 1, At, B1); PG8_BAR;
            }
        }
        if constexpr (ALIGN_EPI) { if (wr == 0) PG8_BAR; }
        if constexpr (!Epi::AFTER_DRAIN) { E(acc, cur, wr, wc, fr, fq); S.done(cur); }
        if (!has_next) break;
#pragma unroll
        for (int a = 0; a < 2; ++a)
#pragma unroll
            for (int b = 0; b < 2; ++b)
#pragma unroll
                for (int m = 0; m < 4; ++m)
#pragma unroll
                    for (int n = 0; n < 2; ++n) acc[a][b][m][n] = (f32x4){0.f, 0.f, 0.f, 0.f};
        cur = nxt; cA = nA; cB = nB; ++ui;
        if constexpr (ALIGN_EPI) { if (wr == 1) PG8_BAR; }
    }
    PG8_WAIT_V(0);
    if constexpr (!ALIGN_EPI) { if (wr == 0) PG8_BAR; }
    PG8_BAR;
    if constexpr (Epi::AFTER_DRAIN) { E.fused(acc, cur, wr, wc, fr, fq, lds, wid, lane); S.done(cur); }
#undef PG8_SA
#undef PG8_SB
#undef PG8_STAGE
#undef PG8_LDA
#undef PG8_LDB
#undef PG8_MMA
#undef PG8_WAIT_V
#undef PG8_WAIT_L
#undef PG8_BAR
#undef PG8_SCHED
}
}

namespace att {
using bf16x8 = __attribute__((ext_vector_type(8))) short;
using u32x4 = __attribute__((ext_vector_type(4))) unsigned;
constexpr int D = 128, DR = 64, NW = 8, QBLK = 32, KVBLK = 64;
constexpr float SCALE = 0.07216878364870322f;
constexpr float THR = 8.f;
#ifndef ATT_SDEPTH
#define ATT_SDEPTH 1
#endif
#ifndef ATT_QROPE_LDS
#define ATT_QROPE_LDS 1
#endif
constexpr int SDEPTH = ATT_SDEPTH; constexpr bool QROPE_LDS = ATT_QROPE_LDS;
constexpr int LDQ = 1536, LDK = 128, LDR = 64, LDO = 2048;
constexpr int SHM_V = KVBLK * D * 2, SHM_K = KVBLK * D * 2, SHM_R = KVBLK * DR * 2;
constexpr int OFF_V = 0, OFF_K = 2 * SHM_V, OFF_R = OFF_K + 2 * SHM_K, OFF_WS = OFF_R + 2 * SHM_R, OFF_QR = OFF_WS + NW * 64 * 4, SHM_ATTN = OFF_QR + 256 * DR * 2;
#define KSWZ(row, colB) ((row) * 256 + ((colB) ^ (((row) & 7) << 4)))
#define RSWZ(row, colB) ((row) * 128 + ((colB) ^ ((((row) >> 1) & 7) << 4)))
#define SBAR() __builtin_amdgcn_sched_barrier(0)
__device__ __forceinline__ int crow(int r, int hi) { return (r & 3) + 8 * (r >> 2) + 4 * hi; }
__device__ __forceinline__ unsigned cvtpk(float lo, float hi) { unsigned r; asm volatile("v_cvt_pk_bf16_f32 %0, %1, %2" : "=v"(r) : "v"(lo), "v"(hi)); return r; }
__device__ __forceinline__ void partialSM(f32x16& p0, f32x16& p1, float& m_reg, float& mn, float& alpha) {
  constexpr float C = SCALE * 1.4426950408889634f;
  float pmax = p0[0]; for (int r = 1; r < 16; ++r) pmax = fmaxf(pmax, p0[r]); for (int r = 0; r < 16; ++r) pmax = fmaxf(pmax, p1[r]);
  { auto rr = __builtin_amdgcn_permlane32_swap(__float_as_uint(pmax), __float_as_uint(pmax), false, false);
    pmax = fmaxf(__uint_as_float(rr[0]), __uint_as_float(rr[1])); }
  if (__builtin_expect(__all(pmax - m_reg <= THR / SCALE), 1)) { mn = m_reg; alpha = 1.f; }
  else { mn = fmaxf(m_reg, pmax); alpha = __builtin_amdgcn_exp2f((m_reg - mn) * C); m_reg = mn; }
  float mnC = -mn * C;
  for (int r = 0; r < 16; ++r) p0[r] = fmaf(p0[r], C, mnC); for (int r = 0; r < 16; ++r) p1[r] = fmaf(p1[r], C, mnC);
  for (int r = 0; r < 16; ++r) p0[r] = __builtin_amdgcn_exp2f(p0[r]);
}
__device__ __forceinline__ void finishSM(f32x16& p0, f32x16& p1, float alpha, float& l_reg, bf16x8& pa0, bf16x8& pa1, bf16x8& pa2, bf16x8& pa3) {
  for (int r = 0; r < 16; ++r) p1[r] = __builtin_amdgcn_exp2f(p1[r]);
  float ps = 0; for (int r = 0; r < 16; ++r) ps += p0[r]; for (int r = 0; r < 16; ++r) ps += p1[r];
  { auto rr = __builtin_amdgcn_permlane32_swap(__float_as_uint(ps), __float_as_uint(ps), false, false);
    ps = __uint_as_float(rr[0]) + __uint_as_float(rr[1]); }
  l_reg = l_reg * alpha + ps;
#define PK4(P, BASE, OUT) do { unsigned a0 = cvtpk(P[BASE + 0], P[BASE + 1]), a1 = cvtpk(P[BASE + 2], P[BASE + 3]);   \
    unsigned b0 = cvtpk(P[BASE + 4], P[BASE + 5]), b1 = cvtpk(P[BASE + 6], P[BASE + 7]);                              \
    auto r0 = __builtin_amdgcn_permlane32_swap(a0, b0, false, false); auto r1 = __builtin_amdgcn_permlane32_swap(a1, b1, false, false); \
    u32x4 w = {r0[0], r1[0], r0[1], r1[1]}; OUT = *reinterpret_cast<bf16x8*>(&w); } while (0)
  PK4(p0, 0, pa0); PK4(p0, 8, pa1); PK4(p1, 0, pa2); PK4(p1, 8, pa3);
#undef PK4
}
__device__ __forceinline__ void qkt(f32x16& p0, f32x16& p1, const char* Ks, const char* Rs, const bf16x8* qr, int r32, int hi, const char* Qrs) {
  p0 = f32x16{}; p1 = f32x16{};
#pragma unroll
  for (int d0 = 0; d0 < 8; ++d0) { int cb = (d0 * 16 + hi * 8) * 2;
    bf16x8 b0 = *reinterpret_cast<const bf16x8*>(Ks + KSWZ(r32, cb));
    bf16x8 b1 = *reinterpret_cast<const bf16x8*>(Ks + KSWZ(32 + r32, cb));
    p0 = __builtin_amdgcn_mfma_f32_32x32x16_bf16(b0, qr[d0], p0, 0, 0, 0);
    p1 = __builtin_amdgcn_mfma_f32_32x32x16_bf16(b1, qr[d0], p1, 0, 0, 0);
#ifdef ATT_QK_SBAR
    if (d0 == 3 || d0 == 7) SBAR();
#endif
  }
#pragma unroll
  for (int d0 = 0; d0 < 4; ++d0) { int cb = (d0 * 16 + hi * 8) * 2;
    bf16x8 b0 = *reinterpret_cast<const bf16x8*>(Rs + d0 * 2048 + r32 * 32 + hi * 16);
    bf16x8 b1 = *reinterpret_cast<const bf16x8*>(Rs + d0 * 2048 + 1024 + r32 * 32 + hi * 16);
    bf16x8 qf; if constexpr (QROPE_LDS) qf = *reinterpret_cast<const bf16x8*>(Qrs + d0 * 8192); else qf = qr[8 + d0];
    p0 = __builtin_amdgcn_mfma_f32_32x32x16_bf16(b0, qf, p0, 0, 0, 0);
    p1 = __builtin_amdgcn_mfma_f32_32x32x16_bf16(b1, qf, p1, 0, 0, 0); }
}
__device__ __forceinline__ int v_st(int k, int c) { const int kk = (k & ~0xC) | ((k & 4) << 1) | ((k & 8) >> 1); return ((kk >> 3) * 4 + (c >> 5)) * 512 + ((kk & 7) * 32 + (c & 31)) * 2; }
__device__ __forceinline__ int v_rd_base(int lane) { return ((lane & 3) << 3) | (((lane >> 2) & 3) << 6) | (((lane >> 4) & 1) << 5) | (((lane >> 5) & 1) << 8); }
constexpr int v_rd_off(int d0, int ks, int half) { return d0 * 512 + ks * 4096 + half * 2048; }
template <int OFF> __device__ __forceinline__ s16x4 tr_read(int vb) {
  s16x4 r; asm volatile("ds_read_b64_tr_b16 %0, %1 offset:%2" : "=&v"(r) : "v"(vb), "i"(OFF) : "memory"); return r;
}
template <int D0> __device__ __forceinline__ void pv_one(f32x16& od, int vb, bf16x8 pa0, bf16x8 pa1, bf16x8 pa2, bf16x8 pa3) {
  const s16x4 l0 = tr_read<v_rd_off(D0, 0, 0)>(vb), h0 = tr_read<v_rd_off(D0, 0, 1)>(vb), l1 = tr_read<v_rd_off(D0, 1, 0)>(vb), h1 = tr_read<v_rd_off(D0, 1, 1)>(vb);
  const s16x4 l2 = tr_read<v_rd_off(D0, 2, 0)>(vb), h2 = tr_read<v_rd_off(D0, 2, 1)>(vb), l3 = tr_read<v_rd_off(D0, 3, 0)>(vb), h3 = tr_read<v_rd_off(D0, 3, 1)>(vb);
  asm volatile("s_waitcnt lgkmcnt(0)" ::: "memory"); SBAR();
#define PK(L, H) (bf16x8){L[0], L[1], L[2], L[3], H[0], H[1], H[2], H[3]}
  od = __builtin_amdgcn_mfma_f32_32x32x16_bf16(pa0, PK(l0, h0), od, 0, 0, 0);
  od = __builtin_amdgcn_mfma_f32_32x32x16_bf16(pa1, PK(l1, h1), od, 0, 0, 0);
  od = __builtin_amdgcn_mfma_f32_32x32x16_bf16(pa2, PK(l2, h2), od, 0, 0, 0);
  od = __builtin_amdgcn_mfma_f32_32x32x16_bf16(pa3, PK(l3, h3), od, 0, 0, 0);
#undef PK
}
__device__ __forceinline__ void pv_d0(f32x16* o, int vb, bf16x8 pa0, bf16x8 pa1, bf16x8 pa2, bf16x8 pa3) {
  pv_one<0>(o[0], vb, pa0, pa1, pa2, pa3); pv_one<1>(o[1], vb, pa0, pa1, pa2, pa3); pv_one<2>(o[2], vb, pa0, pa1, pa2, pa3); pv_one<3>(o[3], vb, pa0, pa1, pa2, pa3);
}
__device__ __forceinline__ void attn_dense_body(const bf16* __restrict__ Qb, const bf16* __restrict__ Kh, const bf16* __restrict__ Vh, const bf16* __restrict__ Rh,
                                                bf16* __restrict__ Ob, int seq, char* lds) {
  const int tid = threadIdx.x, wid = tid >> 6, lane = tid & 63, r32 = lane & 31, hi = lane >> 5;
  char* V_lds = lds + OFF_V; char* K_lds = lds + OFF_K; char* R_lds = lds + OFF_R;
  float* ws = (float*)(lds + OFF_WS) + wid * 64; float* li_l = ws; float* al_l = ws + 32;
  float m_reg = -1e30f, l_reg = 0; f32x16 o[4] = {}; bf16x8 qr[QROPE_LDS ? 8 : 12];
  int tq_ = threadIdx.x; asm volatile("" : "+v"(tq_));
  const bf16* Qw = (const bf16*)((const char*)Qb + (unsigned)((((tq_ >> 6) * QBLK + (tq_ & 31)) * LDQ + ((tq_ >> 5) & 1) * 8) * 2));
  const char* Qrs = lds + OFF_QR + (wid * QBLK + r32) * 32 + hi * 16;
#pragma unroll
  for (int d0 = 0; d0 < (QROPE_LDS ? 8 : 12); ++d0) qr[d0] = *reinterpret_cast<const bf16x8*>(Qw + d0 * 16);
  if constexpr (QROPE_LDS) {
#pragma unroll
    for (int d0 = 0; d0 < 4; ++d0) { const bf16x8 t = *reinterpret_cast<const bf16x8*>(Qw + 128 + d0 * 16); *(bf16x8*)(lds + OFF_QR + d0 * 8192 + (wid * QBLK + r32) * 32 + hi * 16) = t; }
    asm volatile("s_waitcnt lgkmcnt(0)" ::: "memory");
  }
  const int sr = tid >> 4, sc = (tid & 15) * 8, vst0 = v_st(sr, sc), vst1 = v_st(32 + sr, sc);
  const int rr_ = tid >> 3, rc_ = (tid & 7) * 8, rst_ = (rc_ >> 4) * 2048 + rr_ * 32 + (rc_ & 8) * 2;
  const int vb0 = (int)(uintptr_t)(V_lds) + v_rd_base(lane);
  struct { bf16x8 vs0, vs1, ks0, ks1, rs0; } sr_[SDEPTH];
  const unsigned kvo_ = (unsigned)((sr * LDK + sc) * 2), ro_ = (unsigned)((rr_ * LDR + rc_) * 2);
#define SLOAD(i, k0) do { const char* vb_ = (const char*)Vh + (size_t)(k0) * (LDK * 2); const char* kb_ = (const char*)Kh + (size_t)(k0) * (LDK * 2); const char* rb_ = (const char*)Rh + (size_t)(k0) * (LDR * 2); \
    sr_[i].vs0 = *(const bf16x8*)(vb_ + kvo_); sr_[i].vs1 = *(const bf16x8*)(vb_ + 32 * LDK * 2 + kvo_); \
    sr_[i].ks0 = *(const bf16x8*)(kb_ + kvo_); sr_[i].ks1 = *(const bf16x8*)(kb_ + 32 * LDK * 2 + kvo_); \
    sr_[i].rs0 = *(const bf16x8*)(rb_ + ro_); } while (0)
#define SWRITE(b, i) do { *(bf16x8*)(V_lds + (b) * SHM_V + vst0) = sr_[i].vs0;          \
    *(bf16x8*)(V_lds + (b) * SHM_V + vst1) = sr_[i].vs1; int kc = sc * 2;               \
    *(bf16x8*)(K_lds + (b) * SHM_K + KSWZ(sr, kc)) = sr_[i].ks0;                       \
    *(bf16x8*)(K_lds + (b) * SHM_K + KSWZ(32 + sr, kc)) = sr_[i].ks1;                  \
    *(bf16x8*)(R_lds + (b) * SHM_R + rst_) = sr_[i].rs0; } while (0)
#define SWAIT() do { if constexpr (SDEPTH == 2) asm volatile("s_waitcnt vmcnt(5)" ::: "memory"); else asm volatile("s_waitcnt vmcnt(0)" ::: "memory"); } while (0)
#define RESC(a) do { if (__any((a) < 1.f)) { if (hi == 0) al_l[r32] = (a); asm volatile("s_waitcnt lgkmcnt(0)" ::: "memory"); \
    for (int d = 0; d < 4; ++d) for (int r = 0; r < 16; ++r) o[d][r] *= al_l[crow(r, hi)]; } } while (0)
  f32x16 pA0, pA1, pB0, pB1; float mnA, mnB, alA, alB; bf16x8 pa0, pa1, pa2, pa3; const int NT = seq / KVBLK;
  constexpr int SE = 0, SO = SDEPTH - 1;
  SLOAD(SE, 0); asm volatile("s_waitcnt vmcnt(0)" ::: "memory"); SWRITE(0, SE); __syncthreads();
  qkt(pA0, pA1, K_lds, R_lds, qr, r32, hi, Qrs); partialSM(pA0, pA1, m_reg, mnA, alA);
  SLOAD(SO, KVBLK); if constexpr (SDEPTH == 2) { if (2 < NT) SLOAD(SE, 2 * KVBLK); }
  SWAIT(); SWRITE(1, SO); __syncthreads();
  for (int j = 1; j + 1 < NT; j += 2) {
    SBAR(); qkt(pB0, pB1, K_lds + SHM_K, R_lds + SHM_R, qr, r32, hi, Qrs);
    finishSM(pA0, pA1, alA, l_reg, pa0, pa1, pa2, pa3); SBAR();
    SLOAD(SO, (j + SDEPTH) * KVBLK); SBAR();
    pv_d0(o, vb0, pa0, pa1, pa2, pa3); partialSM(pB0, pB1, m_reg, mnB, alB);
    __syncthreads(); SWAIT(); SWRITE(0, SE);
    RESC(alB); __syncthreads();
    SBAR(); qkt(pA0, pA1, K_lds, R_lds, qr, r32, hi, Qrs);
    finishSM(pB0, pB1, alB, l_reg, pa0, pa1, pa2, pa3); SBAR();
    if (SDEPTH == 1 || j + 3 < NT) SLOAD(SE, (j + 1 + SDEPTH) * KVBLK); SBAR();
    pv_d0(o, vb0 + SHM_V, pa0, pa1, pa2, pa3); partialSM(pA0, pA1, m_reg, mnA, alA);
    __syncthreads(); SWAIT(); SWRITE(1, SO);
    RESC(alA); __syncthreads();
  }
  SBAR(); qkt(pB0, pB1, K_lds + SHM_K, R_lds + SHM_R, qr, r32, hi, Qrs);
  finishSM(pA0, pA1, alA, l_reg, pa0, pa1, pa2, pa3); SBAR();
  pv_d0(o, vb0, pa0, pa1, pa2, pa3); partialSM(pB0, pB1, m_reg, mnB, alB);
  __syncthreads(); RESC(alB);
  finishSM(pB0, pB1, alB, l_reg, pa0, pa1, pa2, pa3); SBAR();
  pv_d0(o, vb0 + SHM_V, pa0, pa1, pa2, pa3);
  if (hi == 0) li_l[r32] = l_reg; asm volatile("s_waitcnt lgkmcnt(0)" ::: "memory");
  float rli[16];
#pragma unroll
  for (int r = 0; r < 16; ++r) rli[r] = __builtin_amdgcn_rcpf(li_l[crow(r, hi)]);
  int tl_ = threadIdx.x; asm volatile("" : "+v"(tl_));
  const unsigned oo_ = (unsigned)((((tl_ >> 6) * QBLK + 4 * ((tl_ >> 5) & 1)) * LDO + (tl_ & 31)) * 2);
#pragma unroll
  for (int r = 0; r < 16; ++r) { const char* ob_ = (const char*)Ob + (size_t)(((r & 3) + 8 * (r >> 2)) * LDO * 2);
#pragma unroll
    for (int d0 = 0; d0 < 4; ++d0) { const unsigned w = cvtpk(o[d0][r] * rli[r], 0.f); *(bf16*)(ob_ + d0 * 64 + oo_) = (bf16)(w & 0xffffu); } }
  __syncthreads();
#undef SLOAD
#undef SWRITE
#undef SWAIT
#undef RESC
}
}


constexpr int NWAVES = 8, NTHR = 512;
constexpr int N_PHASES = 14;
#ifndef MK_N_LAUNCHES
#define MK_N_LAUNCHES 1
#endif
constexpr int N_LAUNCHES = MK_N_LAUNCHES;

constexpr size_t MiB = 1u << 20;
constexpr size_t WS_CTL = 0, CTL_ZERO_BYTES = 1 * MiB;
constexpr size_t WS_MODP = 1 * MiB, WS_MODF = 4 * MiB, WS_RSS = 5 * MiB, WS_ROUTE = 6 * MiB, WS_BON = 7 * MiB, WS_WRT = 8 * MiB, WS_LORA = 9 * MiB;
constexpr size_t WS_WTUQ = 10 * MiB, WS_WTUKV = 12 * MiB, WS_WTOUT = 13 * MiB, WS_WTIN = 21 * MiB;
constexpr size_t WS_SCAN = 40 * MiB, SCAN_ARR = (size_t)NB * RH * NKEY * RN * 2;
constexpr int A_R = 0, A_KK = 1, A_W = 2, A_K = 4, A_B = 6, A_V = 8;
constexpr size_t WS_H = 40 * MiB;
constexpr size_t WS_G = 337 * MiB;
constexpr size_t WS_P = 369 * MiB;
constexpr size_t WS_Q = 510 * MiB, WS_KN = 558 * MiB, WS_V = 591 * MiB, WS_KR = 624 * MiB;
constexpr size_t WS_MIX = 369 * MiB;
constexpr size_t WS_MN = 433 * MiB;
constexpr size_t WS_YS = 40 * MiB;
constexpr size_t WS_W13T = 168 * MiB, WS_W2T = 565 * MiB;
constexpr size_t WS_H2 = 40 * MiB, WS_XG = 296 * MiB, WS_HM = 456 * MiB, WS_Y = 296 * MiB;
constexpr size_t WS_END = 629 * MiB;
constexpr int NCHUNK = NKEY / 64;
static_assert(WS_SCAN + 9 * SCAN_ARR <= WS_G && WS_G + (size_t)MROWS * RW * 2 <= WS_P && WS_P + (size_t)MALL * NINP * 2 <= WS_Q, "ws map 1");
static_assert(WS_Q + (size_t)MROWS * 1536 * 2 <= WS_KN && WS_KN + (size_t)NB * 8 * NKEY * 128 * 2 <= WS_V && WS_V + (size_t)NB * 8 * NKEY * 128 * 2 <= WS_KR && WS_KR + (size_t)NB * NKEY * 64 * 2 <= WS_END, "ws map 2");
static_assert(WS_MIX + (size_t)MROWS * DM * 2 <= WS_MN && WS_MN + (size_t)NB * RH * NCHUNK * 2 * 16384 <= WS_W2T && WS_W2T + (size_t)NEXP * DM * DEXP * 2 <= WS_END, "ws map 3");
static_assert(WS_YS + (size_t)2 * MROWS * RW * 4 <= WS_W13T && WS_W13T + (size_t)NEXP * 1024 * DM * 2 <= WS_XG && WS_W13T >= WS_SCAN && WS_XG <= WS_SCAN + 8 * SCAN_ARR, "ws map 4: Y and W13T overlay only the scan inputs that are dead after the chunk builder");
static_assert(WS_H2 + (size_t)MROWS * DM * 2 <= WS_W13T && WS_XG + (size_t)MAXTILES * 256 * DM * 2 <= WS_HM && WS_HM + (size_t)MAXTILES * 256 * DEXP * 2 <= WS_W2T, "ws map 5");
static_assert(WS_WTIN + (size_t)NINP * DM * 2 <= WS_SCAN && WS_H + (size_t)MALL * DM * 2 <= WS_G, "ws map 6");
constexpr int CW_CNT = 64;
constexpr int CW_BAR = 4096;
constexpr size_t RT_E = 0, RT_POS = 131072, RT_GATE = 262144, RT_ROW = 393216, RT_RGATE = 524288;

constexpr int RING_BYTES = 131072, EXTRA_OFF = 131072, LDS_BYTES = 155648, MISC_OFF = LDS_BYTES - 512;
constexpr int LORA_IMG = 2 * 128 * 72 + 64 * 168;

#define LDS_WAIT() asm volatile("s_waitcnt lgkmcnt(0)" ::: "memory")
#define VM_WAIT() asm volatile("s_waitcnt vmcnt(0)" ::: "memory")
__device__ __forceinline__ unsigned f2bf(float f) { unsigned u = __builtin_bit_cast(unsigned, f); return (u + 0x7fffu + ((u >> 16) & 1u)) >> 16; }
__device__ __forceinline__ unsigned pk2(float lo, float hi) { return pg8::cvt_pk_bf16(lo, hi); }
__device__ __forceinline__ float bflo(unsigned w) { return __builtin_bit_cast(float, w << 16); }
__device__ __forceinline__ float bfhi(unsigned w) { return __builtin_bit_cast(float, w & 0xffff0000u); }
__device__ __forceinline__ float bf1(bf16 h) { return __builtin_bit_cast(float, (unsigned)h << 16); }
__device__ __forceinline__ void unpack8(const v4u w, float (&f)[8]) { f[0] = bflo(w.x); f[1] = bfhi(w.x); f[2] = bflo(w.y); f[3] = bfhi(w.y); f[4] = bflo(w.z); f[5] = bfhi(w.z); f[6] = bflo(w.w); f[7] = bfhi(w.w); }
__device__ __forceinline__ v4u pack8f(const float (&f)[8]) { v4u w; w.x = pk2(f[0], f[1]); w.y = pk2(f[2], f[3]); w.z = pk2(f[4], f[5]); w.w = pk2(f[6], f[7]); return w; }
__device__ __forceinline__ float wave_sum(float v) {
#pragma unroll
    for (int o = 1; o < 64; o <<= 1) v += __shfl_xor(v, o);
    return v;
}
__device__ __forceinline__ float sigmoidf_(float x) { return __builtin_amdgcn_rcpf(1.0f + __expf(-x)); }

template <int CTRL> __device__ __forceinline__ float dpp_add(float x) { return x + __builtin_bit_cast(float, __builtin_amdgcn_update_dpp(0, __builtin_bit_cast(int, x), CTRL, 0xf, 0xf, false)); }
__device__ __forceinline__ float red16(float x) { x = dpp_add<0xB1>(x); x = dpp_add<0x4E>(x); x = dpp_add<0x141>(x); x = dpp_add<0x140>(x); return x; }
#define MFMA_DRAIN() do { __builtin_amdgcn_sched_barrier(0); asm volatile("s_nop 15\n\ts_nop 15" ::: "memory"); __builtin_amdgcn_sched_barrier(0); } while (0)
#define XB_TMO      128
#define XB_XCNT(j)  (256  + 64 * (j))
#define XB_XSUB(j)  (1280 + 64 * (j))
#define XB_XGEN(j)  (2304 + 64 * (j))
#define XB_TOP      3328
#define XB_TOPGEN   3392
#define XCD_BAR_WORDS 3456
#define XB_SPIN_CAP (1u << 18)

__device__ __forceinline__ unsigned xb_ld(unsigned* p)              { return __hip_atomic_load(p, __ATOMIC_RELAXED, __HIP_MEMORY_SCOPE_AGENT); }
__device__ __forceinline__ unsigned xb_add(unsigned* p, unsigned v) { return __hip_atomic_fetch_add(p, v, __ATOMIC_RELAXED, __HIP_MEMORY_SCOPE_AGENT); }
__device__ __forceinline__ unsigned xb_xcc_id() { return (unsigned)__builtin_amdgcn_s_getreg((3 << 11) | 20) & 0xFu; }
#define XB_SPIN(cond, bar) do { unsigned _sp = 0; while (cond) { __builtin_amdgcn_s_sleep(1); \
    if ((++_sp & 255u) == 0u) { if (xb_ld(&(bar)[XB_TMO])) break; if (_sp > XB_SPIN_CAP) { atomicAdd(&(bar)[XB_TMO], 1u); break; } } } } while (0)

struct XcdBarrier {
    unsigned* bar; unsigned x;
    volatile LAS unsigned* st;
};

__device__ __forceinline__ XcdBarrier xcd_barrier_post(unsigned* bar, volatile LAS unsigned* st) {
    XcdBarrier b; b.bar = bar; b.x = xb_xcc_id(); b.st = st;
    if (threadIdx.x == 0) (void)xb_add(&bar[XB_XCNT(b.x)], 1u);
    return b;
}
__device__ __forceinline__ void xcd_barrier_complete(unsigned* bar, unsigned x, unsigned& nloc, unsigned& nx) {
    const unsigned G = gridDim.x * gridDim.y * gridDim.z;
    unsigned sum, cnt, mine, sp = 0u;
    for (;;) {
        sum = 0u; cnt = 0u; mine = 0u;
#pragma unroll
        for (unsigned j = 0; j < 16; ++j) { const unsigned c = xb_ld(&bar[XB_XCNT(j)]); sum += c; cnt += (c > 0u) ? 1u : 0u; mine = (j == x) ? c : mine; }
        if (sum == G) break;
        __builtin_amdgcn_s_sleep(1);
        if ((++sp & 255u) == 0u) { if (xb_ld(&bar[XB_TMO])) break; if (sp > XB_SPIN_CAP) { atomicAdd(&bar[XB_TMO], 1u); break; } }
    }
    nloc = mine > 0u ? mine : 1u; nx = cnt > 0u ? cnt : 1u;
}

__device__ __forceinline__ void xcd_barrier(const XcdBarrier& b) {
    asm volatile("s_waitcnt vmcnt(0)" ::: "memory");
    __syncthreads();
    if (threadIdx.x == 0) {
        unsigned* bar = b.bar;
        __builtin_amdgcn_s_waitcnt(0);
        unsigned nloc = b.st[0], nx = b.st[1];
        if (nloc == 0u) { xcd_barrier_complete(bar, b.x, nloc, nx); b.st[0] = nloc; b.st[1] = nx; }
        const unsigned old = xb_add(&bar[XB_XSUB(b.x)], 1u);
        const unsigned gen = old / nloc;
        if (old + 1u == (gen + 1u) * nloc) {
            __builtin_amdgcn_fence(__ATOMIC_RELEASE, "agent");
            asm volatile("s_waitcnt vmcnt(0)" ::: "memory");
            const unsigned og = xb_add(&bar[XB_TOP], 1u);
            const unsigned tg = og / nx;
            if (og + 1u == (tg + 1u) * nx) xb_add(&bar[XB_TOPGEN], 1u);
            else XB_SPIN(xb_ld(&bar[XB_TOPGEN]) == tg, bar);
            __builtin_amdgcn_fence(__ATOMIC_ACQUIRE, "agent");
            xb_add(&bar[XB_XGEN(b.x)], 1u);
            asm volatile("s_waitcnt vmcnt(0)" ::: "memory");
        } else {
            XB_SPIN(xb_ld(&bar[XB_XGEN(b.x)]) == gen, bar);
            __builtin_amdgcn_fence(__ATOMIC_ACQUIRE, "agent");
            asm volatile("s_waitcnt vmcnt(0)" ::: "memory");
        }
    }
    __syncthreads();
}

struct Frame {
    char* lds;
    volatile LAS unsigned* MISC;
    unsigned* ctl;
    unsigned char* ws;
    int tid, lane, wave, G, bid;
    const float* const __attribute__((address_space(4)))* in;
    float* out;
};

__device__ __forceinline__ void transpose_item(const float* W, int K, int N, bf16* WT, int row_off, const float* kscale, float* scr, int item, int lane) {
    const int nblk = N / 32, kb = item / nblk, nb = item % nblk, k0 = 64 * kb, n0 = 32 * nb;
    float tv[32];
#pragma unroll
    for (int i = 0; i < 32; ++i) tv[i] = W[(size_t)(k0 + 2 * i + (lane >> 5)) * N + n0 + (lane & 31)];
#pragma unroll
    for (int i = 0; i < 32; ++i) { const int kk = 2 * i + (lane >> 5); float v = tv[i]; if (kscale) v *= kscale[k0 + kk]; scr[kk * 33 + (lane & 31)] = v; }
    LDS_WAIT(); asm volatile("" ::: "memory");
    const int c = lane & 7;
#pragma unroll
    for (int j = 0; j < 4; ++j) { const int n = (lane >> 3) + 8 * j; const float* s = scr + (8 * c) * 33 + n;
        v4u o; o.x = pk2(s[0 * 33], s[1 * 33]); o.y = pk2(s[2 * 33], s[3 * 33]); o.z = pk2(s[4 * 33], s[5 * 33]); o.w = pk2(s[6 * 33], s[7 * 33]);
        *(v4u*)(WT + (size_t)(row_off + n0 + n) * K + k0 + 8 * c) = o; }
    LDS_WAIT(); asm volatile("" ::: "memory");
}

__device__ __forceinline__ void small_conversions(Frame& F, const int gt, const int NGT) {
    { bf16* wr = (bf16*)(F.ws + WS_WRT);
      for (int i = gt; i < 48 * DM; i += NGT) { const int n = i / DM, k = i - n * DM; float v = 0.f; if (n < 4) v = F.in[25][k * 4 + n]; else if (n < 36) v = F.in[27][k * 32 + (n - 4)]; wr[i] = (bf16)f2bf(v); } }
    { bf16* lw = (bf16*)(F.ws + WS_LORA);
      for (int i = gt; i < RH * LORA_IMG; i += NGT) { const int h = i / LORA_IMG, o = i - h * LORA_IMG; float v = 0.f;
          if (o < 2 * 128 * 72) { const int which = o / (128 * 72), oo = o - which * 128 * 72, r = oo / 72, k = oo - r * 72;
              if (k < 64) v = F.in[which ? 17 : 15][(size_t)((r >> 6) * 64 + k) * RW + h * 64 + (r & 63)]; }
          else { const int oo = o - 2 * 128 * 72, ch = oo / 168, k = oo - ch * 168; if (k < 160) v = F.in[18][(size_t)k * RW + h * 64 + ch]; }
          lw[i] = (bf16)f2bf(v); } }
}

__device__ __forceinline__ void phase0(Frame& F) {
    float* st = (float*)F.lds;
    for (int i = F.tid; i < 3 * DM; i += NTHR) { const int j = i / DM, k = i - j * DM; const float v = j < 2 ? F.in[1][j * DM + k] : F.in[3][k]; st[i] = v * sigmoidf_(v); }
    __syncthreads();
    const int gw = F.bid * NWAVES + F.wave, NGW = F.G * NWAVES;
    const float* wmod = F.in[4]; float* modp = (float*)(F.ws + WS_MODP);
    for (int it = gw; it < 768; it += NGW) {
        const int cc = it % 48, ks = it / 48, n0 = cc * 256 + F.lane * 4;
        pg8::f32x4 a0 = {0.f, 0.f, 0.f, 0.f}, a1 = a0, a2 = a0;
        const float* wp = wmod + (size_t)(ks * 128) * (6 * DM) + n0;
#pragma unroll 8
        for (int k = 0; k < 128; ++k) { const pg8::f32x4 w = *(const pg8::f32x4*)(wp + (size_t)k * (6 * DM)); const int kk = ks * 128 + k;
            a0 += w * st[kk]; a1 += w * st[DM + kk]; a2 += w * st[2 * DM + kk]; }
        *(pg8::f32x4*)(modp + (size_t)(ks * 3 + 0) * (6 * DM) + n0) = a0; *(pg8::f32x4*)(modp + (size_t)(ks * 3 + 1) * (6 * DM) + n0) = a1; *(pg8::f32x4*)(modp + (size_t)(ks * 3 + 2) * (6 * DM) + n0) = a2;
    }
    __syncthreads();
    float* scr = (float*)(F.lds + F.wave * 8448);
    constexpr int I_IN = (DM / 64) * (NIN / 32), I_UQ = (512 / 64) * (1536 / 32), I_UKV = (256 / 64) * (2048 / 32), I_OUT = (DM / 64) * (DM / 32);
    for (int it = gw; it < I_IN + I_UQ + I_UKV + I_OUT; it += NGW) {
        int r = it;
        if (r < I_IN) { transpose_item(F.in[8], DM, NIN, (bf16*)(F.ws + WS_WTIN), 0, nullptr, scr, r, F.lane); continue; } r -= I_IN;
        if (r < I_UQ) { transpose_item(F.in[11], 512, 1536, (bf16*)(F.ws + WS_WTUQ), 0, F.in[10], scr, r, F.lane); continue; } r -= I_UQ;
        if (r < I_UKV) { transpose_item(F.in[13], 256, 2048, (bf16*)(F.ws + WS_WTUKV), 0, F.in[12], scr, r, F.lane); continue; } r -= I_UKV;
        transpose_item(F.in[24], DM, DM, (bf16*)(F.ws + WS_WTOUT), 0, nullptr, scr, r, F.lane);
    }
    const int gt = F.bid * NTHR + F.tid, NGT = F.G * NTHR;
    { v4u* z = (v4u*)((bf16*)(F.ws + WS_WTIN) + (size_t)NIN * DM); const v4u zero = {0u, 0u, 0u, 0u};
      for (int i = gt; i < (NINP - NIN) * DM / 8; i += NGT) z[i] = zero; }
    small_conversions(F, gt, NGT);
}

__device__ __forceinline__ void phase1(Frame& F) {
    float* sft = (float*)F.lds; float* scl = sft + 3 * DM;
    const float* modp = (const float*)(F.ws + WS_MODP); const float* bmod = F.in[5]; const float* gat = F.in[6];
    for (int i = F.tid; i < 3 * 2 * DM; i += NTHR) { const int j = i / (2 * DM), n = i - j * 2 * DM; float s = bmod[n];
        for (int ks = 0; ks < 16; ++ks) s += modp[(size_t)(ks * 3 + j) * (6 * DM) + n];
        if (n < DM) sft[j * DM + n] = s; else scl[j * DM + n - DM] = gat[n - DM] * (1.0f + s); }
    if (F.bid < 144 && F.tid < 256) { const int j = F.bid / 48, n = (F.bid % 48) * 256 + F.tid; float s = bmod[n];
        for (int ks = 0; ks < 16; ++ks) s += modp[(size_t)(ks * 3 + j) * (6 * DM) + n];
        ((float*)(F.ws + WS_MODF))[j * 6 * DM + n] = s; }
    __syncthreads();
    const int gw = F.bid * NWAVES + F.wave, NGW = F.G * NWAVES;
    bf16* H = (bf16*)(F.ws + WS_H);
    for (int m = gw; m < MALL; m += NGW) {
        const int j = m < T ? 0 : (m < MROWS ? 1 : 2);
        const float* xr = m < MROWS ? F.in[0] + (size_t)m * DM : F.in[2] + (size_t)(m - MROWS) * DM;
        pg8::f32x4 v[8]; float s = 0.f;
#pragma unroll
        for (int q = 0; q < 8; ++q) { v[q] = *(const pg8::f32x4*)(xr + q * 256 + F.lane * 4); s += pg8::dot4(v[q]); }
        const float rstd = __builtin_amdgcn_rsqf(wave_sum(s) * (1.0f / DM) + 1e-6f);
#pragma unroll
        for (int q = 0; q < 8; ++q) { const int c = q * 256 + F.lane * 4; const pg8::f32x4 sc = *(const pg8::f32x4*)(scl + j * DM + c), sh = *(const pg8::f32x4*)(sft + j * DM + c);
            const pg8::f32x4 o = v[q] * rstd * sc + sh; v2u w; w.x = pk2(o[0], o[1]); w.y = pk2(o[2], o[3]); *(v2u*)(H + (size_t)m * DM + c) = w; }
    }
}

__device__ __forceinline__ void rwkv_prep_tile(Frame& F, int tile, int h_begin, int h_end) {
    const bf16* P = (const bf16*)(F.ws + WS_P); const float* mu = F.in[9];
    const int m0 = tile * 64;
    const bool isctx = m0 >= MROWS; const int seqlen = isctx ? TC : T;
    const int b = isctx ? (m0 - MROWS) >> 8 : m0 >> 13, t0 = isctx ? (m0 - MROWS) & 255 : m0 & (T - 1), pos0 = isctx ? T + t0 : t0;
    bf16* XW = (bf16*)F.lds; bf16* XA = XW + 64 * 72; bf16* XGt = XA + 64 * 72; float* KS = (float*)(XGt + 64 * 168); float* KKS = KS + 64 * 64; float* KSUM = KKS + 64 * 64;
    for (int i = F.tid; i < 64 * 44; i += NTHR) {
        const int tk = i / 44, gq = i - tk * 44; const int t = t0 + tk; const size_t row = (size_t)(m0 + tk);
        if (gq < 36) {
            const int col = C_WL + gq * 8;
            float c[8], p[8], n[8], o[8];
            unpack8(*(const v4u*)(P + row * NINP + col), c);
            if (t > 0) unpack8(*(const v4u*)(P + (row - 1) * NINP + col), p); else { for (int e = 0; e < 8; ++e) p[e] = 0.f; }
            if (t < seqlen - 1) unpack8(*(const v4u*)(P + (row + 1) * NINP + col), n); else { for (int e = 0; e < 8; ++e) n[e] = 0.f; }
#pragma unroll
            for (int e = 0; e < 8; ++e) { const int rc = col - C_R + e; const float s = c[e] + mu[rc] * (p[e] - c[e]) + mu[3360 + rc] * (n[e] - c[e]);
                o[e] = gq < 8 ? 1.0f - 2.0f * __builtin_amdgcn_rcpf(1.0f + __expf(2.0f * s)) : (gq < 16 ? s : sigmoidf_(s)); }
            bf16* dst = gq < 8 ? XW + tk * 72 + gq * 8 : (gq < 16 ? XA + tk * 72 + (gq - 8) * 8 : XGt + tk * 168 + (gq - 16) * 8);
            *(v4u*)dst = pack8f(o);
        } else if (h_begin == 0) {
            const int g8 = gq - 36, half = g8 >> 2, j0 = (g8 & 3) * 8;
            float x[8], y[8], o[8];
            unpack8(*(const v4u*)(P + row * NINP + C_KR + half * 32 + j0), x);
            unpack8(*(const v4u*)(P + row * NINP + C_KR + half * 32 + (j0 ^ 16)), y);
            if (isctx) { for (int e = 0; e < 8; ++e) o[e] = x[e]; }
            else { const float pos = half == 0 ? (float)(t >> 6) : (float)(t & 63);
#pragma unroll
                for (int e = 0; e < 8; ++e) { const int jf = (j0 & 15) + e; float r = pos * (__builtin_amdgcn_exp2f(-(float)jf * 0.83048202372184059f) * 0.15915494309189535f); r = r - __builtin_floorf(r);
                    const float sn = __builtin_amdgcn_sinf(r), cs = __builtin_amdgcn_cosf(r);
                    o[e] = j0 < 16 ? x[e] * cs - y[e] * sn : y[e] * sn + x[e] * cs; } }
            *(v4u*)((bf16*)(F.ws + WS_KR) + ((size_t)b * NKEY + pos0 + tk) * 64 + half * 32 + j0) = pack8f(o);
        }
    }
    __syncthreads();
    const float* w0 = F.in[14]; const float* a0 = F.in[16]; const float* keyk = F.in[19]; const float* keya = F.in[20];
    const int fr = F.lane & 15, fq = F.lane >> 4;
    char* WIMG = (char*)(KSUM + 64 * 64);
    const bf16* IMG = (const bf16*)(F.ws + WS_LORA);
    constexpr int NPIECE = LORA_IMG / 8;
    const int tkB = F.tid >> 3, c8B = (F.tid & 7) * 8, tB = t0 + tkB; const size_t rowB = (size_t)(m0 + tkB);
    const bool hasp = tB > 0, hasn = tB < seqlen - 1;
    v4u pb[9], wp[8];
    const v4u z4 = {0u, 0u, 0u, 0u};
    auto load_pb = [&](int h) {
#pragma unroll
        for (int a = 0; a < 3; ++a) { const int col = (a == 0 ? C_R : (a == 1 ? C_K : C_V)) + h * 64 + c8B; const bf16* pc = P + rowB * NINP + col;
            pb[3 * a] = *(const v4u*)pc; pb[3 * a + 1] = hasp ? *(const v4u*)(pc - NINP) : z4; pb[3 * a + 2] = hasn ? *(const v4u*)(pc + NINP) : z4; } };
    auto load_wp = [&](int h) {
#pragma unroll
        for (int q = 0; q < 8; ++q) { const int i = F.tid + NTHR * q; wp[q] = i < NPIECE ? *(const v4u*)(IMG + (size_t)h * LORA_IMG + i * 8) : z4; } };
#ifndef PREP_NOPF
    load_pb(h_begin); load_wp(h_begin);
#endif
#pragma unroll 1
    for (int h = h_begin; h < h_end; ++h) {
        const size_t hb = ((size_t)(b * RH + h) * NKEY + pos0) * RN;
#ifdef PREP_NOPF
        load_pb(h); load_wp(h);
#endif
#pragma unroll
        for (int q = 0; q < 8; ++q) { const int i = F.tid + NTHR * q; if (i < NPIECE) *(v4u*)(WIMG + i * 16) = wp[q]; }
        float rs8[8];
        {
            float sh[3][8];
#pragma unroll
            for (int a = 0; a < 3; ++a) { const int col = (a == 0 ? C_R : (a == 1 ? C_K : C_V)) + h * 64 + c8B; float c[8], pp[8], n[8];
                unpack8(pb[3 * a], c); unpack8(pb[3 * a + 1], pp); unpack8(pb[3 * a + 2], n);
#pragma unroll
                for (int e = 0; e < 8; ++e) { const int rc = col - C_R + e; sh[a][e] = c[e] + mu[rc] * (pp[e] - c[e]) + mu[3360 + rc] * (n[e] - c[e]); } }
            *(v4u*)((bf16*)(F.ws + WS_SCAN + A_R * SCAN_ARR) + hb + tkB * 64 + c8B) = pack8f(sh[0]);
            *(v4u*)((bf16*)(F.ws + WS_SCAN + A_V * SCAN_ARR) + hb + tkB * 64 + c8B) = pack8f(sh[2]);
#pragma unroll
            for (int e = 0; e < 8; ++e) rs8[e] = sh[0][e];
            float kk[8], ss = 0.f;
#pragma unroll
            for (int e = 0; e < 8; ++e) { kk[e] = sh[1][e] * keyk[h * 64 + c8B + e]; ss += kk[e] * kk[e]; }
            ss += __shfl_xor(ss, 1); ss += __shfl_xor(ss, 2); ss += __shfl_xor(ss, 4);
            const float rn = __builtin_amdgcn_rsqf(ss + 1e-12f);
#pragma unroll
            for (int e = 0; e < 8; ++e) kk[e] *= rn;
            *(pg8::f32x4*)(KS + tkB * 64 + c8B) = (pg8::f32x4){sh[1][0], sh[1][1], sh[1][2], sh[1][3]}; *(pg8::f32x4*)(KS + tkB * 64 + c8B + 4) = (pg8::f32x4){sh[1][4], sh[1][5], sh[1][6], sh[1][7]};
            *(pg8::f32x4*)(KKS + tkB * 64 + c8B) = (pg8::f32x4){kk[0], kk[1], kk[2], kk[3]}; *(pg8::f32x4*)(KKS + tkB * 64 + c8B + 4) = (pg8::f32x4){kk[4], kk[5], kk[6], kk[7]};
            *(v4u*)((bf16*)(F.ws + WS_SCAN + A_KK * SCAN_ARR) + hb + tkB * 64 + c8B) = pack8f(kk);
        }
#ifndef PREP_NOPF
        if (h + 1 < h_end) { load_pb(h + 1); load_wp(h + 1); }
#endif
        __syncthreads();
        {
            const int tb = F.wave & 3, cbp = F.wave >> 2;
            pg8::bf16x8 xw[2], xa[2], xg[5];
#pragma unroll
            for (int kb = 0; kb < 2; ++kb) { xw[kb] = *(const pg8::bf16x8*)(XW + (tb * 16 + fr) * 72 + kb * 32 + fq * 8); xa[kb] = *(const pg8::bf16x8*)(XA + (tb * 16 + fr) * 72 + kb * 32 + fq * 8); }
#pragma unroll
            for (int kb = 0; kb < 5; ++kb) xg[kb] = *(const pg8::bf16x8*)(XGt + (tb * 16 + fr) * 168 + kb * 32 + fq * 8);
            pg8::f32x4 dw[2][2], da[2][2], dg[2];
#pragma unroll
            for (int cbi = 0; cbi < 2; ++cbi) { const int chl = cbp * 32 + 8 * (fr >> 2) + 4 * cbi + (fr & 3);
                dg[cbi] = (pg8::f32x4){0.f, 0.f, 0.f, 0.f};
#pragma unroll
                for (int d = 0; d < 2; ++d) { dw[cbi][d] = (pg8::f32x4){0.f, 0.f, 0.f, 0.f}; da[cbi][d] = dw[cbi][d];
#pragma unroll
                    for (int kb = 0; kb < 2; ++kb) {
                        const pg8::bf16x8 fw = *(const pg8::bf16x8*)(WIMG + ((d * 64 + chl) * 72 + kb * 32 + fq * 8) * 2);
                        const pg8::bf16x8 fa = *(const pg8::bf16x8*)(WIMG + (128 * 72 + (d * 64 + chl) * 72 + kb * 32 + fq * 8) * 2);
                        dw[cbi][d] = __builtin_amdgcn_mfma_f32_16x16x32_bf16(fw, xw[kb], dw[cbi][d], 0, 0, 0);
                        da[cbi][d] = __builtin_amdgcn_mfma_f32_16x16x32_bf16(fa, xa[kb], da[cbi][d], 0, 0, 0); } }
#pragma unroll
                for (int kb = 0; kb < 5; ++kb) { const pg8::bf16x8 fg = *(const pg8::bf16x8*)(WIMG + (2 * 128 * 72 + chl * 168 + kb * 32 + fq * 8) * 2); dg[cbi] = __builtin_amdgcn_mfma_f32_16x16x32_bf16(fg, xg[kb], dg[cbi], 0, 0, 0); } }
            MFMA_DRAIN();
            asm volatile("s_nop 1" : "+v"(dw[0][0]), "+v"(dw[0][1]), "+v"(dw[1][0]), "+v"(dw[1][1]), "+v"(da[0][0]), "+v"(da[0][1]), "+v"(da[1][0]), "+v"(da[1][1]), "+v"(dg[0]), "+v"(dg[1]));
            __builtin_amdgcn_sched_barrier(0);
            const int tk = tb * 16 + fr, c8 = cbp * 32 + 8 * fq, cg = h * 64 + c8;
            float ks[8], kk[8], ka[8], ksum[8];
            { const pg8::f32x4 a0_ = *(const pg8::f32x4*)(KS + tk * 64 + c8), a1_ = *(const pg8::f32x4*)(KS + tk * 64 + c8 + 4), b0_ = *(const pg8::f32x4*)(KKS + tk * 64 + c8), b1_ = *(const pg8::f32x4*)(KKS + tk * 64 + c8 + 4);
              const pg8::f32x4 c0_ = *(const pg8::f32x4*)(keya + cg), c1_ = *(const pg8::f32x4*)(keya + cg + 4);
#pragma unroll
              for (int j = 0; j < 4; ++j) { ks[j] = a0_[j]; ks[4 + j] = a1_[j]; kk[j] = b0_[j]; kk[4 + j] = b1_[j]; ka[j] = c0_[j]; ka[4 + j] = c1_[j]; ksum[j] = 0.f; ksum[4 + j] = 0.f; } }
#pragma unroll
            for (int d = 0; d < 2; ++d) { float w0e[8], a0e[8], dec[8], kd[8], bd[8];
                { const pg8::f32x4 p0_ = *(const pg8::f32x4*)(w0 + d * RW + cg), p1_ = *(const pg8::f32x4*)(w0 + d * RW + cg + 4), q0_ = *(const pg8::f32x4*)(a0 + d * RW + cg), q1_ = *(const pg8::f32x4*)(a0 + d * RW + cg + 4);
#pragma unroll
                  for (int j = 0; j < 4; ++j) { w0e[j] = p0_[j]; w0e[4 + j] = p1_[j]; a0e[j] = q0_[j]; a0e[4 + j] = q1_[j]; } }
#pragma unroll
                for (int e = 0; e < 8; ++e) { const int cbi = e >> 2, j = e & 3; const float wr = w0e[e] + dw[cbi][d][j]; dec[e] = __expf(-0.60653065971263342f * sigmoidf_(wr));
                    const float eta = sigmoidf_(a0e[e] + da[cbi][d][j]); kd[e] = ks[e] * (1.0f + (eta - 1.0f) * ka[e]); bd[e] = kk[e] * eta; ksum[e] += kd[e]; }
                *(v4u*)((bf16*)(F.ws + WS_SCAN + (A_W + d) * SCAN_ARR) + hb + tk * 64 + c8) = pack8f(dec);
                *(v4u*)((bf16*)(F.ws + WS_SCAN + (A_K + d) * SCAN_ARR) + hb + tk * 64 + c8) = pack8f(kd);
                *(v4u*)((bf16*)(F.ws + WS_SCAN + (A_B + d) * SCAN_ARR) + hb + tk * 64 + c8) = pack8f(bd); }
            *(pg8::f32x4*)(KSUM + tk * 64 + c8) = (pg8::f32x4){ksum[0], ksum[1], ksum[2], ksum[3]}; *(pg8::f32x4*)(KSUM + tk * 64 + c8 + 4) = (pg8::f32x4){ksum[4], ksum[5], ksum[6], ksum[7]};
            if (!isctx) { float g8[8];
#pragma unroll
                for (int e = 0; e < 8; ++e) g8[e] = dg[e >> 2][e & 3];
                *(v4u*)((bf16*)(F.ws + WS_G) + ((size_t)(b * RH + h) * T + t0 + tk) * RN + c8) = pack8f(g8); }
        }
        __syncthreads();
        if (!isctx) { const float* rk = F.in[21] + h * 64 + c8B; float bon = 0.f;
#pragma unroll
            for (int e = 0; e < 8; ++e) bon += rs8[e] * KSUM[tkB * 64 + c8B + e] * rk[e];
            bon += __shfl_xor(bon, 1); bon += __shfl_xor(bon, 2); bon += __shfl_xor(bon, 4);
            if ((F.tid & 7) == 0) ((float*)(F.ws + WS_BON))[(size_t)(b * RH + h) * T + t0 + tkB] = bon; }
        __syncthreads();
    }
    __syncthreads();
}

constexpr int CB_AT = 0, CB_BT = 9216, CB_KT = 18432, CB_RT = 27648, CB_AC = 36864, CB_VC = 46080, CB_BHC = 55296, CB_KHC = 64512, CB_AAB = 73728  ,
              CB_AAK = 90112, CB_BRB = 99328, CB_BRK = 108544, CB_TT = 117760, CB_T1T = EXTRA_OFF + 1024  , CB_P1T = CB_T1T + 2560, CB_GC = CB_P1T + 2560  ;
constexpr int CB_W1T = CB_AT, CB_G1T = CB_BT, CB_W2T = CB_KT;
static_assert(CB_TT + 9216 <= RING_BYTES && CB_GC + 256 <= LDS_BYTES, "chunk builder LDS map");
#define MFMA_PAD1(a) do { MFMA_DRAIN(); asm volatile("s_nop 1" : "+v"(a)); } while (0)
__device__ __forceinline__ bf16 tobf(float x) { return (bf16)(pk2(x, x) & 0xffffu); }
__device__ __forceinline__ pg8::f32x4 mm64(const char* A, const char* B, int arow, int brow, int fq, pg8::f32x4 acc) {
#pragma unroll
    for (int kb = 0; kb < 2; ++kb) acc = __builtin_amdgcn_mfma_f32_16x16x32_bf16(*(const pg8::bf16x8*)(A + arow * 144 + kb * 64 + fq * 16), *(const pg8::bf16x8*)(B + brow * 144 + kb * 64 + fq * 16), acc, 0, 0, 0);
    return acc;
}
template <int CTRL, int ROWMASK> __device__ __forceinline__ float dpp_get0(float x) { return __builtin_bit_cast(float, __builtin_amdgcn_update_dpp(0, __builtin_bit_cast(int, x), CTRL, ROWMASK, 0xf, false)); }
__device__ __forceinline__ float wave_incl_scan(float x) {
    x += dpp_get0<0x111, 0xf>(x); x += dpp_get0<0x112, 0xf>(x); x += dpp_get0<0x114, 0xf>(x); x += dpp_get0<0x118, 0xf>(x);
    x += dpp_get0<0x142, 0xa>(x); x += dpp_get0<0x143, 0xc>(x); return x;
}
#define LBAR() do { asm volatile("s_waitcnt lgkmcnt(0)" ::: "memory"); __builtin_amdgcn_s_barrier(); asm volatile("" ::: "memory"); } while (0)
#define PAD8(a) MFMA_DRAIN(); asm volatile("s_nop 1" : "+v"(a[0]), "+v"(a[1]), "+v"(a[2]), "+v"(a[3]), "+v"(a[4]), "+v"(a[5]), "+v"(a[6]), "+v"(a[7]))
#define PAD4(a) MFMA_DRAIN(); asm volatile("s_nop 1" : "+v"(a[0]), "+v"(a[1]), "+v"(a[2]), "+v"(a[3]))
struct ChunkRaw { v4u r, kk, w, k, be, v; };
__device__ __forceinline__ void chunk_raw_load(Frame& F, int it, ChunkRaw& c) {
    const int dir = it & 1, qq = it >> 1, cg = qq % NCHUNK, bh = qq / NCHUNK; const int tau = F.lane, nat = dir == 0 ? tau : 63 - tau;
    const size_t off = ((size_t)bh * NKEY + cg * 64 + nat) * RN + F.wave * 8;
    c.r = *(const v4u*)((const bf16*)(F.ws + WS_SCAN + A_R * SCAN_ARR) + off); c.kk = *(const v4u*)((const bf16*)(F.ws + WS_SCAN + A_KK * SCAN_ARR) + off);
    c.w = *(const v4u*)((const bf16*)(F.ws + WS_SCAN + (A_W + dir) * SCAN_ARR) + off); c.k = *(const v4u*)((const bf16*)(F.ws + WS_SCAN + (A_K + dir) * SCAN_ARR) + off);
    c.be = *(const v4u*)((const bf16*)(F.ws + WS_SCAN + (A_B + dir) * SCAN_ARR) + off); c.v = *(const v4u*)((const bf16*)(F.ws + WS_SCAN + A_V * SCAN_ARR) + off);
}
#ifndef BUILD_DUP
#define BUILD_DUP 0
#endif
#define BREP(k) for (int rep_ = 0; rep_ < ((BUILD_DUP == (k)) ? 2 : 1); ++rep_)
__device__ __forceinline__ void chunk_build_item(Frame& F, int it, const ChunkRaw& cur, int it_next, int it_end, ChunkRaw& nxt) {
    const int dir = it & 1, qq = it >> 1, cg = qq % NCHUNK, bh = qq / NCHUNK;
    int lane_ = F.lane; asm volatile("" : "+v"(lane_));
    char* L = F.lds; const int lane = lane_, wave = F.wave, fr = lane & 15, fq = lane >> 4;
    const pg8::f32x4 zero4 = {0.f, 0.f, 0.f, 0.f};
    BREP(1) {
        const int tau = lane, cw = wave * 8;
        float r[8], kk[8], w[8], k[8], be[8], v[8];
        unpack8(cur.r, r); unpack8(cur.kk, kk); unpack8(cur.w, w); unpack8(cur.k, k); unpack8(cur.be, be); unpack8(cur.v, v);
        float at[8], bt[8], kt[8], rt[8], bhh[8], khh[8];
#pragma unroll
        for (int e = 0; e < 8; ++e) { const float lw = __logf(w[e]), lin = wave_incl_scan(lw);
            const float gcl = __builtin_bit_cast(float, __builtin_amdgcn_readlane(__builtin_bit_cast(int, lin), 63));
            const float ea = __expf(lin - lw), ei = __expf(-lin), eg = __expf(lin), gr = __expf(gcl - lin);
            at[e] = -kk[e] * ea; bt[e] = be[e] * ei; kt[e] = k[e] * ei; rt[e] = r[e] * eg; bhh[e] = be[e] * gr; khh[e] = k[e] * gr;
            if (lane == 63) ((float*)(L + CB_GC))[cw + e] = __expf(gcl); }
        *(v4u*)(L + CB_AT + tau * 144 + cw * 2) = pack8f(at); *(v4u*)(L + CB_BT + tau * 144 + cw * 2) = pack8f(bt);
        *(v4u*)(L + CB_KT + tau * 144 + cw * 2) = pack8f(kt); *(v4u*)(L + CB_RT + tau * 144 + cw * 2) = pack8f(rt);
#pragma unroll
        for (int e = 0; e < 8; ++e) { const int o = ((cw + e) * 72 + tau) * 2;
            *(bf16*)(L + CB_AC + o) = tobf(at[e]); *(bf16*)(L + CB_VC + o) = tobf(v[e]); *(bf16*)(L + CB_BHC + o) = tobf(bhh[e]); *(bf16*)(L + CB_KHC + o) = tobf(khh[e]); }
    }
    if (it_next < it_end) chunk_raw_load(F, it_next, nxt);
    LBAR();
    BREP(2) {
        const int m = wave >> 1, jh = wave & 1;
        const char* X = L + (m < 2 ? CB_AT : CB_RT); const char* Y = L + ((m & 1) ? CB_KT : CB_BT);
        char* dst = L + (m == 1 ? CB_AAK : (m == 2 ? CB_BRB : CB_BRK));
        pg8::f32x4 acc[8];
#pragma unroll
        for (int tI = 0; tI < 8; ++tI) { const int ib = tI >> 1, jb = 2 * jh + (tI & 1); acc[tI] = zero4;
            if (ib >= jb) { if (m == 0) acc[tI] = mm64(X, Y, ib * 16 + fr, jb * 16 + fr, fq, acc[tI]); else acc[tI] = mm64(Y, X, jb * 16 + fr, ib * 16 + fr, fq, acc[tI]); } }
        PAD8(acc);
#pragma unroll
        for (int tI = 0; tI < 8; ++tI) { const int ib = tI >> 1, jb = 2 * jh + (tI & 1);
            if (m == 0) { const int j = jb * 16 + fr, i0 = ib * 16 + 4 * fq; pg8::f32x4 o;
#pragma unroll
                for (int rr = 0; rr < 4; ++rr) o[rr] = (i0 + rr > j) ? acc[tI][rr] : 0.f;
                *(pg8::f32x4*)((float*)(L + CB_AAB) + j * 64 + i0) = o; }
            else { const int i = ib * 16 + fr, j0 = jb * 16 + 4 * fq; float o[4];
#pragma unroll
                for (int rr = 0; rr < 4; ++rr) { const bool keep = m == 1 ? (i > j0 + rr) : (i >= j0 + rr); o[rr] = keep ? acc[tI][rr] : 0.f; }
                v2u w; w.x = pk2(o[0], o[1]); w.y = pk2(o[2], o[3]); *(v2u*)(dst + (i * 72 + j0) * 2) = w; } }
    }
    LBAR();
    BREP(3) {
        const int rowid = wave * 8 + (lane >> 3), g = lane & 7, blk = rowid >> 5, n = rowid & 31;
        const float* A = (const float*)(L + CB_AAB) + (blk * 32) * 64 + blk * 32 + 4 * g;
        float t0 = 0.f, t1 = 0.f, t2 = 0.f, t3 = 0.f;
#pragma unroll
        for (int ii = 0; ii < 32; ++ii) { const int i = 31 - ii; const pg8::f32x4 a = *(const pg8::f32x4*)(A + i * 64);
            float s = (a[0] * t0 + a[1] * t1) + (a[2] * t2 + a[3] * t3);
            s = dpp_add<0xB1>(s); s = dpp_add<0x4E>(s); s = dpp_add<0x141>(s);
            s += (i == n) ? 1.f : 0.f;
            if (g == (i >> 2)) { if ((i & 3) == 0) t0 = s; else if ((i & 3) == 1) t1 = s; else if ((i & 3) == 2) t2 = s; else t3 = s; } }
        v2u w; w.x = pk2(t0, t1); w.y = pk2(t2, t3);
        *(v2u*)(L + CB_TT + ((blk * 32 + n) * 72 + blk * 32 + 4 * g) * 2) = w;
        if (blk == 0) { const v2u z = {0u, 0u}; *(v2u*)(L + CB_TT + (n * 72 + 32 + 4 * g) * 2) = z;
            *(bf16*)(L + CB_T1T + ((4 * g + 0) * 40 + n) * 2) = tobf(t0); *(bf16*)(L + CB_T1T + ((4 * g + 1) * 40 + n) * 2) = tobf(t1);
            *(bf16*)(L + CB_T1T + ((4 * g + 2) * 40 + n) * 2) = tobf(t2); *(bf16*)(L + CB_T1T + ((4 * g + 3) * 40 + n) * 2) = tobf(t3); }
    }
    LBAR();
    if (wave == 0) {
        pg8::f32x4 acc[4];
#pragma unroll
        for (int tI = 0; tI < 4; ++tI) { const int jb2 = tI >> 1, ib2 = tI & 1; const float* ar = (const float*)(L + CB_AAB) + (jb2 * 16 + fr) * 64 + 32 + 8 * fq;
            const pg8::f32x4 a0 = *(const pg8::f32x4*)ar, a1 = *(const pg8::f32x4*)(ar + 4);
            acc[tI] = __builtin_amdgcn_mfma_f32_16x16x32_bf16(__builtin_bit_cast(pg8::bf16x8, pg8::pack8(a0, a1)), *(const pg8::bf16x8*)(L + CB_TT + (32 + ib2 * 16 + fr) * 144 + (32 + 8 * fq) * 2), zero4, 0, 0, 0); }
        PAD4(acc);
#pragma unroll
        for (int tI = 0; tI < 4; ++tI) { const int jb2 = tI >> 1, ib2 = tI & 1; v2u w; w.x = pk2(acc[tI][0], acc[tI][1]); w.y = pk2(acc[tI][2], acc[tI][3]); *(v2u*)(L + CB_P1T + (ib2 * 16 + fr) * 80 + (jb2 * 16 + 4 * fq) * 2) = w; }
        LDS_WAIT();
#pragma unroll
        for (int tI = 0; tI < 4; ++tI) { const int nb = tI >> 1, ib2 = tI & 1;
            acc[tI] = __builtin_amdgcn_mfma_f32_16x16x32_bf16(*(const pg8::bf16x8*)(L + CB_T1T + (nb * 16 + fr) * 80 + fq * 16), *(const pg8::bf16x8*)(L + CB_P1T + (ib2 * 16 + fr) * 80 + fq * 16), zero4, 0, 0, 0); }
        PAD4(acc);
#pragma unroll
        for (int tI = 0; tI < 4; ++tI) { const int nb = tI >> 1, ib2 = tI & 1; v2u w; w.x = pk2(acc[tI][0], acc[tI][1]); w.y = pk2(acc[tI][2], acc[tI][3]); *(v2u*)(L + CB_TT + ((32 + ib2 * 16 + fr) * 72 + nb * 16 + 4 * fq) * 2) = w; }
    } else {
        pg8::f32x4 acc[4];
#pragma unroll
        for (int q3 = 0; q3 < 3; ++q3) { const int tt = wave - 1 + 7 * q3; acc[q3] = zero4; if (tt < 16) acc[q3] = mm64(L + CB_AAK, L + CB_VC, (tt & 3) * 16 + fr, (tt >> 2) * 16 + fr, fq, zero4); }
        acc[3] = zero4; PAD4(acc);
#pragma unroll
        for (int q3 = 0; q3 < 3; ++q3) { const int tt = wave - 1 + 7 * q3; if (tt < 16) { const int vb = tt >> 2, ib = tt & 3;
            v2u w; w.x = pk2(acc[q3][0], acc[q3][1]); w.y = pk2(acc[q3][2], acc[q3][3]); *(v2u*)(L + CB_G1T + ((vb * 16 + fr) * 72 + ib * 16 + 4 * fq) * 2) = w; } }
    }
    LBAR();
    BREP(4) {
        pg8::f32x4 acc[4];
#pragma unroll
        for (int q4 = 0; q4 < 4; ++q4) { const int tt = wave * 4 + q4, second = tt >> 4, xb = (tt >> 2) & 3, ib = tt & 3; acc[q4] = mm64(L + CB_TT, L + (second ? CB_G1T : CB_AC), ib * 16 + fr, xb * 16 + fr, fq, zero4); }
        PAD4(acc);
#pragma unroll
        for (int q4 = 0; q4 < 4; ++q4) { const int tt = wave * 4 + q4, second = tt >> 4, xb = (tt >> 2) & 3, ib = tt & 3;
            v2u w; w.x = pk2(acc[q4][0], acc[q4][1]); w.y = pk2(acc[q4][2], acc[q4][3]); *(v2u*)(L + (second ? CB_W2T : CB_W1T) + ((xb * 16 + fr) * 72 + ib * 16 + 4 * fq) * 2) = w; }
    }
    LBAR();
    BREP(5) {
        const int mat = wave >> 1, nh = wave & 1; const bool latent = cg < 128;
        bf16* mn = (bf16*)(F.ws + WS_MN) + ((size_t)(bh * NCHUNK + cg) * 2 + dir) * 8192;
        bf16* pq = (bf16*)F.out + ((size_t)(bh * 128 + (cg & 127)) * 2 + dir) * 8192;
        if (mat < 2 || latent) {
            bf16* out = mat == 0 ? mn : (mat == 1 ? mn + 4096 : (mat == 2 ? pq : pq + 4096));
            const char* A1 = L + ((mat & 1) ? CB_W2T : CB_W1T); const char* B1 = L + (mat < 2 ? CB_BHC : CB_BRB); const char* B2 = L + (mat == 1 ? CB_KHC : CB_BRK);
            pg8::f32x4 acc[8];
#pragma unroll
            for (int tI = 0; tI < 8; ++tI) { const int mb = tI >> 1, ncol = (2 * nh + (tI & 1)) * 16 + fr; acc[tI] = mm64(A1, B1, mb * 16 + fr, ncol, fq, zero4); if (mat & 1) acc[tI] = mm64(L + CB_VC, B2, mb * 16 + fr, ncol, fq, acc[tI]); }
            PAD8(acc);
#pragma unroll
            for (int tI = 0; tI < 8; ++tI) { const int mb = tI >> 1, ncol = (2 * nh + (tI & 1)) * 16 + fr, m0r = mb * 16 + 4 * fq;
                if (mat == 0) { const float g = ((const float*)(L + CB_GC))[ncol];
#pragma unroll
                    for (int rr = 0; rr < 4; ++rr) if (m0r + rr == ncol) acc[tI][rr] += g; }
                if (mat == 2) { const v2u rw = *(const v2u*)(L + CB_RT + ncol * 144 + m0r * 2); acc[tI][0] += bflo(rw.x); acc[tI][1] += bfhi(rw.x); acc[tI][2] += bflo(rw.y); acc[tI][3] += bfhi(rw.y); }
                v2u w; w.x = pk2(acc[tI][0], acc[tI][1]); w.y = pk2(acc[tI][2], acc[tI][3]); *(v2u*)(out + ncol * 64 + m0r) = w; }
        }
    }
    LBAR();
}
__device__ __forceinline__ void phase_build(Frame& F) {
    const int it_end = NB * RH * NCHUNK * 2; ChunkRaw cur, nxt;
    if (F.bid < it_end) chunk_raw_load(F, F.bid, cur);
#pragma unroll 1
    for (int it = F.bid; it < it_end; it += F.G) {
        chunk_build_item(F, it, cur, it + F.G, it_end, nxt);
        cur = nxt;
    }
}

__device__ __forceinline__ void scan2_unit(Frame& F, int sc) {
    const int dir = sc & 1, bh = sc >> 1; const bool fwd = dir == 0;
    char* L = F.lds; constexpr int SB = 4 * 9216, OFF_ZT = 2 * SB; constexpr int NS = NCHUNK + 0;
    const int lane = F.lane, wave = F.wave, fr = lane & 15, fq = lane >> 4, tid = F.tid;
    const bf16* MNb = (const bf16*)(F.ws + WS_MN); const bf16* PQb = (const bf16*)F.out;
    float* Yg = (float*)(F.ws + WS_YS) + (size_t)dir * MROWS * RW + (size_t)bh * T * RN;
    auto chunk_of = [&](int s) { return s < 4 ? (fwd ? 128 + s : 131 - s) : (fwd ? s - 4 : 131 - s); };
    v4u st0[4], st1[4], st2[4], st3[4];
    auto gload = [&](v4u (&st)[4], int s) { const int cg = chunk_of(s); const bf16* mn = MNb + ((size_t)(bh * NCHUNK + cg) * 2 + dir) * 8192; const bf16* pq = PQb + ((size_t)(bh * 128 + (cg & 127)) * 2 + dir) * 8192;
#pragma unroll
        for (int k = 0; k < 4; ++k) st[k] = *(const v4u*)((k < 2 ? mn + k * 4096 : pq + (k - 2) * 4096) + (tid >> 3) * 64 + (tid & 7) * 8); };
    auto lstore = [&](const v4u (&st)[4], int buf) {
#pragma unroll
        for (int k = 0; k < 4; ++k) *(v4u*)(L + buf * SB + k * 9216 + (tid >> 3) * 144 + (tid & 7) * 16) = st[k]; };
    for (int i = tid; i < 9216 / 4; i += NTHR) ((unsigned*)(L + OFF_ZT))[i] = 0u;
    gload(st0, 0); gload(st1, 1); gload(st2, 2); gload(st3, 3); lstore(st0, 0); __syncthreads();
    const int vb = wave >> 1, nh = wave & 1;
    auto step = [&](int s, v4u (&stcur)[4], const v4u (&stnext)[4]) {
        const int cg = chunk_of(s); const bool latent = cg < 128; const char* B = L + (s & 1) * SB;
        if (s + 4 < NS) gload(stcur, s + 4);
        pg8::bf16x8 za[2];
#pragma unroll
        for (int kb = 0; kb < 2; ++kb) za[kb] = *(const pg8::bf16x8*)(L + OFF_ZT + (vb * 16 + fr) * 144 + kb * 64 + fq * 16);
        pg8::f32x4 zn[2], yy[2];
#pragma unroll
        for (int nn = 0; nn < 2; ++nn) { const int nrow = (2 * nh + nn) * 16 + fr;
            const v2u nw = *(const v2u*)(B + 9216 + nrow * 144 + (vb * 16 + 4 * fq) * 2); zn[nn] = (pg8::f32x4){bflo(nw.x), bfhi(nw.x), bflo(nw.y), bfhi(nw.y)};
#pragma unroll
            for (int kb = 0; kb < 2; ++kb) zn[nn] = __builtin_amdgcn_mfma_f32_16x16x32_bf16(za[kb], *(const pg8::bf16x8*)(B + nrow * 144 + kb * 64 + fq * 16), zn[nn], 0, 0, 0);
            const v2u qw = *(const v2u*)(B + 3 * 9216 + nrow * 144 + (vb * 16 + 4 * fq) * 2); yy[nn] = (pg8::f32x4){bflo(qw.x), bfhi(qw.x), bflo(qw.y), bfhi(qw.y)};
#pragma unroll
            for (int kb = 0; kb < 2; ++kb) yy[nn] = __builtin_amdgcn_mfma_f32_16x16x32_bf16(za[kb], *(const pg8::bf16x8*)(B + 2 * 9216 + nrow * 144 + kb * 64 + fq * 16), yy[nn], 0, 0, 0); }
        MFMA_DRAIN(); asm volatile("s_nop 1" : "+v"(zn[0]), "+v"(zn[1]), "+v"(yy[0]), "+v"(yy[1]));
        if (latent) {
#pragma unroll
            for (int nn = 0; nn < 2; ++nn) { const int i = (2 * nh + nn) * 16 + fr, nat = fwd ? i : 63 - i; *(pg8::f32x4*)(Yg + ((size_t)(cg * 64 + nat)) * RN + vb * 16 + 4 * fq) = yy[nn]; }
        }
        __syncthreads();
#pragma unroll
        for (int nn = 0; nn < 2; ++nn)
#pragma unroll
            for (int rr = 0; rr < 4; ++rr) *(bf16*)(L + OFF_ZT + ((vb * 16 + 4 * fq + rr) * 72 + (2 * nh + nn) * 16 + fr) * 2) = tobf(zn[nn][rr]);
        if (s + 1 < NS) lstore(stnext, (s + 1) & 1);
        __syncthreads();
    };
    static_assert(NS % 4 == 0, "the register ring is walked four chunks at a time");
    for (int s = 0; s < NS; s += 4) { step(s, st0, st1); step(s + 1, st1, st2); step(s + 2, st2, st3); step(s + 3, st3, st0); }
}


__device__ __forceinline__ void scan_unit(Frame& F, int sc) {
    const int dir = sc & 1, bh = sc >> 1; const bool fwd = dir == 0;
    const size_t hb = (size_t)bh * NKEY * RN;
    const bf16* src0 = (const bf16*)(F.ws + WS_SCAN) + hb;
    float* Yg = (float*)(F.ws + WS_YS) + (size_t)dir * MROWS * RW + (size_t)bh * T * RN;
    float* buf = (float*)F.lds;
    float* ybuf = buf + 2 * 6 * 2048;
    constexpr int NCH = (TC + T) / 32;
    auto chunk_pos = [&](int c) { if (c < 8) { const int cn = fwd ? c : 7 - c; return T + 32 * cn; } const int cl = c - 8, cn = fwd ? cl : 255 - cl; return 32 * cn; };
    auto load_chunk = [&](int c, int nthreads, int t0) {
        const int pos = chunk_pos(c); float* dst = buf + (c & 1) * 6 * 2048;
        for (int i = F.tid - t0; i < 6 * 256; i += nthreads) { const int a = i >> 8, e8 = (i & 255) * 8; float f[8]; const int ai = a == 0 ? A_R : (a == 1 ? A_V : (a == 2 ? A_KK : (a == 3 ? A_W + dir : (a == 4 ? A_K + dir : A_B + dir)))); unpack8(*(const v4u*)(src0 + (size_t)ai * (SCAN_ARR / 2) + (size_t)pos * RN + e8), f);
            *(pg8::f32x4*)(dst + a * 2048 + e8) = (pg8::f32x4){f[0], f[1], f[2], f[3]}; *(pg8::f32x4*)(dst + a * 2048 + e8 + 4) = (pg8::f32x4){f[4], f[5], f[6], f[7]}; }
    };
    constexpr int C0 = 0;
    load_chunk(C0, NTHR, 0);
    __syncthreads();
    const int vg = F.lane >> 4, kl = F.lane & 15, vrow = 16 * F.wave + 4 * vg;
    float S[4][4];
#pragma unroll
    for (int i = 0; i < 4; ++i)
#pragma unroll
        for (int j = 0; j < 4; ++j) S[i][j] = 0.f;
    for (int c = C0; c < NCH; ++c) {
        const bool latent = c >= 8;
        if (F.wave >= 4) { if (c + 1 < NCH) load_chunk(c + 1, 256, 256); }
        else {
            const float* cb = buf + (c & 1) * 6 * 2048;
            for (int s = 0; s < 32; ++s) {
                const int sn = fwd ? s : 31 - s;
                const pg8::f32x4 rv = *(const pg8::f32x4*)(cb + 0 * 2048 + sn * 64 + 4 * kl), vv = *(const pg8::f32x4*)(cb + 1 * 2048 + sn * 64 + vrow);
                const pg8::f32x4 kk = *(const pg8::f32x4*)(cb + 2 * 2048 + sn * 64 + 4 * kl), w = *(const pg8::f32x4*)(cb + 3 * 2048 + sn * 64 + 4 * kl);
                const pg8::f32x4 kv = *(const pg8::f32x4*)(cb + 4 * 2048 + sn * 64 + 4 * kl), bt = *(const pg8::f32x4*)(cb + 5 * 2048 + sn * 64 + 4 * kl);
                float sa[4];
#pragma unroll
                for (int i = 0; i < 4; ++i) sa[i] = -red16((S[i][0] * kk[0] + S[i][1] * kk[1]) + (S[i][2] * kk[2] + S[i][3] * kk[3]));
#pragma unroll
                for (int i = 0; i < 4; ++i)
#pragma unroll
                    for (int j = 0; j < 4; ++j) S[i][j] = S[i][j] * w[j] + sa[i] * bt[j] + vv[i] * kv[j];
                if (latent) {
                    float y[4];
#pragma unroll
                    for (int i = 0; i < 4; ++i) y[i] = red16((S[i][0] * rv[0] + S[i][1] * rv[1]) + (S[i][2] * rv[2] + S[i][3] * rv[3]));
                    if (kl == 0) *(pg8::f32x4*)(ybuf + sn * 64 + vrow) = (pg8::f32x4){y[0], y[1], y[2], y[3]};
                }
            }
        }
        __syncthreads();
        if (latent) { const int pos = chunk_pos(c); *(pg8::f32x4*)(Yg + (size_t)pos * RN + F.tid * 4) = *(const pg8::f32x4*)(ybuf + F.tid * 4); }
        __syncthreads();
    }
}
__device__ __forceinline__ void phase_scan(Frame& F) {
#ifndef CHAIN_DUP
#define CHAIN_DUP 1
#endif
    if (F.bid < 64) { for (int rep_ = 0; rep_ < CHAIN_DUP; ++rep_) { if (rep_) __syncthreads(); scan2_unit(F, F.bid); } return; }
    float* scr = (float*)(F.lds + F.wave * 8448);
    const int gw = (F.bid - 64) * NWAVES + F.wave, NGW = (F.G - 64) * NWAVES;
    constexpr int I13 = (DM / 64) * (DEXP / 32), I2 = (DEXP / 64) * (DM / 32);
#ifndef CONV_DUP
#define CONV_DUP 1
#endif
    for (int rep_ = 0; rep_ < CONV_DUP; ++rep_)
    for (int it = gw; it < NEXP * (2 * I13 + I2); it += NGW) {
        const int e = it / (2 * I13 + I2); int r = it - e * (2 * I13 + I2);
        if (r < 2 * I13) { const int is3 = r >= I13; if (is3) r -= I13; const int n0 = 32 * (r % (DEXP / 32));
            transpose_item(F.in[is3 ? 30 : 29] + (size_t)e * DM * DEXP, DM, DEXP, (bf16*)(F.ws + WS_W13T), e * 1024 + (n0 / 128) * 128 + 128 * is3, nullptr, scr, r, F.lane); }
        else transpose_item(F.in[31] + (size_t)e * DEXP * DM, DEXP, DM, (bf16*)(F.ws + WS_W2T), e * DM, nullptr, scr, r - 2 * I13, F.lane);
    }
}

__device__ __forceinline__ void phase_readout(Frame& F) {
    const float* lg = F.in[22]; const float* lb = F.in[23]; const float* Ysrc = (const float*)(F.ws + WS_YS); const float* bonp = (const float*)(F.ws + WS_BON);
    bf16* MIX = (bf16*)(F.ws + WS_MIX);
    const int tk = F.tid >> 3, c8 = (F.tid & 7) * 8;
    for (int it = F.bid; it < NB * RH * (T / 64); it += F.G) {
        const int bh = it >> 7, tt = (it & 127) * 64 + tk, b = bh >> 4, h = bh & 15;
        const size_t ys = ((size_t)bh * T + tt) * RN + c8, ss = ((size_t)bh * NKEY + tt) * RN + c8;
        const pg8::f32x4 f0 = *(const pg8::f32x4*)(Ysrc + ys), f1 = *(const pg8::f32x4*)(Ysrc + ys + 4);
        const pg8::f32x4 b0 = *(const pg8::f32x4*)(Ysrc + (size_t)MROWS * RW + ys), b1 = *(const pg8::f32x4*)(Ysrc + (size_t)MROWS * RW + ys + 4);
        float y[8] = {f0[0] + b0[0], f0[1] + b0[1], f0[2] + b0[2], f0[3] + b0[3], f1[0] + b1[0], f1[1] + b1[1], f1[2] + b1[2], f1[3] + b1[3]};
        float v[8], g[8];
        unpack8(*(const v4u*)((const bf16*)(F.ws + WS_SCAN + A_V * SCAN_ARR) + ss), v);
        unpack8(*(const v4u*)((const bf16*)(F.ws + WS_G) + ys), g);
        const float bon = bonp[(size_t)bh * T + tt];
        float s = 0.f;
#pragma unroll
        for (int e = 0; e < 8; ++e) s += y[e];
        s += __shfl_xor(s, 1); s += __shfl_xor(s, 2); s += __shfl_xor(s, 4);
        const float mean = s * (1.0f / 64.0f); float q = 0.f;
#pragma unroll
        for (int e = 0; e < 8; ++e) { y[e] -= mean; q += y[e] * y[e]; }
        q += __shfl_xor(q, 1); q += __shfl_xor(q, 2); q += __shfl_xor(q, 4);
        const float rstd = __builtin_amdgcn_rsqf(q * (1.0f / 64.0f) + 64e-5f);
        float o[8];
#pragma unroll
        for (int e = 0; e < 8; ++e) { const int ch = h * 64 + c8 + e; o[e] = (y[e] * rstd * lg[ch] + lb[ch] + bon * v[e]) * g[e]; }
        *(v4u*)(MIX + ((size_t)b * T + tt) * DM + RW + h * 64 + c8) = pack8f(o);
    }
}

__device__ __forceinline__ void phase_route(Frame& F) {
    const float* X1 = F.out; const float* modf = (const float*)(F.ws + WS_MODF); const float* gf = F.in[7];
    const bf16* WR = (const bf16*)(F.ws + WS_WRT); bf16* H2 = (bf16*)(F.ws + WS_H2);
    int* rte = (int*)(F.ws + WS_ROUTE + RT_E); int* rtp = (int*)(F.ws + WS_ROUTE + RT_POS); float* rtg = (float*)(F.ws + WS_ROUTE + RT_GATE);
    float* lg = (float*)(F.lds) + F.wave * (16 * 48);
    const int fr = F.lane & 15, fq = F.lane >> 4;
    const int gw = F.bid * NWAVES + F.wave, NGW = F.G * NWAVES;
    for (int it = gw; it < MROWS / 16; it += NGW) {
        const int row = it * 16 + fr, b = row >> 13; const float* xr = X1 + (size_t)row * DM + fq * 8;
        float ss = 0.f;
#pragma unroll 8
        for (int k = 0; k < 64; ++k) { const pg8::f32x4 a = *(const pg8::f32x4*)(xr + k * 32), c = *(const pg8::f32x4*)(xr + k * 32 + 4); ss += pg8::dot4(a) + pg8::dot4(c); }
        ss += __shfl_xor(ss, 16); ss += __shfl_xor(ss, 32);
        const float rstd = __builtin_amdgcn_rsqf(ss * (1.0f / DM) + 1e-6f);
        const float* sh2 = modf + (size_t)b * 6 * DM + 3 * DM + fq * 8; const float* sc2 = modf + (size_t)b * 6 * DM + 4 * DM + fq * 8;
        pg8::f32x4 acc[3] = {{0.f, 0.f, 0.f, 0.f}, {0.f, 0.f, 0.f, 0.f}, {0.f, 0.f, 0.f, 0.f}};
#pragma unroll 4
        for (int k = 0; k < 64; ++k) {
            const pg8::f32x4 a = *(const pg8::f32x4*)(xr + k * 32), c = *(const pg8::f32x4*)(xr + k * 32 + 4);
            const pg8::f32x4 g0 = *(const pg8::f32x4*)(gf + fq * 8 + k * 32), g1 = *(const pg8::f32x4*)(gf + fq * 8 + k * 32 + 4);
            const pg8::f32x4 s0 = *(const pg8::f32x4*)(sc2 + k * 32), s1 = *(const pg8::f32x4*)(sc2 + k * 32 + 4), h0 = *(const pg8::f32x4*)(sh2 + k * 32), h1 = *(const pg8::f32x4*)(sh2 + k * 32 + 4);
            const pg8::f32x4 o0 = a * rstd * g0 * (s0 + 1.0f) + h0, o1 = c * rstd * g1 * (s1 + 1.0f) + h1;
            const pg8::u32x4 w = pg8::pack8(o0, o1);
            *(pg8::u32x4*)(H2 + (size_t)row * DM + fq * 8 + k * 32) = w;
            const pg8::bf16x8 xb = __builtin_bit_cast(pg8::bf16x8, w);
#pragma unroll
            for (int nb = 0; nb < 3; ++nb) { const pg8::bf16x8 wf = *(const pg8::bf16x8*)(WR + (size_t)(nb * 16 + fr) * DM + k * 32 + fq * 8); acc[nb] = __builtin_amdgcn_mfma_f32_16x16x32_bf16(wf, xb, acc[nb], 0, 0, 0); }
        }
        MFMA_DRAIN(); asm volatile("s_nop 1" : "+v"(acc[0]), "+v"(acc[1]), "+v"(acc[2]));
#pragma unroll
        for (int nb = 0; nb < 3; ++nb)
#pragma unroll
            for (int j = 0; j < 4; ++j) lg[fr * 48 + nb * 16 + 4 * fq + j] = acc[nb][j];
        LDS_WAIT(); asm volatile("" ::: "memory");
        if (F.lane < 16) {
            const float* l = lg + F.lane * 48; const float* bg = F.in[26]; const float* be = F.in[28];
            int g = 0; float gm = l[0] + bg[0]; float gl[4]; gl[0] = gm;
#pragma unroll
            for (int i = 1; i < 4; ++i) { gl[i] = l[i] + bg[i]; if (gl[i] > gm) { gm = gl[i]; g = i; } }
            float gs = 0.f;
#pragma unroll
            for (int i = 0; i < 4; ++i) gs += __expf(gl[i] - gm);
            const float gval = 1.0f / gs;
            float w8[8]; int i1 = 0; float m1 = -3.0e38f;
#pragma unroll
            for (int i = 0; i < 8; ++i) { w8[i] = l[4 + 8 * g + i] + be[8 * g + i]; if (w8[i] > m1) { m1 = w8[i]; i1 = i; } }
            int i2 = 0; float m2 = -3.0e38f;
#pragma unroll
            for (int i = 0; i < 8; ++i) { if (i != i1 && w8[i] > m2) { m2 = w8[i]; i2 = i; } }
            const float e2 = __expf(m2 - m1), inv = 1.0f / (1.0f + e2);
            const int ea = 8 * g + i1, eb = 8 * g + i2; const int t = it * 16 + F.lane;
            const int pa = (int)atomicAdd(F.ctl + CW_CNT + ea, 1u), pb = (int)atomicAdd(F.ctl + CW_CNT + eb, 1u);
            rte[2 * t] = ea; rte[2 * t + 1] = eb; rtp[2 * t] = pa; rtp[2 * t + 1] = pb; rtg[2 * t] = gval * inv; rtg[2 * t + 1] = gval * e2 * inv;
        }
        LDS_WAIT(); asm volatile("" ::: "memory");
    }
}

__device__ __forceinline__ void build_tiles(Frame& F) {
    int* tab = (int*)(F.lds + EXTRA_OFF);
    if (F.tid == 0) { int tb = 0;
        for (int e = 0; e < NEXP; ++e) { const int c = (int)__hip_atomic_load(F.ctl + CW_CNT + e, __ATOMIC_RELAXED, __HIP_MEMORY_SCOPE_AGENT); const int nt = (c + 255) >> 8; tab[e] = tb * 256;
            for (int i = 0; i < nt && tb + i < MAXTILES; ++i) tab[64 + tb + i] = e; tb += nt; }
        tab[32] = tb < MAXTILES ? tb : MAXTILES; }
    __syncthreads();
}
__device__ __forceinline__ void phase_gather(Frame& F) {
    build_tiles(F);
    const int* tab = (const int*)(F.lds + EXTRA_OFF);
    const int* rte = (const int*)(F.ws + WS_ROUTE + RT_E); const int* rtp = (const int*)(F.ws + WS_ROUTE + RT_POS); const float* rtg = (const float*)(F.ws + WS_ROUTE + RT_GATE);
    int* rtr = (int*)(F.ws + WS_ROUTE + RT_ROW); float* rgate = (float*)(F.ws + WS_ROUTE + RT_RGATE);
    const bf16* H2 = (const bf16*)(F.ws + WS_H2); bf16* XG = (bf16*)(F.ws + WS_XG);
    const int gw = F.bid * NWAVES + F.wave, NGW = F.G * NWAVES;
    for (int p = gw; p < 2 * MROWS; p += NGW) {
        const int t = p >> 1; const int row = tab[rte[p]] + rtp[p];
        const v4u* s = (const v4u*)(H2 + (size_t)t * DM) + F.lane; v4u* d = (v4u*)(XG + (size_t)row * DM) + F.lane;
#pragma unroll
        for (int q = 0; q < 4; ++q) d[64 * q] = s[64 * q];
        if (F.lane == 0) { rtr[p] = row; rgate[row] = rtg[p]; }
    }
}
__device__ __forceinline__ void phase_final(Frame& F) {
    const float* modf = (const float*)(F.ws + WS_MODF); const float* fg = F.in[32]; const bf16* Y = (const bf16*)(F.ws + WS_Y); const int* rtr = (const int*)(F.ws + WS_ROUTE + RT_ROW);
    const int gw = F.bid * NWAVES + F.wave, NGW = F.G * NWAVES;
    for (int m = gw; m < MROWS; m += NGW) {
        const int b = m >> 13, ra = rtr[2 * m], rb = rtr[2 * m + 1]; const float* g2 = modf + (size_t)b * 6 * DM + 5 * DM;
        float* xr = F.out + (size_t)m * DM; pg8::f32x4 v[8]; float s = 0.f;
#pragma unroll
        for (int q = 0; q < 8; ++q) { const int c = q * 256 + F.lane * 4; const pg8::f32x4 x = *(const pg8::f32x4*)(xr + c), g = *(const pg8::f32x4*)(g2 + c);
            const v2u ya = *(const v2u*)(Y + (size_t)ra * DM + c), yb = *(const v2u*)(Y + (size_t)rb * DM + c);
            const pg8::f32x4 ys = {bflo(ya.x) + bflo(yb.x), bfhi(ya.x) + bfhi(yb.x), bflo(ya.y) + bflo(yb.y), bfhi(ya.y) + bfhi(yb.y)};
            v[q] = x + g * ys; s += pg8::dot4(v[q]); }
        const float rstd = __builtin_amdgcn_rsqf(wave_sum(s) * (1.0f / DM) + 1e-6f);
#pragma unroll
        for (int q = 0; q < 8; ++q) { const int c = q * 256 + F.lane * 4; *(pg8::f32x4*)(xr + c) = v[q] * rstd * *(const pg8::f32x4*)(fg + c); }
    }
}

struct Args { const float* in[33]; float* out; unsigned char* ws; int ph_lo, ph_hi; };
__global__ void __launch_bounds__(NTHR, 2) fwd_kernel(Args args) {
    extern __shared__ __attribute__((aligned(16))) unsigned char lds_raw[];
    Frame F;
    F.lds = (char*)lds_raw; F.MISC = (volatile LAS unsigned*)((LAS unsigned char*)lds_raw + MISC_OFF);
    F.tid = threadIdx.x; F.lane = F.tid & 63; F.wave = __builtin_amdgcn_readfirstlane(F.tid >> 6); F.G = gridDim.x; F.bid = blockIdx.x;
    F.ws = args.ws; F.ctl = (unsigned*)(args.ws + WS_CTL); F.out = args.out;
    F.in = (const float* const __attribute__((address_space(4)))*)__builtin_amdgcn_kernarg_segment_ptr();
    if (F.tid < 128) ((LAS unsigned*)((LAS unsigned char*)lds_raw + MISC_OFF))[F.tid] = 0u;
    __syncthreads();
    XcdBarrier bar; bar.bar = F.ctl + CW_BAR; bar.x = 0; bar.st = nullptr;
    if (N_LAUNCHES == 1) bar = xcd_barrier_post(F.ctl + CW_BAR, F.MISC + 8);
    const int lo = args.ph_lo, hi = args.ph_hi;
#ifndef PH_MASK
#define PH_MASK 0xffff
#endif
#define IN(k) (((PH_MASK >> (k)) & 1) && lo <= (k) && (k) < hi)
#ifndef PROBE_DOUBLE
#define PROBE_DOUBLE -1
#endif
#define REPS(k) ((PROBE_DOUBLE == (k)) ? 2 : 1)
#define SEAM(k) do { if (IN(k) && IN((k) + 1)) xcd_barrier(bar); } while (0)
    LAS unsigned char* ring = (LAS unsigned char*)lds_raw;

    if (IN(0)) for (int rep = 0; rep < REPS(0); ++rep) { if (rep) xcd_barrier(bar); phase0(F); } SEAM(0);
    if (IN(1)) for (int rep = 0; rep < REPS(1); ++rep) { if (rep) xcd_barrier(bar); phase1(F); } SEAM(1);
    if (IN(2)) for (int rep = 0; rep < REPS(2); ++rep) { if (rep) xcd_barrier(bar);
        pg8::Gemm g{(const bf16*)(F.ws + WS_H), (const bf16*)(F.ws + WS_WTIN), MALL, NINP, DM, DM}; pg8::StaticOrder S; S.init(MALL, NINP, F.G, F.bid);
        pg8::EpiP E{(bf16*)(F.ws + WS_P), NINP, (float*)(F.ws + WS_RSS)};
        pg8::gemm_phase<pg8::EpiP, pg8::StaticOrder, true, true>(ring, g, S, E);
    } SEAM(2);
    if (IN(3)) for (int rep = 0; rep < REPS(3); ++rep) { if (rep) xcd_barrier(bar);
        for (int tl = F.bid; tl < MROWS / 64; tl += F.G) rwkv_prep_tile(F, tl, 0, RH);
        for (int j = F.G - 1 - F.bid; j < (NB * TC / 64) * RH; j += F.G) rwkv_prep_tile(F, MROWS / 64 + (j >> 4), j & 15, (j & 15) + 1);
        { pg8::Gemm g{(const bf16*)(F.ws + WS_P) + C_CQ, (const bf16*)(F.ws + WS_WTUQ), MROWS, 1536, 512, NINP}; pg8::StaticOrder S; S.init(MROWS, 1536, F.G, F.bid);
          pg8::EpiQ E{(bf16*)(F.ws + WS_Q), (const float*)(F.ws + WS_RSS)};
          pg8::gemm_phase<pg8::EpiQ, pg8::StaticOrder, true, true>(ring, g, S, E); }
        { pg8::Gemm g{(const bf16*)(F.ws + WS_P) + C_CKV, (const bf16*)(F.ws + WS_WTUKV), MALL, 2048, 256, NINP}; pg8::StaticOrder S; S.init(MALL, 2048, F.G, F.bid);
          pg8::EpiKV E{(bf16*)(F.ws + WS_KN), (bf16*)(F.ws + WS_V), (const float*)(F.ws + WS_RSS)};
          pg8::gemm_phase<pg8::EpiKV, pg8::StaticOrder, true, true>(ring, g, S, E); }
    } SEAM(3);
    if (IN(4)) for (int rep = 0; rep < REPS(4); ++rep) { if (rep) xcd_barrier(bar);
        for (int u = F.bid; u < NB * 8 * (T / 256); u += F.G) {
            const int qb = u & 31, bh = u >> 5, b = bh >> 3, h = bh & 7;
            att::attn_dense_body((const bf16*)(F.ws + WS_Q) + ((size_t)(b * T + qb * 256)) * 1536 + h * 192,
                                 (const bf16*)(F.ws + WS_KN) + (size_t)bh * NKEY * 128, (const bf16*)(F.ws + WS_V) + (size_t)bh * NKEY * 128,
                                 (const bf16*)(F.ws + WS_KR) + (size_t)b * NKEY * 64,
                                 (bf16*)(F.ws + WS_MIX) + ((size_t)(b * T + qb * 256)) * DM + h * 128, NKEY, F.lds);
        }
    } SEAM(4);
    if (IN(5)) for (int rep = 0; rep < REPS(5); ++rep) { if (rep) xcd_barrier(bar); phase_build(F); } SEAM(5);
    if (IN(6)) for (int rep = 0; rep < REPS(6); ++rep) { if (rep) xcd_barrier(bar); phase_scan(F); } SEAM(6);
    if (IN(7)) for (int rep = 0; rep < REPS(7); ++rep) { if (rep) xcd_barrier(bar); phase_readout(F); } SEAM(7);
    if (IN(8)) for (int rep = 0; rep < REPS(8); ++rep) { if (rep) xcd_barrier(bar);
        pg8::Gemm g{(const bf16*)(F.ws + WS_MIX), (const bf16*)(F.ws + WS_WTOUT), MROWS, DM, DM, DM}; pg8::StaticOrder S; S.init(MROWS, DM, F.G, F.bid);
        pg8::EpiOut E{F.in[0], F.out, (const float*)(F.ws + WS_MODF) + 2 * DM};
        pg8::gemm_phase<pg8::EpiOut, pg8::StaticOrder, true, true>(ring, g, S, E);
    } SEAM(8);
    if (IN(9)) for (int rep = 0; rep < REPS(9); ++rep) { if (rep) xcd_barrier(bar); phase_route(F); } SEAM(9);
    if (IN(10)) for (int rep = 0; rep < REPS(10); ++rep) { if (rep) xcd_barrier(bar); phase_gather(F); } SEAM(10);
    if (IN(11)) for (int rep = 0; rep < REPS(11); ++rep) { if (rep) xcd_barrier(bar);
        build_tiles(F); const int* tab = (const int*)(F.lds + EXTRA_OFF);
        pg8::Gemm g{(const bf16*)(F.ws + WS_XG), (const bf16*)(F.ws + WS_W13T), MAXTILES * 256, NEXP * 1024, DM, DM};
        pg8::MoeOrder S{(const LAS int*)((LAS unsigned char*)lds_raw + EXTRA_OFF) + 64, tab[32], 4, F.G, F.bid};
        pg8::EpiMoe1 E{(bf16*)(F.ws + WS_HM)};
        pg8::gemm_phase<pg8::EpiMoe1, pg8::MoeOrder, true, true>(ring, g, S, E);
    } SEAM(11);
    if (IN(12)) for (int rep = 0; rep < REPS(12); ++rep) { if (rep) xcd_barrier(bar);
        build_tiles(F); const int* tab = (const int*)(F.lds + EXTRA_OFF);
        pg8::Gemm g{(const bf16*)(F.ws + WS_HM), (const bf16*)(F.ws + WS_W2T), MAXTILES * 256, NEXP * DM, DEXP, DEXP};
        pg8::MoeOrder S{(const LAS int*)((LAS unsigned char*)lds_raw + EXTRA_OFF) + 64, tab[32], 8, F.G, F.bid};
        pg8::EpiMoe2 E{(bf16*)(F.ws + WS_Y), (const float*)(F.ws + WS_ROUTE + RT_RGATE)};
        pg8::gemm_phase<pg8::EpiMoe2, pg8::MoeOrder, true, true>(ring, g, S, E);
    } SEAM(12);
    if (IN(13)) for (int rep = 0; rep < REPS(13); ++rep) { if (rep) xcd_barrier(bar); phase_final(F); }
#undef IN
#undef SEAM
}

extern "C" void kernel_launch(void* const* d_in, const int* in_sizes, int n_in, void* d_out, int out_size, void* d_ws, size_t ws_size, hipStream_t stream) {
    static int grid = 0;
    if (grid == 0) {
        if (n_in != 33 || in_sizes[0] != MROWS * DM || out_size != MROWS * DM || ws_size < WS_END) {
            fprintf(stderr, "kernel_launch: shape mismatch: n_in %d in0 %d out %d ws %zu (need %zu); nothing launched\n", n_in, n_in > 0 ? in_sizes[0] : -1, out_size, ws_size, (size_t)WS_END); grid = -1; return; }
        int dev = 0, cus = 0, per_cu = 0;
        if (hipGetDevice(&dev) != hipSuccess || hipDeviceGetAttribute(&cus, hipDeviceAttributeMultiprocessorCount, dev) != hipSuccess) { grid = -1; return; }
        if (hipFuncSetAttribute((const void*)fwd_kernel, hipFuncAttributeMaxDynamicSharedMemorySize, LDS_BYTES) != hipSuccess) { fprintf(stderr, "kernel_launch: hipFuncSetAttribute failed\n"); grid = -1; return; }
        if (hipOccupancyMaxActiveBlocksPerMultiprocessor(&per_cu, (const void*)fwd_kernel, NTHR, LDS_BYTES) != hipSuccess || per_cu < 1)
            fprintf(stderr, "kernel_launch: occupancy query reports %d workgroups per CU\n", per_cu);
        (void)hipGetLastError();
        grid = cus;
    }
    if (grid < 0) return;
    if (hipMemsetAsync((char*)d_ws + WS_CTL, 0, CTL_ZERO_BYTES, stream) != hipSuccess) return;
    Args a{};
    for (int i = 0; i < 33; ++i) a.in[i] = (const float*)d_in[i];
    a.out = (float*)d_out; a.ws = (unsigned char*)d_ws;
    for (int li = 0; li < N_LAUNCHES; ++li) {
        a.ph_lo = (N_LAUNCHES == 1) ? 0 : li; a.ph_hi = (N_LAUNCHES == 1) ? N_PHASES : li + 1;
        hipLaunchKernelGGL(fwd_kernel, dim3(grid), dim3(NTHR), LDS_BYTES, stream, a);
        const hipError_t le = hipPeekAtLastError();
        if (le != hipSuccess) { fprintf(stderr, "kernel_launch: launch %d failed: %s\n", li, hipGetErrorName(le)); break; }
    }
}
```

```cpp
#include <hip/hip_runtime.h>
#include <cstdio>
#include <cstdint>

#define GAS __attribute__((address_space(1)))
#define LAS __attribute__((address_space(3)))
typedef unsigned short bf16;
typedef unsigned v4u __attribute__((ext_vector_type(4)));
typedef unsigned v2u __attribute__((ext_vector_type(2)));
typedef float f32x2 __attribute__((ext_vector_type(2)));
typedef float f32x16 __attribute__((ext_vector_type(16)));
typedef short s16x4 __attribute__((ext_vector_type(4)));

constexpr int DM = 2048, NB = 2, T = 8192, TC = 256, MROWS = NB * T;
constexpr int MALL = MROWS + NB * TC;
constexpr int NIN = 4192, NINP = 4352;
constexpr int C_CQ = 0, C_CKV = 512, C_KR = 768, C_R = 832, C_K = 1856, C_V = 2880, C_WL = 3904, C_AL = 3968, C_GL = 4032;
constexpr int NKEY = T + TC;
constexpr int RH = 16, RN = 64, RW = 1024;
constexpr int NEXP = 32, DEXP = 512, MAXTILES = 160;

namespace pg8 {
#define PG8_LAS __attribute__((address_space(3)))
typedef unsigned short bf16_t;
typedef short bf16x8 __attribute__((ext_vector_type(8)));
typedef float f32x4 __attribute__((ext_vector_type(4)));
typedef unsigned u32x4 __attribute__((ext_vector_type(4)));
constexpr int BM = 256, BK = 64, HALF = 128, HTB = HALF * BK * 2  , STAGE_BYTES = 8 * HTB, NXCD = 8, WGM = 8;

__host__ __device__ __forceinline__ int lds_byte(int r, int c) { const int st = (r >> 4) * 2 + (c >> 5), rr = r & 15, cc = c & 31, ob = rr * 64 + cc * 2; return st * 1024 + (ob ^ (((ob >> 9) & 1) << 5)); }
__host__ __device__ __forceinline__ void stage_rc(int b, int& R, int& C) { const int st = b / 1024, sb = b % 1024, swz = sb ^ (((sb >> 9) & 1) << 5); R = (st >> 1) * 16 + swz / 64; C = (st & 1) * 32 + (swz % 64) / 2; }
__host__ __device__ __forceinline__ int perm32(int rho) { const int n = rho >> 4, i = rho & 15; return 8 * (i >> 2) + 4 * n + (i & 3); }

struct Unit { int pm, pn; };
struct Gemm { const bf16_t* A; const bf16_t* Bt; int M, N, K, lda; };

struct StaticOrder {
    int nM, nN, nwg, G, c;
    __host__ __device__ void init(int M, int N, int G_, int c_) { nM = M / BM; nN = N / BM; nwg = nM * nN; G = G_; c = c_; }
    __host__ __device__ bool next(int i, Unit& u) const {
        const long L = (long)i * G + c; if (L >= nwg) return false;
        int wgid = (int)L; { const int q = nwg / NXCD, r = nwg % NXCD, xcd = wgid % NXCD, off = wgid / NXCD; wgid = (xcd < r ? xcd * (q + 1) : r * (q + 1) + (xcd - r) * q) + off; }
        const int nig = WGM * nN, gid = wgid / nig, fm = gid * WGM, gsz = (nM - fm) < WGM ? (nM - fm) : WGM;
        u.pm = fm + ((wgid % nig) % gsz); u.pn = (wgid % nig) / gsz; return true;
    }
    __device__ __forceinline__ void a_ready(const Unit&) const {}
    __device__ __forceinline__ void done(const Unit&) const {}
};


__device__ __forceinline__ unsigned cvt_pk_bf16(float lo, float hi) { unsigned r; asm volatile("v_cvt_pk_bf16_f32 %0, %1, %2" : "=v"(r) : "v"(lo), "v"(hi)); return r; }
typedef unsigned u32x2 __attribute__((ext_vector_type(2)));
__device__ __forceinline__ u32x4 pack8(const f32x4 a, const f32x4 b) { u32x4 w; w.x = cvt_pk_bf16(a[0], a[1]); w.y = cvt_pk_bf16(a[2], a[3]); w.z = cvt_pk_bf16(b[0], b[1]); w.w = cvt_pk_bf16(b[2], b[3]); return w; }
__device__ __forceinline__ float dot4(const f32x4 a) { return (a[0] * a[0] + a[1] * a[1]) + (a[2] * a[2] + a[3] * a[3]); }

struct EpiP {
    static constexpr bool PERM = true, AFTER_DRAIN = false;
    bf16_t* O; int ldc; float* rss;
    __device__ __forceinline__ void operator()(const f32x4 (&acc)[2][2][4][2], const Unit& u, int wr, int wc, int fr, int fq) const {
        const int row0 = u.pm * BM + wr * 64 + fr, col0 = u.pn * BM + wc * 32 + 8 * fq;
#pragma unroll
        for (int ai = 0; ai < 2; ++ai)
#pragma unroll
            for (int m = 0; m < 4; ++m) { const int row = row0 + ai * HALF + m * 16; bf16_t* rowp = O + (size_t)row * ldc + col0; float ss = 0.f;
#pragma unroll
                for (int bj = 0; bj < 2; ++bj) { const f32x4 v0 = acc[ai][bj][m][0], v1 = acc[ai][bj][m][1]; ss += dot4(v0) + dot4(v1); *(u32x4*)(rowp + bj * HALF) = pack8(v0, v1); }
                if (u.pn < 3) { ss += __shfl_xor(ss, 16); ss += __shfl_xor(ss, 32); if (fq == 0) rss[(size_t)row * 12 + u.pn * 4 + wc] = ss; } }
    }
};
struct EpiQ {
    static constexpr bool PERM = false, AFTER_DRAIN = false;
    bf16_t* Q; const float* rss;
    __device__ __forceinline__ void operator()(const f32x4 (&acc)[2][2][4][2], const Unit& u, int wr, int wc, int fr, int fq) const {
        const int row0 = u.pm * BM + wr * 64 + fr;
        float rev[4];
#pragma unroll
        for (int e = 0; e < 4; ++e) rev[e] = __builtin_amdgcn_exp2f(-(float)(4 * fq + e) * 0.83048202372184059f) * 0.15915494309189535f;
#pragma unroll
        for (int ai = 0; ai < 2; ++ai)
#pragma unroll
            for (int m = 0; m < 4; ++m) { const int row = row0 + ai * HALF + m * 16;
                const f32x4 s0 = *(const f32x4*)(rss + (size_t)row * 12), s1 = *(const f32x4*)(rss + (size_t)row * 12 + 4);
                const float ss = ((s0[0] + s0[1]) + (s0[2] + s0[3])) + ((s1[0] + s1[1]) + (s1[2] + s1[3]));
                const float rstd = __builtin_amdgcn_rsqf(ss * (1.0f / 512.0f) + 1e-6f);
                const int t = row & (T - 1); const float pr = (float)(t >> 6), pc = (float)(t & 63);
#pragma unroll
                for (int bj = 0; bj < 2; ++bj) { const int g32 = 8 * u.pn + 4 * bj + wc, gi = g32 % 6; const int col = 256 * u.pn + 128 * bj + 32 * wc + 4 * fq;
                    f32x4 v0 = acc[ai][bj][m][0] * rstd, v1 = acc[ai][bj][m][1] * rstd;
                    if (gi >= 4) { const float pos = gi == 4 ? pr : pc;
#pragma unroll
                        for (int e = 0; e < 4; ++e) { float r = pos * rev[e]; r = r - __builtin_floorf(r); const float sn = __builtin_amdgcn_sinf(r), cs = __builtin_amdgcn_cosf(r);
                            const float x1 = v0[e], x2 = v1[e]; v0[e] = x1 * cs - x2 * sn; v1[e] = x1 * sn + x2 * cs; } }
                    u32x2 w0, w1; w0.x = cvt_pk_bf16(v0[0], v0[1]); w0.y = cvt_pk_bf16(v0[2], v0[3]); w1.x = cvt_pk_bf16(v1[0], v1[1]); w1.y = cvt_pk_bf16(v1[2], v1[3]);
                    bf16_t* p = Q + (size_t)row * 1536 + col; *(u32x2*)p = w0; *(u32x2*)(p + 16) = w1; } }
    }
};
struct EpiKV {
    static constexpr bool PERM = true, AFTER_DRAIN = false;
    bf16_t* KN; bf16_t* V; const float* rss;
    __device__ __forceinline__ void operator()(const f32x4 (&acc)[2][2][4][2], const Unit& u, int wr, int wc, int fr, int fq) const {
        const int row0 = u.pm * BM + wr * 64 + fr;
#pragma unroll
        for (int ai = 0; ai < 2; ++ai)
#pragma unroll
            for (int m = 0; m < 4; ++m) { const int row = row0 + ai * HALF + m * 16;
                const f32x4 s0 = *(const f32x4*)(rss + (size_t)row * 12 + 8);
                const float rstd = __builtin_amdgcn_rsqf(((s0[0] + s0[1]) + (s0[2] + s0[3])) * (1.0f / 256.0f) + 1e-6f);
                int b, key; if (row < MROWS) { b = row >> 13; key = row & (T - 1); } else { const int r2 = row - MROWS; b = r2 >> 8; key = T + (r2 & 255); }
                const size_t off = ((size_t)(b * 8 + u.pn) * NKEY + key) * 128 + wc * 32 + 8 * fq;
                *(u32x4*)(KN + off) = pack8(acc[ai][0][m][0] * rstd, acc[ai][0][m][1] * rstd);
                *(u32x4*)(V + off) = pack8(acc[ai][1][m][0] * rstd, acc[ai][1][m][1] * rstd); }
    }
};
struct EpiOut {
    static constexpr bool PERM = false, AFTER_DRAIN = false;
    const float* x; float* X1; const float* g1; float* ssq;
    __device__ __forceinline__ void operator()(const f32x4 (&acc)[2][2][4][2], const Unit& u, int wr, int wc, int fr, int fq) const {
        const int row0 = u.pm * BM + wr * 64 + fr, col0 = u.pn * BM + wc * 32 + 4 * fq; const int b = (u.pm * BM) >> 13;
        f32x4 gv[2][2];
#pragma unroll
        for (int bj = 0; bj < 2; ++bj)
#pragma unroll
            for (int n = 0; n < 2; ++n) gv[bj][n] = *(const f32x4*)(g1 + (size_t)b * 6 * DM + col0 + bj * HALF + n * 16);
#pragma unroll
        for (int ai = 0; ai < 2; ++ai)
#pragma unroll
            for (int m = 0; m < 4; ++m) { const int row = row0 + ai * HALF + m * 16; const size_t off = (size_t)row * DM + col0; float ss = 0.f;
#pragma unroll
                for (int bj = 0; bj < 2; ++bj)
#pragma unroll
                    for (int n = 0; n < 2; ++n) { const f32x4 xv = *(const f32x4*)(x + off + bj * HALF + n * 16); const f32x4 o = xv + gv[bj][n] * acc[ai][bj][m][n]; ss += dot4(o); *(f32x4*)(X1 + off + bj * HALF + n * 16) = o; }
                ss += __shfl_xor(ss, 16); ss += __shfl_xor(ss, 32); if (fq == 0) ssq[(size_t)row * 32 + u.pn * 4 + wc] = ss;
                if (m & 1) asm volatile("" ::: "memory"); }
    }
};
struct EpiMoe1 {
    static constexpr bool PERM = true, AFTER_DRAIN = false;
    bf16_t* HM;
    __device__ __forceinline__ void operator()(const f32x4 (&acc)[2][2][4][2], const Unit& u, int wr, int wc, int fr, int fq) const {
        const int row0 = u.pm * BM + wr * 64 + fr, col0 = (u.pn & 3) * 128 + wc * 32 + 8 * fq;
#pragma unroll
        for (int ai = 0; ai < 2; ++ai)
#pragma unroll
            for (int m = 0; m < 4; ++m) { f32x4 h[2];
#pragma unroll
                for (int n = 0; n < 2; ++n)
#pragma unroll
                    for (int e = 0; e < 4; ++e) { const float a = acc[ai][0][m][n][e], b = acc[ai][1][m][n][e]; h[n][e] = a * __builtin_amdgcn_rcpf(1.0f + __expf(-a)) * b; }
                *(u32x4*)(HM + (size_t)(row0 + ai * HALF + m * 16) * DEXP + col0) = pack8(h[0], h[1]); }
    }
};
struct EpiMoe2 {
    static constexpr bool PERM = true, AFTER_DRAIN = false;
    bf16_t* Y; const float* rowgate;
    __device__ __forceinline__ void operator()(const f32x4 (&acc)[2][2][4][2], const Unit& u, int wr, int wc, int fr, int fq) const {
        const int row0 = u.pm * BM + wr * 64 + fr, col0 = (u.pn & 7) * 256 + wc * 32 + 8 * fq;
#pragma unroll
        for (int ai = 0; ai < 2; ++ai)
#pragma unroll
            for (int m = 0; m < 4; ++m) { const int row = row0 + ai * HALF + m * 16; const float gt = rowgate[row];
#pragma unroll
                for (int bj = 0; bj < 2; ++bj) *(u32x4*)(Y + (size_t)row * DM + col0 + bj * HALF) = pack8(acc[ai][bj][m][0] * gt, acc[ai][bj][m][1] * gt); }
    }
};
struct MoeOrder {
    const PG8_LAS int* tile_e; int ntiles, NJ, G, c;
    __device__ __forceinline__ bool next(int i, Unit& u) const { const int L = i * G + c; if (L >= ntiles * NJ) return false; const int rt = L / NJ, j = L - rt * NJ; u.pm = rt; u.pn = tile_e[rt] * NJ + j; return true; }
    __device__ __forceinline__ void a_ready(const Unit&) const {}
    __device__ __forceinline__ void done(const Unit&) const {}
};

template <class Epi, class Sched, bool ALIGN_EPI = false, bool SP2 = false, bool GATHER = false>
__device__ __forceinline__ void gemm_phase(PG8_LAS unsigned char* lds, const Gemm g, const Sched& S, const Epi& E, const PG8_LAS int* toks = nullptr) {
    const int tid = threadIdx.x, wid = __builtin_amdgcn_readfirstlane(tid >> 6), lane = tid & 63, wr = wid >> 2, wc = wid & 3, fr = lane & 15, fq = lane >> 4;
    const int K = g.K, nt = K / BK;
    unsigned voffA[2], voffB[2];
#pragma unroll
    for (int i = 0; i < 2; ++i) { int R, C; stage_rc(tid * 16 + i * 8192, R, C); const int Rb = Epi::PERM ? ((R & ~31) + perm32(R & 31)) : R;
        voffA[i] = (unsigned)(R * g.lda + C) * 2u; voffB[i] = (unsigned)(Rb * K + C) * 2u; }
    const size_t kstep = (size_t)(BK * 2);
    const size_t hstepA = (size_t)HALF * g.lda * 2, hstepB = (size_t)HALF * K * 2;
    const size_t tstepA = 2 * hstepA, tstepB = 2 * hstepB;
    int rA[2], cA2[2];
#pragma unroll
    for (int i = 0; i < 2; ++i) { int R, C; stage_rc(tid * 16 + i * 8192, R, C); rA[i] = R; cA2[i] = C * 2; }
    unsigned vc0[2], vc1[2], vn0[2], vn1[2];
    auto a_offsets = [&](int unit_index, unsigned (&v0)[2], unsigned (&v1)[2]) {
#pragma unroll
        for (int i = 0; i < 2; ++i) {
            if constexpr (GATHER) { v0[i] = (unsigned)toks[unit_index * 256 + rA[i]] * (unsigned)(g.lda * 2) + (unsigned)cA2[i]; v1[i] = (unsigned)toks[unit_index * 256 + 128 + rA[i]] * (unsigned)(g.lda * 2) + (unsigned)cA2[i]; }
            else { v0[i] = voffA[i]; v1[i] = voffA[i] + (unsigned)hstepA; } } };
    const unsigned ldsw = (unsigned)wid * 1024u;
    const int aoff = lds_byte(wr * 64 + fr, fq * 8), boff = lds_byte(wc * 32 + fr, fq * 8);
#define PG8_SA(b, h) (((b) * 2 + (h)) * HTB)
#define PG8_SB(b, h) ((4 + (b) * 2 + (h)) * HTB)
#define PG8_STAGE(bufoff, gbase, voff) do { _Pragma("unroll") for (int _i = 0; _i < 2; ++_i) \
        __builtin_amdgcn_global_load_lds((const unsigned*)((const char*)(gbase) + (voff)[_i]), (PG8_LAS unsigned*)(lds + (bufoff) + ldsw + _i * 8192), 16, 0, 0); } while (0)
#define PG8_LDA(dst, b, h) do { _Pragma("unroll") for (int m = 0; m < 4; ++m) _Pragma("unroll") for (int k = 0; k < 2; ++k) dst[m][k] = *(const PG8_LAS bf16x8*)(lds + PG8_SA(b, h) + aoff + m * 2048 + k * 1024); } while (0)
#define PG8_LDB(dst, b, h) do { _Pragma("unroll") for (int n = 0; n < 2; ++n) _Pragma("unroll") for (int k = 0; k < 2; ++k) dst[n][k] = *(const PG8_LAS bf16x8*)(lds + PG8_SB(b, h) + boff + n * 2048 + k * 1024); } while (0)
#define PG8_MMA(ai, bj, At, Bt) do { __builtin_amdgcn_s_setprio(1); _Pragma("unroll") for (int m = 0; m < 4; ++m) _Pragma("unroll") for (int n = 0; n < 2; ++n) _Pragma("unroll") for (int k = 0; k < 2; ++k) \
        acc[ai][bj][m][n] = __builtin_amdgcn_mfma_f32_16x16x32_bf16(Bt[n][k], At[m][k], acc[ai][bj][m][n], 0, 0, 0); __builtin_amdgcn_s_setprio(0); } while (0)
#define PG8_WAIT_V(n) asm volatile("s_waitcnt vmcnt(" #n ")" ::: "memory")
#define PG8_WAIT_L(n) asm volatile("s_waitcnt lgkmcnt(" #n ")" ::: "memory")
#define PG8_BAR __builtin_amdgcn_s_barrier()
#define PG8_SCHED __builtin_amdgcn_sched_barrier(0)
    Unit cur, nxt; int ui = 0;
    if (!S.next(0, cur)) return;
    f32x4 acc[2][2][4][2];
#pragma unroll
    for (int a = 0; a < 2; ++a)
#pragma unroll
        for (int b = 0; b < 2; ++b)
#pragma unroll
            for (int m = 0; m < 4; ++m)
#pragma unroll
                for (int n = 0; n < 2; ++n) acc[a][b][m][n] = (f32x4){0.f, 0.f, 0.f, 0.f};
    bf16x8 At[4][2], B0[2][2], B1[2][2];
    const char* cA = (const char*)g.A + (GATHER ? (size_t)0 : (size_t)cur.pm * tstepA); a_offsets(0, vc0, vc1); const char* cB = (const char*)g.Bt + (size_t)cur.pn * tstepB;
    S.a_ready(cur);
    if constexpr (SP2) {
        PG8_STAGE(PG8_SB(0, 0), cB, voffB); PG8_STAGE(PG8_SB(0, 1), cB + hstepB, voffB); PG8_STAGE(PG8_SA(0, 0), cA, vc0); PG8_STAGE(PG8_SA(0, 1), cA, vc1);
        if (wr == 1) PG8_BAR;
        PG8_WAIT_V(2); PG8_BAR;
        PG8_STAGE(PG8_SB(1, 0), cB + kstep, voffB); PG8_STAGE(PG8_SA(1, 0), cA + kstep, vc0); PG8_STAGE(PG8_SB(1, 1), cB + hstepB + kstep, voffB);
        PG8_WAIT_V(6); PG8_BAR;
    } else {
        PG8_STAGE(PG8_SB(0, 0), cB, voffB); PG8_STAGE(PG8_SA(0, 0), cA, vc0); PG8_STAGE(PG8_SB(0, 1), cB + hstepB, voffB); PG8_STAGE(PG8_SA(0, 1), cA, vc1);
        if (wr == 1) PG8_BAR;
        PG8_WAIT_V(4); PG8_BAR;
        PG8_STAGE(PG8_SB(1, 0), cB + kstep, voffB); PG8_STAGE(PG8_SA(1, 0), cA + kstep, vc0); PG8_STAGE(PG8_SB(1, 1), cB + hstepB + kstep, voffB);
        PG8_WAIT_V(6); PG8_BAR;
    }
    for (;;) {
        const bool has_next = S.next(ui + 1, nxt);
        const char* nA = has_next ? (const char*)g.A + (GATHER ? (size_t)0 : (size_t)nxt.pm * tstepA) : cA; if (has_next) a_offsets(ui + 1, vn0, vn1); else { vn0[0] = vc0[0]; vn0[1] = vc0[1]; vn1[0] = vc1[0]; vn1[1] = vc1[1]; } const char* nB = has_next ? (const char*)g.Bt + (size_t)nxt.pn * tstepB : cB;
        for (int t = 0; t < nt; t += 2) {
            const bool last = (t == nt - 2);
            const char* a1 = cA + (size_t)(t + 1) * kstep;
            const char* a2 = last ? nA : cA + (size_t)(t + 2) * kstep; const char* b2 = last ? nB : cB + (size_t)(t + 2) * kstep;
            const char* a3 = a2 + kstep; const char* b3 = b2 + kstep;
            unsigned vs0[2], vs1[2];
            vs0[0] = last ? vn0[0] : vc0[0]; vs0[1] = last ? vn0[1] : vc0[1]; vs1[0] = last ? vn1[0] : vc1[0]; vs1[1] = last ? vn1[1] : vc1[1];
            if (last && has_next) S.a_ready(nxt);
            if constexpr (SP2) {
            PG8_LDB(B0, 0, 0); PG8_LDB(B1, 0, 1); PG8_SCHED; PG8_LDA(At, 0, 0); PG8_STAGE(PG8_SA(1, 1), a1, vc1);
            PG8_WAIT_V(8); PG8_WAIT_L(0); PG8_BAR; PG8_MMA(0, 0, At, B0); PG8_MMA(0, 1, At, B1); PG8_BAR; PG8_SCHED;
            PG8_LDA(At, 0, 1); PG8_STAGE(PG8_SB(0, 0), b2, voffB); PG8_STAGE(PG8_SB(0, 1), b2 + hstepB, voffB); PG8_STAGE(PG8_SA(0, 0), a2, vs0);
            PG8_WAIT_V(8); PG8_WAIT_L(0); PG8_BAR; PG8_MMA(1, 0, At, B0); PG8_MMA(1, 1, At, B1); PG8_BAR; PG8_SCHED;
            PG8_LDB(B0, 1, 0); PG8_LDB(B1, 1, 1); PG8_SCHED; PG8_LDA(At, 1, 0); PG8_STAGE(PG8_SA(0, 1), a2, vs1);
            PG8_WAIT_V(8); PG8_WAIT_L(0); PG8_BAR; PG8_MMA(0, 0, At, B0); PG8_MMA(0, 1, At, B1); PG8_BAR; PG8_SCHED;
            PG8_LDA(At, 1, 1); PG8_STAGE(PG8_SB(1, 0), b3, voffB); PG8_STAGE(PG8_SB(1, 1), b3 + hstepB, voffB); PG8_STAGE(PG8_SA(1, 0), a3, vs0);
            PG8_WAIT_V(8); PG8_WAIT_L(0); PG8_BAR; PG8_MMA(1, 0, At, B0); PG8_MMA(1, 1, At, B1); PG8_BAR; PG8_SCHED;
            } else {
            PG8_LDB(B0, 0, 0); PG8_SCHED; PG8_LDA(At, 0, 0); PG8_STAGE(PG8_SA(1, 1), a1, vc1);
            PG8_WAIT_L(8); PG8_BAR; PG8_WAIT_L(0); PG8_MMA(0, 0, At, B0); PG8_BAR; PG8_SCHED;
            PG8_LDB(B1, 0, 1); PG8_STAGE(PG8_SB(0, 0), b2, voffB);
            PG8_BAR; PG8_WAIT_L(0); PG8_MMA(0, 1, At, B1); PG8_BAR;
            PG8_LDA(At, 0, 1); PG8_STAGE(PG8_SA(0, 0), a2, vs0);
            PG8_BAR; PG8_WAIT_L(0); PG8_MMA(1, 0, At, B0); PG8_BAR; PG8_SCHED;
            PG8_STAGE(PG8_SB(0, 1), b2 + hstepB, voffB);
            PG8_WAIT_V(6); PG8_BAR; PG8_MMA(1, 1, At, B1); PG8_BAR;
            PG8_LDB(B0, 1, 0); PG8_SCHED; PG8_LDA(At, 1, 0); PG8_STAGE(PG8_SA(0, 1), a2, vs1);
            PG8_WAIT_L(8); PG8_BAR; PG8_WAIT_L(0); PG8_MMA(0, 0, At, B0); PG8_BAR; PG8_SCHED;
            PG8_LDB(B1, 1, 1); PG8_STAGE(PG8_SB(1, 0), b3, voffB);
            PG8_BAR; PG8_WAIT_L(0); PG8_MMA(0, 1, At, B1); PG8_BAR;
            PG8_LDA(At, 1, 1); PG8_STAGE(PG8_SA(1, 0), a3, vs0);
            PG8_BAR; PG8_WAIT_L(0); PG8_MMA(1, 0, At, B0); PG8_BAR; PG8_SCHED;
            PG8_STAGE(PG8_SB(1, 1), b3 + hstepB, voffB);
            PG8_WAIT_V(6); PG8_BAR; PG8_MMA(1, 1, At, B1); PG8_BAR;
            }
        }
        if constexpr (ALIGN_EPI) { if (wr == 0) PG8_BAR; }
        if constexpr (!Epi::AFTER_DRAIN) { E(acc, cur, wr, wc, fr, fq); S.done(cur); }
        if (!has_next) break;
#pragma unroll
        for (int a = 0; a < 2; ++a)
#pragma unroll
            for (int b = 0; b < 2; ++b)
#pragma unroll
                for (int m = 0; m < 4; ++m)
#pragma unroll
                    for (int n = 0; n < 2; ++n) acc[a][b][m][n] = (f32x4){0.f, 0.f, 0.f, 0.f};
        cur = nxt; cA = nA; cB = nB; ++ui; vc0[0] = vn0[0]; vc0[1] = vn0[1]; vc1[0] = vn1[0]; vc1[1] = vn1[1];
        if constexpr (ALIGN_EPI) { if (wr == 1) PG8_BAR; }
    }
    PG8_WAIT_V(0);
    if constexpr (!ALIGN_EPI) { if (wr == 0) PG8_BAR; }
    PG8_BAR;
    if constexpr (Epi::AFTER_DRAIN) { E.fused(acc, cur, wr, wc, fr, fq, lds, wid, lane); S.done(cur); }
#undef PG8_SA
#undef PG8_SB
#undef PG8_STAGE
#undef PG8_LDA
#undef PG8_LDB
#undef PG8_MMA
#undef PG8_WAIT_V
#undef PG8_WAIT_L
#undef PG8_BAR
#undef PG8_SCHED
}
}

namespace att {
using bf16x8 = __attribute__((ext_vector_type(8))) short;
using u32x4 = __attribute__((ext_vector_type(4))) unsigned;
constexpr int D = 128, DR = 64, NW = 8, QBLK = 32, KVBLK = 64;
constexpr float SCALE = 0.07216878364870322f;
constexpr float THR = 8.f;
#ifndef ATT_SDEPTH
#define ATT_SDEPTH 1
#endif
#ifndef ATT_QROPE_LDS
#define ATT_QROPE_LDS 1
#endif
constexpr int SDEPTH = ATT_SDEPTH; constexpr bool QROPE_LDS = ATT_QROPE_LDS;
constexpr int LDQ = 1536, LDK = 128, LDR = 64, LDO = 2048;
constexpr int SHM_V = KVBLK * D * 2, SHM_K = KVBLK * D * 2, SHM_R = KVBLK * DR * 2;
constexpr int OFF_V = 0, OFF_K = 2 * SHM_V, OFF_R = OFF_K + 2 * SHM_K, OFF_WS = OFF_R + 2 * SHM_R, OFF_QR = OFF_WS + NW * 64 * 4, SHM_ATTN = OFF_QR + 256 * DR * 2;
#define KSWZ(row, colB) ((row) * 256 + ((colB) ^ (((row) & 7) << 4)))
#define RSWZ(row, colB) ((row) * 128 + ((colB) ^ ((((row) >> 1) & 7) << 4)))
#define SBAR() __builtin_amdgcn_sched_barrier(0)
__device__ __forceinline__ int crow(int r, int hi) { return (r & 3) + 8 * (r >> 2) + 4 * hi; }
__device__ __forceinline__ unsigned cvtpk(float lo, float hi) { unsigned r; asm volatile("v_cvt_pk_bf16_f32 %0, %1, %2" : "=v"(r) : "v"(lo), "v"(hi)); return r; }
__device__ __forceinline__ void partialSM(f32x16& p0, f32x16& p1, float& m_reg, float& mn, float& alpha) {
  constexpr float C = SCALE * 1.4426950408889634f;
  float pmax = p0[0]; for (int r = 1; r < 16; ++r) pmax = fmaxf(pmax, p0[r]); for (int r = 0; r < 16; ++r) pmax = fmaxf(pmax, p1[r]);
  { auto rr = __builtin_amdgcn_permlane32_swap(__float_as_uint(pmax), __float_as_uint(pmax), false, false);
    pmax = fmaxf(__uint_as_float(rr[0]), __uint_as_float(rr[1])); }
  if (__builtin_expect(__all(pmax - m_reg <= THR / SCALE), 1)) { mn = m_reg; alpha = 1.f; }
  else { mn = fmaxf(m_reg, pmax); alpha = __builtin_amdgcn_exp2f((m_reg - mn) * C); m_reg = mn; }
  float mnC = -mn * C;
  for (int r = 0; r < 16; ++r) p0[r] = fmaf(p0[r], C, mnC); for (int r = 0; r < 16; ++r) p1[r] = fmaf(p1[r], C, mnC);
  for (int r = 0; r < 16; ++r) p0[r] = __builtin_amdgcn_exp2f(p0[r]);
}
__device__ __forceinline__ void finishSM(f32x16& p0, f32x16& p1, float alpha, float& l_reg, bf16x8& pa0, bf16x8& pa1, bf16x8& pa2, bf16x8& pa3) {
  for (int r = 0; r < 16; ++r) p1[r] = __builtin_amdgcn_exp2f(p1[r]);
  float ps = 0; for (int r = 0; r < 16; ++r) ps += p0[r]; for (int r = 0; r < 16; ++r) ps += p1[r];
  { auto rr = __builtin_amdgcn_permlane32_swap(__float_as_uint(ps), __float_as_uint(ps), false, false);
    ps = __uint_as_float(rr[0]) + __uint_as_float(rr[1]); }
  l_reg = l_reg * alpha + ps;
#define PK4(P, BASE, OUT) do { unsigned a0 = cvtpk(P[BASE + 0], P[BASE + 1]), a1 = cvtpk(P[BASE + 2], P[BASE + 3]);   \
    unsigned b0 = cvtpk(P[BASE + 4], P[BASE + 5]), b1 = cvtpk(P[BASE + 6], P[BASE + 7]);                              \
    auto r0 = __builtin_amdgcn_permlane32_swap(a0, b0, false, false); auto r1 = __builtin_amdgcn_permlane32_swap(a1, b1, false, false); \
    u32x4 w = {r0[0], r1[0], r0[1], r1[1]}; OUT = *reinterpret_cast<bf16x8*>(&w); } while (0)
  PK4(p0, 0, pa0); PK4(p0, 8, pa1); PK4(p1, 0, pa2); PK4(p1, 8, pa3);
#undef PK4
}
__device__ __forceinline__ void qkt(f32x16& p0, f32x16& p1, const char* Ks, const char* Rs, const bf16x8* qr, int r32, int hi, const char* Qrs) {
  p0 = f32x16{}; p1 = f32x16{};
#pragma unroll
  for (int d0 = 0; d0 < 8; ++d0) { int cb = (d0 * 16 + hi * 8) * 2;
    bf16x8 b0 = *reinterpret_cast<const bf16x8*>(Ks + KSWZ(r32, cb));
    bf16x8 b1 = *reinterpret_cast<const bf16x8*>(Ks + KSWZ(32 + r32, cb));
    p0 = __builtin_amdgcn_mfma_f32_32x32x16_bf16(b0, qr[d0], p0, 0, 0, 0);
    p1 = __builtin_amdgcn_mfma_f32_32x32x16_bf16(b1, qr[d0], p1, 0, 0, 0);
#ifdef ATT_QK_SBAR
    if (d0 == 3 || d0 == 7) SBAR();
#endif
  }
#pragma unroll
  for (int d0 = 0; d0 < 4; ++d0) { int cb = (d0 * 16 + hi * 8) * 2;
    bf16x8 b0 = *reinterpret_cast<const bf16x8*>(Rs + d0 * 2048 + r32 * 32 + hi * 16);
    bf16x8 b1 = *reinterpret_cast<const bf16x8*>(Rs + d0 * 2048 + 1024 + r32 * 32 + hi * 16);
    bf16x8 qf; if constexpr (QROPE_LDS) qf = *reinterpret_cast<const bf16x8*>(Qrs + d0 * 8192); else qf = qr[8 + d0];
    p0 = __builtin_amdgcn_mfma_f32_32x32x16_bf16(b0, qf, p0, 0, 0, 0);
    p1 = __builtin_amdgcn_mfma_f32_32x32x16_bf16(b1, qf, p1, 0, 0, 0); }
}
__device__ __forceinline__ int v_st(int k, int c) { const int kk = (k & ~0xC) | ((k & 4) << 1) | ((k & 8) >> 1); return ((kk >> 3) * 4 + (c >> 5)) * 512 + ((kk & 7) * 32 + (c & 31)) * 2; }
__device__ __forceinline__ int v_rd_base(int lane) { return ((lane & 3) << 3) | (((lane >> 2) & 3) << 6) | (((lane >> 4) & 1) << 5) | (((lane >> 5) & 1) << 8); }
constexpr int v_rd_off(int d0, int ks, int half) { return d0 * 512 + ks * 4096 + half * 2048; }
template <int OFF> __device__ __forceinline__ s16x4 tr_read(int vb) {
  s16x4 r; asm volatile("ds_read_b64_tr_b16 %0, %1 offset:%2" : "=&v"(r) : "v"(vb), "i"(OFF) : "memory"); return r;
}
template <int D0> __device__ __forceinline__ void pv_one(f32x16& od, int vb, bf16x8 pa0, bf16x8 pa1, bf16x8 pa2, bf16x8 pa3) {
  const s16x4 l0 = tr_read<v_rd_off(D0, 0, 0)>(vb), h0 = tr_read<v_rd_off(D0, 0, 1)>(vb), l1 = tr_read<v_rd_off(D0, 1, 0)>(vb), h1 = tr_read<v_rd_off(D0, 1, 1)>(vb);
  const s16x4 l2 = tr_read<v_rd_off(D0, 2, 0)>(vb), h2 = tr_read<v_rd_off(D0, 2, 1)>(vb), l3 = tr_read<v_rd_off(D0, 3, 0)>(vb), h3 = tr_read<v_rd_off(D0, 3, 1)>(vb);
  asm volatile("s_waitcnt lgkmcnt(0)" ::: "memory"); SBAR();
#define PK(L, H) (bf16x8){L[0], L[1], L[2], L[3], H[0], H[1], H[2], H[3]}
  od = __builtin_amdgcn_mfma_f32_32x32x16_bf16(pa0, PK(l0, h0), od, 0, 0, 0);
  od = __builtin_amdgcn_mfma_f32_32x32x16_bf16(pa1, PK(l1, h1), od, 0, 0, 0);
  od = __builtin_amdgcn_mfma_f32_32x32x16_bf16(pa2, PK(l2, h2), od, 0, 0, 0);
  od = __builtin_amdgcn_mfma_f32_32x32x16_bf16(pa3, PK(l3, h3), od, 0, 0, 0);
#undef PK
}
__device__ __forceinline__ void pv_d0(f32x16* o, int vb, bf16x8 pa0, bf16x8 pa1, bf16x8 pa2, bf16x8 pa3) {
  pv_one<0>(o[0], vb, pa0, pa1, pa2, pa3); pv_one<1>(o[1], vb, pa0, pa1, pa2, pa3); pv_one<2>(o[2], vb, pa0, pa1, pa2, pa3); pv_one<3>(o[3], vb, pa0, pa1, pa2, pa3);
}
__device__ __forceinline__ void attn_dense_body(const bf16* __restrict__ Qb, const bf16* __restrict__ Kh, const bf16* __restrict__ Vh, const bf16* __restrict__ Rh,
                                                bf16* __restrict__ Ob, int seq, char* lds) {
  const int tid = threadIdx.x, wid = tid >> 6, lane = tid & 63, r32 = lane & 31, hi = lane >> 5;
  char* V_lds = lds + OFF_V; char* K_lds = lds + OFF_K; char* R_lds = lds + OFF_R;
  float* ws = (float*)(lds + OFF_WS) + wid * 64; float* li_l = ws; float* al_l = ws + 32;
  float m_reg = -1e30f, l_reg = 0; f32x16 o[4] = {}; bf16x8 qr[QROPE_LDS ? 8 : 12];
  int tq_ = threadIdx.x; asm volatile("" : "+v"(tq_));
  const bf16* Qw = (const bf16*)((const char*)Qb + (unsigned)((((tq_ >> 6) * QBLK + (tq_ & 31)) * LDQ + ((tq_ >> 5) & 1) * 8) * 2));
  const char* Qrs = lds + OFF_QR + (wid * QBLK + r32) * 32 + hi * 16;
#pragma unroll
  for (int d0 = 0; d0 < (QROPE_LDS ? 8 : 12); ++d0) qr[d0] = *reinterpret_cast<const bf16x8*>(Qw + d0 * 16);
  if constexpr (QROPE_LDS) {
#pragma unroll
    for (int d0 = 0; d0 < 4; ++d0) { const bf16x8 t = *reinterpret_cast<const bf16x8*>(Qw + 128 + d0 * 16); *(bf16x8*)(lds + OFF_QR + d0 * 8192 + (wid * QBLK + r32) * 32 + hi * 16) = t; }
    asm volatile("s_waitcnt lgkmcnt(0)" ::: "memory");
  }
  const int sr = tid >> 4, sc = (tid & 15) * 8, vst0 = v_st(sr, sc), vst1 = v_st(32 + sr, sc);
  const int rr_ = tid >> 3, rc_ = (tid & 7) * 8, rst_ = (rc_ >> 4) * 2048 + rr_ * 32 + (rc_ & 8) * 2;
  const int vb0 = (int)(uintptr_t)(V_lds) + v_rd_base(lane);
  struct { bf16x8 vs0, vs1, ks0, ks1, rs0; } sr_[SDEPTH];
  const unsigned kvo_ = (unsigned)((sr * LDK + sc) * 2), ro_ = (unsigned)((rr_ * LDR + rc_) * 2);
#define SLOAD(i, k0) do { const char* vb_ = (const char*)Vh + (size_t)(k0) * (LDK * 2); const char* kb_ = (const char*)Kh + (size_t)(k0) * (LDK * 2); const char* rb_ = (const char*)Rh + (size_t)(k0) * (LDR * 2); \
    sr_[i].vs0 = *(const bf16x8*)(vb_ + kvo_); sr_[i].vs1 = *(const bf16x8*)(vb_ + 32 * LDK * 2 + kvo_); \
    sr_[i].ks0 = *(const bf16x8*)(kb_ + kvo_); sr_[i].ks1 = *(const bf16x8*)(kb_ + 32 * LDK * 2 + kvo_); \
    sr_[i].rs0 = *(const bf16x8*)(rb_ + ro_); } while (0)
#define SWRITE(b, i) do { *(bf16x8*)(V_lds + (b) * SHM_V + vst0) = sr_[i].vs0;          \
    *(bf16x8*)(V_lds + (b) * SHM_V + vst1) = sr_[i].vs1; int kc = sc * 2;               \
    *(bf16x8*)(K_lds + (b) * SHM_K + KSWZ(sr, kc)) = sr_[i].ks0;                       \
    *(bf16x8*)(K_lds + (b) * SHM_K + KSWZ(32 + sr, kc)) = sr_[i].ks1;                  \
    *(bf16x8*)(R_lds + (b) * SHM_R + rst_) = sr_[i].rs0; } while (0)
#define SWAIT() do { if constexpr (SDEPTH == 2) asm volatile("s_waitcnt vmcnt(5)" ::: "memory"); else asm volatile("s_waitcnt vmcnt(0)" ::: "memory"); } while (0)
#define RESC(a) do { if (__any((a) < 1.f)) { if (hi == 0) al_l[r32] = (a); asm volatile("s_waitcnt lgkmcnt(0)" ::: "memory"); \
    for (int d = 0; d < 4; ++d) for (int r = 0; r < 16; ++r) o[d][r] *= al_l[crow(r, hi)]; } } while (0)
  f32x16 pA0, pA1, pB0, pB1; float mnA, mnB, alA, alB; bf16x8 pa0, pa1, pa2, pa3; const int NT = seq / KVBLK;
  constexpr int SE = 0, SO = SDEPTH - 1;
  SLOAD(SE, 0); asm volatile("s_waitcnt vmcnt(0)" ::: "memory"); SWRITE(0, SE); __syncthreads();
  qkt(pA0, pA1, K_lds, R_lds, qr, r32, hi, Qrs); partialSM(pA0, pA1, m_reg, mnA, alA);
  SLOAD(SO, KVBLK); if constexpr (SDEPTH == 2) { if (2 < NT) SLOAD(SE, 2 * KVBLK); }
  SWAIT(); SWRITE(1, SO); __syncthreads();
  for (int j = 1; j + 1 < NT; j += 2) {
    SBAR(); qkt(pB0, pB1, K_lds + SHM_K, R_lds + SHM_R, qr, r32, hi, Qrs);
    finishSM(pA0, pA1, alA, l_reg, pa0, pa1, pa2, pa3); SBAR();
    SLOAD(SO, (j + SDEPTH) * KVBLK); SBAR();
    pv_d0(o, vb0, pa0, pa1, pa2, pa3); partialSM(pB0, pB1, m_reg, mnB, alB);
    __syncthreads(); SWAIT(); SWRITE(0, SE);
    RESC(alB); __syncthreads();
    SBAR(); qkt(pA0, pA1, K_lds, R_lds, qr, r32, hi, Qrs);
    finishSM(pB0, pB1, alB, l_reg, pa0, pa1, pa2, pa3); SBAR();
    if (SDEPTH == 1 || j + 3 < NT) SLOAD(SE, (j + 1 + SDEPTH) * KVBLK); SBAR();
    pv_d0(o, vb0 + SHM_V, pa0, pa1, pa2, pa3); partialSM(pA0, pA1, m_reg, mnA, alA);
    __syncthreads(); SWAIT(); SWRITE(1, SO);
    RESC(alA); __syncthreads();
  }
  SBAR(); qkt(pB0, pB1, K_lds + SHM_K, R_lds + SHM_R, qr, r32, hi, Qrs);
  finishSM(pA0, pA1, alA, l_reg, pa0, pa1, pa2, pa3); SBAR();
  pv_d0(o, vb0, pa0, pa1, pa2, pa3); partialSM(pB0, pB1, m_reg, mnB, alB);
  __syncthreads(); RESC(alB);
  finishSM(pB0, pB1, alB, l_reg, pa0, pa1, pa2, pa3); SBAR();
  pv_d0(o, vb0 + SHM_V, pa0, pa1, pa2, pa3);
  if (hi == 0) li_l[r32] = l_reg; asm volatile("s_waitcnt lgkmcnt(0)" ::: "memory");
  float rli[16];
#pragma unroll
  for (int r = 0; r < 16; ++r) rli[r] = __builtin_amdgcn_rcpf(li_l[crow(r, hi)]);
  int tl_ = threadIdx.x; asm volatile("" : "+v"(tl_));
  const unsigned oo_ = (unsigned)((((tl_ >> 6) * QBLK + 4 * ((tl_ >> 5) & 1)) * LDO + (tl_ & 31)) * 2);
#pragma unroll
  for (int r = 0; r < 16; ++r) { const char* ob_ = (const char*)Ob + (size_t)(((r & 3) + 8 * (r >> 2)) * LDO * 2);
#pragma unroll
    for (int d0 = 0; d0 < 4; ++d0) { const unsigned w = cvtpk(o[d0][r] * rli[r], 0.f); *(bf16*)(ob_ + d0 * 64 + oo_) = (bf16)(w & 0xffffu); } }
  __syncthreads();
#undef SLOAD
#undef SWRITE
#undef SWAIT
#undef RESC
}
}


constexpr int NWAVES = 8, NTHR = 512;
constexpr int N_PHASES = 14;
#ifndef MK_N_LAUNCHES
#define MK_N_LAUNCHES 1
#endif
constexpr int N_LAUNCHES = MK_N_LAUNCHES;

constexpr size_t MiB = 1u << 20;
constexpr size_t WS_CTL = 0, CTL_ZERO_BYTES = 1 * MiB;
constexpr size_t WS_X1SS = 1 * MiB;
constexpr size_t WS_MODP = 1 * MiB, WS_MODF = 4 * MiB, WS_RSS = 5 * MiB, WS_ROUTE = 6 * MiB, WS_BON = 7 * MiB, WS_WRT = 8 * MiB, WS_LORA = 9 * MiB;
constexpr size_t WS_WTUQ = 10 * MiB, WS_WTUKV = 12 * MiB, WS_WTOUT = 13 * MiB, WS_WTIN = 21 * MiB;
constexpr size_t WS_SCAN = 40 * MiB, SCAN_ARR = (size_t)NB * RH * NKEY * RN * 2;
constexpr int A_R = 0, A_KK = 1, A_W = 2, A_K = 4, A_B = 6, A_V = 8;
constexpr size_t WS_H = 40 * MiB;
constexpr size_t WS_G = 337 * MiB;
constexpr size_t WS_P = 369 * MiB;
constexpr size_t WS_Q = 510 * MiB, WS_KN = 558 * MiB, WS_V = 591 * MiB, WS_KR = 624 * MiB;
constexpr size_t WS_MIX = 369 * MiB;
constexpr size_t WS_MN = 433 * MiB;
constexpr size_t WS_YS = 40 * MiB;
constexpr size_t WS_W13T = 168 * MiB, WS_W2T = 565 * MiB;
constexpr size_t WS_H2 = 40 * MiB, WS_XG = 296 * MiB, WS_HM = 456 * MiB, WS_Y = 296 * MiB;
constexpr size_t WS_END = 629 * MiB;
constexpr int NCHUNK = NKEY / 64;
static_assert(WS_SCAN + 9 * SCAN_ARR <= WS_G && WS_G + (size_t)MROWS * RW * 2 <= WS_P && WS_P + (size_t)MALL * NINP * 2 <= WS_Q, "ws map 1");
static_assert(WS_Q + (size_t)MROWS * 1536 * 2 <= WS_KN && WS_KN + (size_t)NB * 8 * NKEY * 128 * 2 <= WS_V && WS_V + (size_t)NB * 8 * NKEY * 128 * 2 <= WS_KR && WS_KR + (size_t)NB * NKEY * 64 * 2 <= WS_END, "ws map 2");
static_assert(WS_MIX + (size_t)MROWS * DM * 2 <= WS_MN && WS_MN + (size_t)NB * RH * NCHUNK * 2 * 16384 <= WS_W2T && WS_W2T + (size_t)NEXP * DM * DEXP * 2 <= WS_END, "ws map 3");
static_assert(WS_YS + (size_t)2 * MROWS * RW * 4 <= WS_W13T && WS_W13T + (size_t)NEXP * 1024 * DM * 2 <= WS_XG && WS_W13T >= WS_SCAN && WS_XG <= WS_SCAN + 8 * SCAN_ARR, "ws map 4: Y and W13T overlay only the scan inputs that are dead after the chunk builder");
static_assert(WS_H2 + (size_t)MROWS * DM * 2 <= WS_W13T && WS_XG + (size_t)MAXTILES * 256 * DM * 2 <= WS_HM && WS_HM + (size_t)MAXTILES * 256 * DEXP * 2 <= WS_W2T, "ws map 5");
static_assert(WS_WTIN + (size_t)NINP * DM * 2 <= WS_SCAN && WS_H + (size_t)MALL * DM * 2 <= WS_G, "ws map 6");
constexpr int CW_CNT = 64;
constexpr int CW_ROWTOK = 131072;
constexpr int CW_CONVQ = 128;
constexpr int CW_BAR = 4096;
constexpr size_t RT_E = 0, RT_POS = 131072, RT_GATE = 262144, RT_ROW = 393216, RT_RGATE = 524288;

constexpr int RING_BYTES = 131072, EXTRA_OFF = 131072, LDS_BYTES = 155648, MISC_OFF = LDS_BYTES - 512;
constexpr int LORA_IMG = 2 * 128 * 72 + 64 * 168;

#define LDS_WAIT() asm volatile("s_waitcnt lgkmcnt(0)" ::: "memory")
#define VM_WAIT() asm volatile("s_waitcnt vmcnt(0)" ::: "memory")
__device__ __forceinline__ unsigned f2bf(float f) { unsigned u = __builtin_bit_cast(unsigned, f); return (u + 0x7fffu + ((u >> 16) & 1u)) >> 16; }
__device__ __forceinline__ unsigned pk2(float lo, float hi) { return pg8::cvt_pk_bf16(lo, hi); }
__device__ __forceinline__ float bflo(unsigned w) { return __builtin_bit_cast(float, w << 16); }
__device__ __forceinline__ float bfhi(unsigned w) { return __builtin_bit_cast(float, w & 0xffff0000u); }
__device__ __forceinline__ float bf1(bf16 h) { return __builtin_bit_cast(float, (unsigned)h << 16); }
__device__ __forceinline__ void unpack8(const v4u w, float (&f)[8]) { f[0] = bflo(w.x); f[1] = bfhi(w.x); f[2] = bflo(w.y); f[3] = bfhi(w.y); f[4] = bflo(w.z); f[5] = bfhi(w.z); f[6] = bflo(w.w); f[7] = bfhi(w.w); }
__device__ __forceinline__ v4u pack8f(const float (&f)[8]) { v4u w; w.x = pk2(f[0], f[1]); w.y = pk2(f[2], f[3]); w.z = pk2(f[4], f[5]); w.w = pk2(f[6], f[7]); return w; }
__device__ __forceinline__ float wave_sum(float v) {
#pragma unroll
    for (int o = 1; o < 64; o <<= 1) v += __shfl_xor(v, o);
    return v;
}
__device__ __forceinline__ float sigmoidf_(float x) { return __builtin_amdgcn_rcpf(1.0f + __expf(-x)); }

template <int CTRL> __device__ __forceinline__ float dpp_add(float x) { return x + __builtin_bit_cast(float, __builtin_amdgcn_update_dpp(0, __builtin_bit_cast(int, x), CTRL, 0xf, 0xf, false)); }
__device__ __forceinline__ float red16(float x) { x = dpp_add<0xB1>(x); x = dpp_add<0x4E>(x); x = dpp_add<0x141>(x); x = dpp_add<0x140>(x); return x; }
#define MFMA_DRAIN() do { __builtin_amdgcn_sched_barrier(0); asm volatile("s_nop 15\n\ts_nop 15" ::: "memory"); __builtin_amdgcn_sched_barrier(0); } while (0)
#define XB_TMO      128
#define XB_XCNT(j)  (256  + 64 * (j))
#define XB_XSUB(j)  (1280 + 64 * (j))
#define XB_XGEN(j)  (2304 + 64 * (j))
#define XB_TOP      3328
#define XB_TOPGEN   3392
#define XCD_BAR_WORDS 3456
#define XB_SPIN_CAP (1u << 18)

__device__ __forceinline__ unsigned xb_ld(unsigned* p)              { return __hip_atomic_load(p, __ATOMIC_RELAXED, __HIP_MEMORY_SCOPE_AGENT); }
__device__ __forceinline__ unsigned xb_add(unsigned* p, unsigned v) { return __hip_atomic_fetch_add(p, v, __ATOMIC_RELAXED, __HIP_MEMORY_SCOPE_AGENT); }
__device__ __forceinline__ unsigned xb_xcc_id() { return (unsigned)__builtin_amdgcn_s_getreg((3 << 11) | 20) & 0xFu; }
#define XB_SPIN(cond, bar) do { unsigned _sp = 0; while (cond) { __builtin_amdgcn_s_sleep(1); \
    if ((++_sp & 255u) == 0u) { if (xb_ld(&(bar)[XB_TMO])) break; if (_sp > XB_SPIN_CAP) { atomicAdd(&(bar)[XB_TMO], 1u); break; } } } } while (0)

struct XcdBarrier {
    unsigned* bar; unsigned x;
    volatile LAS unsigned* st;
};

__device__ __forceinline__ XcdBarrier xcd_barrier_post(unsigned* bar, volatile LAS unsigned* st) {
    XcdBarrier b; b.bar = bar; b.x = xb_xcc_id(); b.st = st;
    if (threadIdx.x == 0) (void)xb_add(&bar[XB_XCNT(b.x)], 1u);
    return b;
}
__device__ __forceinline__ void xcd_barrier_complete(unsigned* bar, unsigned x, unsigned& nloc, unsigned& nx) {
    const unsigned G = gridDim.x * gridDim.y * gridDim.z;
    unsigned sum, cnt, mine, sp = 0u;
    for (;;) {
        sum = 0u; cnt = 0u; mine = 0u;
#pragma unroll
        for (unsigned j = 0; j < 16; ++j) { const unsigned c = xb_ld(&bar[XB_XCNT(j)]); sum += c; cnt += (c > 0u) ? 1u : 0u; mine = (j == x) ? c : mine; }
        if (sum == G) break;
        __builtin_amdgcn_s_sleep(1);
        if ((++sp & 255u) == 0u) { if (xb_ld(&bar[XB_TMO])) break; if (sp > XB_SPIN_CAP) { atomicAdd(&bar[XB_TMO], 1u); break; } }
    }
    nloc = mine > 0u ? mine : 1u; nx = cnt > 0u ? cnt : 1u;
}

__device__ __forceinline__ void xcd_barrier(const XcdBarrier& b) {
    asm volatile("s_waitcnt vmcnt(0)" ::: "memory");
    __syncthreads();
    if (threadIdx.x == 0) {
        unsigned* bar = b.bar;
        __builtin_amdgcn_s_waitcnt(0);
        unsigned nloc = b.st[0], nx = b.st[1];
        if (nloc == 0u) { xcd_barrier_complete(bar, b.x, nloc, nx); b.st[0] = nloc; b.st[1] = nx; }
        const unsigned old = xb_add(&bar[XB_XSUB(b.x)], 1u);
        const unsigned gen = old / nloc;
        if (old + 1u == (gen + 1u) * nloc) {
            __builtin_amdgcn_fence(__ATOMIC_RELEASE, "agent");
            asm volatile("s_waitcnt vmcnt(0)" ::: "memory");
            const unsigned og = xb_add(&bar[XB_TOP], 1u);
            const unsigned tg = og / nx;
            if (og + 1u == (tg + 1u) * nx) xb_add(&bar[XB_TOPGEN], 1u);
            else XB_SPIN(xb_ld(&bar[XB_TOPGEN]) == tg, bar);
            __builtin_amdgcn_fence(__ATOMIC_ACQUIRE, "agent");
            xb_add(&bar[XB_XGEN(b.x)], 1u);
            asm volatile("s_waitcnt vmcnt(0)" ::: "memory");
        } else {
            XB_SPIN(xb_ld(&bar[XB_XGEN(b.x)]) == gen, bar);
            __builtin_amdgcn_fence(__ATOMIC_ACQUIRE, "agent");
            asm volatile("s_waitcnt vmcnt(0)" ::: "memory");
        }
    }
    __syncthreads();
}

struct Frame {
    char* lds;
    volatile LAS unsigned* MISC;
    unsigned* ctl;
    unsigned char* ws;
    int tid, lane, wave, G, bid;
    const float* const __attribute__((address_space(4)))* in;
    float* out;
};

__device__ __forceinline__ void transpose_item(const float* W, int K, int N, bf16* WT, int row_off, const float* kscale, float* scr, int item, int lane) {
    const int nblk = N / 32, kb = item / nblk, nb = item % nblk, k0 = 64 * kb, n0 = 32 * nb;
    float tv[32];
#pragma unroll
    for (int i = 0; i < 32; ++i) tv[i] = W[(size_t)(k0 + 2 * i + (lane >> 5)) * N + n0 + (lane & 31)];
#pragma unroll
    for (int i = 0; i < 32; ++i) { const int kk = 2 * i + (lane >> 5); float v = tv[i]; if (kscale) v *= kscale[k0 + kk]; scr[kk * 33 + (lane & 31)] = v; }
    LDS_WAIT(); asm volatile("" ::: "memory");
    const int c = lane & 7;
#pragma unroll
    for (int j = 0; j < 4; ++j) { const int n = (lane >> 3) + 8 * j; const float* s = scr + (8 * c) * 33 + n;
        v4u o; o.x = pk2(s[0 * 33], s[1 * 33]); o.y = pk2(s[2 * 33], s[3 * 33]); o.z = pk2(s[4 * 33], s[5 * 33]); o.w = pk2(s[6 * 33], s[7 * 33]);
        *(v4u*)(WT + (size_t)(row_off + n0 + n) * K + k0 + 8 * c) = o; }
    LDS_WAIT(); asm volatile("" ::: "memory");
}

__device__ __forceinline__ void small_conversions(Frame& F, const int gt, const int NGT) {
    { bf16* wr = (bf16*)(F.ws + WS_WRT);
      for (int i = gt; i < 48 * DM; i += NGT) { const int n = i / DM, k = i - n * DM; float v = 0.f; if (n < 4) v = F.in[25][k * 4 + n]; else if (n < 36) v = F.in[27][k * 32 + (n - 4)]; wr[i] = (bf16)f2bf(v); } }
    { bf16* lw = (bf16*)(F.ws + WS_LORA);
      for (int i = gt; i < RH * LORA_IMG; i += NGT) { const int h = i / LORA_IMG, o = i - h * LORA_IMG; float v = 0.f;
          if (o < 2 * 128 * 72) { const int which = o / (128 * 72), oo = o - which * 128 * 72, r = oo / 72, k = oo - r * 72;
              if (k < 64) v = F.in[which ? 17 : 15][(size_t)((r >> 6) * 64 + k) * RW + h * 64 + (r & 63)]; }
          else { const int oo = o - 2 * 128 * 72, ch = oo / 168, k = oo - ch * 168; if (k < 160) v = F.in[18][(size_t)k * RW + h * 64 + ch]; }
          lw[i] = (bf16)f2bf(v); } }
}

__device__ __forceinline__ void phase0(Frame& F) {
    float* st = (float*)F.lds;
    for (int i = F.tid; i < 3 * DM; i += NTHR) { const int j = i / DM, k = i - j * DM; const float v = j < 2 ? F.in[1][j * DM + k] : F.in[3][k]; st[i] = v * sigmoidf_(v); }
    __syncthreads();
    const int gw = F.bid * NWAVES + F.wave, NGW = F.G * NWAVES;
    const float* wmod = F.in[4]; float* modp = (float*)(F.ws + WS_MODP);
    for (int it = gw; it < 768; it += NGW) {
        const int cc = it % 48, ks = it / 48, n0 = cc * 256 + F.lane * 4;
        pg8::f32x4 a0 = {0.f, 0.f, 0.f, 0.f}, a1 = a0, a2 = a0;
        const float* wp = wmod + (size_t)(ks * 128) * (6 * DM) + n0;
#pragma unroll 8
        for (int k = 0; k < 128; ++k) { const pg8::f32x4 w = *(const pg8::f32x4*)(wp + (size_t)k * (6 * DM)); const int kk = ks * 128 + k;
            a0 += w * st[kk]; a1 += w * st[DM + kk]; a2 += w * st[2 * DM + kk]; }
        *(pg8::f32x4*)(modp + (size_t)(ks * 3 + 0) * (6 * DM) + n0) = a0; *(pg8::f32x4*)(modp + (size_t)(ks * 3 + 1) * (6 * DM) + n0) = a1; *(pg8::f32x4*)(modp + (size_t)(ks * 3 + 2) * (6 * DM) + n0) = a2;
    }
    __syncthreads();
    float* scr = (float*)(F.lds + F.wave * 8448);
    constexpr int I_IN = (DM / 64) * (NIN / 32), I_UQ = (512 / 64) * (1536 / 32), I_UKV = (256 / 64) * (2048 / 32), I_OUT = (DM / 64) * (DM / 32);
    for (int it = gw; it < I_IN + I_UQ + I_UKV + I_OUT; it += NGW) {
        int r = it;
        if (r < I_IN) { transpose_item(F.in[8], DM, NIN, (bf16*)(F.ws + WS_WTIN), 0, nullptr, scr, r, F.lane); continue; } r -= I_IN;
        if (r < I_UQ) { transpose_item(F.in[11], 512, 1536, (bf16*)(F.ws + WS_WTUQ), 0, F.in[10], scr, r, F.lane); continue; } r -= I_UQ;
        if (r < I_UKV) { transpose_item(F.in[13], 256, 2048, (bf16*)(F.ws + WS_WTUKV), 0, F.in[12], scr, r, F.lane); continue; } r -= I_UKV;
        transpose_item(F.in[24], DM, DM, (bf16*)(F.ws + WS_WTOUT), 0, nullptr, scr, r, F.lane);
    }
    const int gt = F.bid * NTHR + F.tid, NGT = F.G * NTHR;
    { v4u* z = (v4u*)((bf16*)(F.ws + WS_WTIN) + (size_t)NIN * DM); const v4u zero = {0u, 0u, 0u, 0u};
      for (int i = gt; i < (NINP - NIN) * DM / 8; i += NGT) z[i] = zero; }
    small_conversions(F, gt, NGT);
}

__device__ __forceinline__ void phase1(Frame& F) {
    float* sft = (float*)F.lds; float* scl = sft + 3 * DM;
    const float* modp = (const float*)(F.ws + WS_MODP); const float* bmod = F.in[5]; const float* gat = F.in[6];
    for (int i = F.tid; i < 3 * 2 * DM; i += NTHR) { const int j = i / (2 * DM), n = i - j * 2 * DM; float s = bmod[n];
        for (int ks = 0; ks < 16; ++ks) s += modp[(size_t)(ks * 3 + j) * (6 * DM) + n];
        if (n < DM) sft[j * DM + n] = s; else scl[j * DM + n - DM] = gat[n - DM] * (1.0f + s); }
    if (F.bid < 144 && F.tid < 256) { const int j = F.bid / 48, n = (F.bid % 48) * 256 + F.tid; float s = bmod[n];
        for (int ks = 0; ks < 16; ++ks) s += modp[(size_t)(ks * 3 + j) * (6 * DM) + n];
        ((float*)(F.ws + WS_MODF))[j * 6 * DM + n] = s; }
    __syncthreads();
    const int gw = F.bid * NWAVES + F.wave, NGW = F.G * NWAVES;
    bf16* H = (bf16*)(F.ws + WS_H);
    for (int m = gw; m < MALL; m += NGW) {
        const int j = m < T ? 0 : (m < MROWS ? 1 : 2);
        const float* xr = m < MROWS ? F.in[0] + (size_t)m * DM : F.in[2] + (size_t)(m - MROWS) * DM;
        pg8::f32x4 v[8]; float s = 0.f;
#pragma unroll
        for (int q = 0; q < 8; ++q) { v[q] = *(const pg8::f32x4*)(xr + q * 256 + F.lane * 4); s += pg8::dot4(v[q]); }
        const float rstd = __builtin_amdgcn_rsqf(wave_sum(s) * (1.0f / DM) + 1e-6f);
#pragma unroll
        for (int q = 0; q < 8; ++q) { const int c = q * 256 + F.lane * 4; const pg8::f32x4 sc = *(const pg8::f32x4*)(scl + j * DM + c), sh = *(const pg8::f32x4*)(sft + j * DM + c);
            const pg8::f32x4 o = v[q] * rstd * sc + sh; v2u w; w.x = pk2(o[0], o[1]); w.y = pk2(o[2], o[3]); *(v2u*)(H + (size_t)m * DM + c) = w; }
    }
}

__device__ __forceinline__ void rwkv_prep_tile(Frame& F, int tile, int h_begin, int h_end) {
    const bf16* P = (const bf16*)(F.ws + WS_P); const float* mu = F.in[9];
    const int m0 = tile * 64;
    const bool isctx = m0 >= MROWS; const int seqlen = isctx ? TC : T;
    const int b = isctx ? (m0 - MROWS) >> 8 : m0 >> 13, t0 = isctx ? (m0 - MROWS) & 255 : m0 & (T - 1), pos0 = isctx ? T + t0 : t0;
    bf16* XW = (bf16*)F.lds; bf16* XA = XW + 64 * 72; bf16* XGt = XA + 64 * 72; float* KS = (float*)(XGt + 64 * 168); float* KKS = KS + 64 * 64; float* KSUM = KKS + 64 * 64;
    for (int i = F.tid; i < 64 * 44; i += NTHR) {
        const int tk = i / 44, gq = i - tk * 44; const int t = t0 + tk; const size_t row = (size_t)(m0 + tk);
        if (gq < 36) {
            const int col = C_WL + gq * 8;
            float c[8], p[8], n[8], o[8];
            unpack8(*(const v4u*)(P + row * NINP + col), c);
            if (t > 0) unpack8(*(const v4u*)(P + (row - 1) * NINP + col), p); else { for (int e = 0; e < 8; ++e) p[e] = 0.f; }
            if (t < seqlen - 1) unpack8(*(const v4u*)(P + (row + 1) * NINP + col), n); else { for (int e = 0; e < 8; ++e) n[e] = 0.f; }
#pragma unroll
            for (int e = 0; e < 8; ++e) { const int rc = col - C_R + e; const float s = c[e] + mu[rc] * (p[e] - c[e]) + mu[3360 + rc] * (n[e] - c[e]);
                o[e] = gq < 8 ? 1.0f - 2.0f * __builtin_amdgcn_rcpf(1.0f + __expf(2.0f * s)) : (gq < 16 ? s : sigmoidf_(s)); }
            bf16* dst = gq < 8 ? XW + tk * 72 + gq * 8 : (gq < 16 ? XA + tk * 72 + (gq - 8) * 8 : XGt + tk * 168 + (gq - 16) * 8);
            *(v4u*)dst = pack8f(o);
        } else if (h_begin == 0) {
            const int g8 = gq - 36, half = g8 >> 2, j0 = (g8 & 3) * 8;
            float x[8], y[8], o[8];
            unpack8(*(const v4u*)(P + row * NINP + C_KR + half * 32 + j0), x);
            unpack8(*(const v4u*)(P + row * NINP + C_KR + half * 32 + (j0 ^ 16)), y);
            if (isctx) { for (int e = 0; e < 8; ++e) o[e] = x[e]; }
            else { const float pos = half == 0 ? (float)(t >> 6) : (float)(t & 63);
#pragma unroll
                for (int e = 0; e < 8; ++e) { const int jf = (j0 & 15) + e; float r = pos * (__builtin_amdgcn_exp2f(-(float)jf * 0.83048202372184059f) * 0.15915494309189535f); r = r - __builtin_floorf(r);
                    const float sn = __builtin_amdgcn_sinf(r), cs = __builtin_amdgcn_cosf(r);
                    o[e] = j0 < 16 ? x[e] * cs - y[e] * sn : y[e] * sn + x[e] * cs; } }
            *(v4u*)((bf16*)(F.ws + WS_KR) + ((size_t)b * NKEY + pos0 + tk) * 64 + half * 32 + j0) = pack8f(o);
        }
    }
    __syncthreads();
    const float* w0 = F.in[14]; const float* a0 = F.in[16]; const float* keyk = F.in[19]; const float* keya = F.in[20];
    const int fr = F.lane & 15, fq = F.lane >> 4;
    char* WIMG = (char*)(KSUM + 64 * 64);
    const bf16* IMG = (const bf16*)(F.ws + WS_LORA);
    constexpr int NPIECE = LORA_IMG / 8;
    const int tkB = F.tid >> 3, c8B = (F.tid & 7) * 8, tB = t0 + tkB; const size_t rowB = (size_t)(m0 + tkB);
    const bool hasp = tB > 0, hasn = tB < seqlen - 1;
    v4u pb[9], wp[8];
    const v4u z4 = {0u, 0u, 0u, 0u};
    auto load_pb = [&](int h) {
#pragma unroll
        for (int a = 0; a < 3; ++a) { const int col = (a == 0 ? C_R : (a == 1 ? C_K : C_V)) + h * 64 + c8B; const bf16* pc = P + rowB * NINP + col;
            pb[3 * a] = *(const v4u*)pc; pb[3 * a + 1] = hasp ? *(const v4u*)(pc - NINP) : z4; pb[3 * a + 2] = hasn ? *(const v4u*)(pc + NINP) : z4; } };
    auto load_wp = [&](int h) {
#pragma unroll
        for (int q = 0; q < 8; ++q) { const int i = F.tid + NTHR * q; wp[q] = i < NPIECE ? *(const v4u*)(IMG + (size_t)h * LORA_IMG + i * 8) : z4; } };
#ifndef PREP_NOPF
    load_pb(h_begin); load_wp(h_begin);
#endif
#pragma unroll 1
    for (int h = h_begin; h < h_end; ++h) {
        const size_t hb = ((size_t)(b * RH + h) * NKEY + pos0) * RN;
#ifdef PREP_NOPF
        load_pb(h); load_wp(h);
#endif
#pragma unroll
        for (int q = 0; q < 8; ++q) { const int i = F.tid + NTHR * q; if (i < NPIECE) *(v4u*)(WIMG + i * 16) = wp[q]; }
        float rs8[8];
        {
            float sh[3][8];
#pragma unroll
            for (int a = 0; a < 3; ++a) { const int col = (a == 0 ? C_R : (a == 1 ? C_K : C_V)) + h * 64 + c8B; float c[8], pp[8], n[8];
                unpack8(pb[3 * a], c); unpack8(pb[3 * a + 1], pp); unpack8(pb[3 * a + 2], n);
#pragma unroll
                for (int e = 0; e < 8; ++e) { const int rc = col - C_R + e; sh[a][e] = c[e] + mu[rc] * (pp[e] - c[e]) + mu[3360 + rc] * (n[e] - c[e]); } }
            *(v4u*)((bf16*)(F.ws + WS_SCAN + A_R * SCAN_ARR) + hb + tkB * 64 + c8B) = pack8f(sh[0]);
            *(v4u*)((bf16*)(F.ws + WS_SCAN + A_V * SCAN_ARR) + hb + tkB * 64 + c8B) = pack8f(sh[2]);
#pragma unroll
            for (int e = 0; e < 8; ++e) rs8[e] = sh[0][e];
            float kk[8], ss = 0.f;
#pragma unroll
            for (int e = 0; e < 8; ++e) { kk[e] = sh[1][e] * keyk[h * 64 + c8B + e]; ss += kk[e] * kk[e]; }
            ss += __shfl_xor(ss, 1); ss += __shfl_xor(ss, 2); ss += __shfl_xor(ss, 4);
            const float rn = __builtin_amdgcn_rsqf(ss + 1e-12f);
#pragma unroll
            for (int e = 0; e < 8; ++e) kk[e] *= rn;
            *(pg8::f32x4*)(KS + tkB * 64 + c8B) = (pg8::f32x4){sh[1][0], sh[1][1], sh[1][2], sh[1][3]}; *(pg8::f32x4*)(KS + tkB * 64 + c8B + 4) = (pg8::f32x4){sh[1][4], sh[1][5], sh[1][6], sh[1][7]};
            *(pg8::f32x4*)(KKS + tkB * 64 + c8B) = (pg8::f32x4){kk[0], kk[1], kk[2], kk[3]}; *(pg8::f32x4*)(KKS + tkB * 64 + c8B + 4) = (pg8::f32x4){kk[4], kk[5], kk[6], kk[7]};
            *(v4u*)((bf16*)(F.ws + WS_SCAN + A_KK * SCAN_ARR) + hb + tkB * 64 + c8B) = pack8f(kk);
        }
#ifndef PREP_NOPF
        if (h + 1 < h_end) { load_pb(h + 1); load_wp(h + 1); }
#endif
        __syncthreads();
        {
            const int tb = F.wave & 3, cbp = F.wave >> 2;
            pg8::bf16x8 xw[2], xa[2], xg[5];
#pragma unroll
            for (int kb = 0; kb < 2; ++kb) { xw[kb] = *(const pg8::bf16x8*)(XW + (tb * 16 + fr) * 72 + kb * 32 + fq * 8); xa[kb] = *(const pg8::bf16x8*)(XA + (tb * 16 + fr) * 72 + kb * 32 + fq * 8); }
#pragma unroll
            for (int kb = 0; kb < 5; ++kb) xg[kb] = *(const pg8::bf16x8*)(XGt + (tb * 16 + fr) * 168 + kb * 32 + fq * 8);
            pg8::f32x4 dw[2][2], da[2][2], dg[2];
#pragma unroll
            for (int cbi = 0; cbi < 2; ++cbi) { const int chl = cbp * 32 + 8 * (fr >> 2) + 4 * cbi + (fr & 3);
                dg[cbi] = (pg8::f32x4){0.f, 0.f, 0.f, 0.f};
#pragma unroll
                for (int d = 0; d < 2; ++d) { dw[cbi][d] = (pg8::f32x4){0.f, 0.f, 0.f, 0.f}; da[cbi][d] = dw[cbi][d];
#pragma unroll
                    for (int kb = 0; kb < 2; ++kb) {
                        const pg8::bf16x8 fw = *(const pg8::bf16x8*)(WIMG + ((d * 64 + chl) * 72 + kb * 32 + fq * 8) * 2);
                        const pg8::bf16x8 fa = *(const pg8::bf16x8*)(WIMG + (128 * 72 + (d * 64 + chl) * 72 + kb * 32 + fq * 8) * 2);
                        dw[cbi][d] = __builtin_amdgcn_mfma_f32_16x16x32_bf16(fw, xw[kb], dw[cbi][d], 0, 0, 0);
                        da[cbi][d] = __builtin_amdgcn_mfma_f32_16x16x32_bf16(fa, xa[kb], da[cbi][d], 0, 0, 0); } }
#pragma unroll
                for (int kb = 0; kb < 5; ++kb) { const pg8::bf16x8 fg = *(const pg8::bf16x8*)(WIMG + (2 * 128 * 72 + chl * 168 + kb * 32 + fq * 8) * 2); dg[cbi] = __builtin_amdgcn_mfma_f32_16x16x32_bf16(fg, xg[kb], dg[cbi], 0, 0, 0); } }
            MFMA_DRAIN();
            asm volatile("s_nop 1" : "+v"(dw[0][0]), "+v"(dw[0][1]), "+v"(dw[1][0]), "+v"(dw[1][1]), "+v"(da[0][0]), "+v"(da[0][1]), "+v"(da[1][0]), "+v"(da[1][1]), "+v"(dg[0]), "+v"(dg[1]));
            __builtin_amdgcn_sched_barrier(0);
            const int tk = tb * 16 + fr, c8 = cbp * 32 + 8 * fq, cg = h * 64 + c8;
            float ks[8], kk[8], ka[8], ksum[8];
            { const pg8::f32x4 a0_ = *(const pg8::f32x4*)(KS + tk * 64 + c8), a1_ = *(const pg8::f32x4*)(KS + tk * 64 + c8 + 4), b0_ = *(const pg8::f32x4*)(KKS + tk * 64 + c8), b1_ = *(const pg8::f32x4*)(KKS + tk * 64 + c8 + 4);
              const pg8::f32x4 c0_ = *(const pg8::f32x4*)(keya + cg), c1_ = *(const pg8::f32x4*)(keya + cg + 4);
#pragma unroll
              for (int j = 0; j < 4; ++j) { ks[j] = a0_[j]; ks[4 + j] = a1_[j]; kk[j] = b0_[j]; kk[4 + j] = b1_[j]; ka[j] = c0_[j]; ka[4 + j] = c1_[j]; ksum[j] = 0.f; ksum[4 + j] = 0.f; } }
#pragma unroll
            for (int d = 0; d < 2; ++d) { float w0e[8], a0e[8], dec[8], kd[8], bd[8];
                { const pg8::f32x4 p0_ = *(const pg8::f32x4*)(w0 + d * RW + cg), p1_ = *(const pg8::f32x4*)(w0 + d * RW + cg + 4), q0_ = *(const pg8::f32x4*)(a0 + d * RW + cg), q1_ = *(const pg8::f32x4*)(a0 + d * RW + cg + 4);
#pragma unroll
                  for (int j = 0; j < 4; ++j) { w0e[j] = p0_[j]; w0e[4 + j] = p1_[j]; a0e[j] = q0_[j]; a0e[4 + j] = q1_[j]; } }
#pragma unroll
                for (int e = 0; e < 8; ++e) { const int cbi = e >> 2, j = e & 3; const float wr = w0e[e] + dw[cbi][d][j]; dec[e] = __expf(-0.60653065971263342f * sigmoidf_(wr));
                    const float eta = sigmoidf_(a0e[e] + da[cbi][d][j]); kd[e] = ks[e] * (1.0f + (eta - 1.0f) * ka[e]); bd[e] = kk[e] * eta; ksum[e] += kd[e]; }
                *(v4u*)((bf16*)(F.ws + WS_SCAN + (A_W + d) * SCAN_ARR) + hb + tk * 64 + c8) = pack8f(dec);
                *(v4u*)((bf16*)(F.ws + WS_SCAN + (A_K + d) * SCAN_ARR) + hb + tk * 64 + c8) = pack8f(kd);
                *(v4u*)((bf16*)(F.ws + WS_SCAN + (A_B + d) * SCAN_ARR) + hb + tk * 64 + c8) = pack8f(bd); }
            *(pg8::f32x4*)(KSUM + tk * 64 + c8) = (pg8::f32x4){ksum[0], ksum[1], ksum[2], ksum[3]}; *(pg8::f32x4*)(KSUM + tk * 64 + c8 + 4) = (pg8::f32x4){ksum[4], ksum[5], ksum[6], ksum[7]};
            if (!isctx) { float g8[8];
#pragma unroll
                for (int e = 0; e < 8; ++e) g8[e] = dg[e >> 2][e & 3];
                *(v4u*)((bf16*)(F.ws + WS_G) + ((size_t)(b * RH + h) * T + t0 + tk) * RN + c8) = pack8f(g8); }
        }
        __syncthreads();
        if (!isctx) { const float* rk = F.in[21] + h * 64 + c8B; float bon = 0.f;
#pragma unroll
            for (int e = 0; e < 8; ++e) bon += rs8[e] * KSUM[tkB * 64 + c8B + e] * rk[e];
            bon += __shfl_xor(bon, 1); bon += __shfl_xor(bon, 2); bon += __shfl_xor(bon, 4);
            if ((F.tid & 7) == 0) ((float*)(F.ws + WS_BON))[(size_t)(b * RH + h) * T + t0 + tkB] = bon; }
        __syncthreads();
    }
    __syncthreads();
}

constexpr int CB_AT = 0, CB_BT = 9216, CB_KT = 18432, CB_RT = 27648, CB_AC = 36864, CB_VC = 46080, CB_BHC = 55296, CB_KHC = 64512, CB_AAB = 73728  ,
              CB_AAK = 90112, CB_BRB = 99328, CB_BRK = 108544, CB_TT = 117760, CB_T1T = EXTRA_OFF + 1024  , CB_P1T = CB_T1T + 2560, CB_GC = CB_P1T + 2560  ;
constexpr int CB_W1T = CB_AT, CB_G1T = CB_BT, CB_W2T = CB_KT;
static_assert(CB_TT + 9216 <= RING_BYTES && CB_GC + 256 <= LDS_BYTES, "chunk builder LDS map");
#define MFMA_PAD1(a) do { MFMA_DRAIN(); asm volatile("s_nop 1" : "+v"(a)); } while (0)
__device__ __forceinline__ bf16 tobf(float x) { return (bf16)(pk2(x, x) & 0xffffu); }
__device__ __forceinline__ pg8::f32x4 mm64(const char* A, const char* B, int arow, int brow, int fq, pg8::f32x4 acc) {
#pragma unroll
    for (int kb = 0; kb < 2; ++kb) acc = __builtin_amdgcn_mfma_f32_16x16x32_bf16(*(const pg8::bf16x8*)(A + arow * 144 + kb * 64 + fq * 16), *(const pg8::bf16x8*)(B + brow * 144 + kb * 64 + fq * 16), acc, 0, 0, 0);
    return acc;
}
template <int CTRL, int ROWMASK> __device__ __forceinline__ float dpp_get0(float x) { return __builtin_bit_cast(float, __builtin_amdgcn_update_dpp(0, __builtin_bit_cast(int, x), CTRL, ROWMASK, 0xf, false)); }
__device__ __forceinline__ float wave_incl_scan(float x) {
    x += dpp_get0<0x111, 0xf>(x); x += dpp_get0<0x112, 0xf>(x); x += dpp_get0<0x114, 0xf>(x); x += dpp_get0<0x118, 0xf>(x);
    x += dpp_get0<0x142, 0xa>(x); x += dpp_get0<0x143, 0xc>(x); return x;
}
#define LBAR() do { asm volatile("s_waitcnt lgkmcnt(0)" ::: "memory"); __builtin_amdgcn_s_barrier(); asm volatile("" ::: "memory"); } while (0)
#define PAD8(a) MFMA_DRAIN(); asm volatile("s_nop 1" : "+v"(a[0]), "+v"(a[1]), "+v"(a[2]), "+v"(a[3]), "+v"(a[4]), "+v"(a[5]), "+v"(a[6]), "+v"(a[7]))
#define PAD4(a) MFMA_DRAIN(); asm volatile("s_nop 1" : "+v"(a[0]), "+v"(a[1]), "+v"(a[2]), "+v"(a[3]))
struct ChunkRaw { v4u r, kk, w, k, be, v; };
__device__ __forceinline__ void chunk_raw_load(Frame& F, int it, ChunkRaw& c) {
    const int dir = it & 1, qq = it >> 1, cg = qq % NCHUNK, bh = qq / NCHUNK; const int tau = F.lane, nat = dir == 0 ? tau : 63 - tau;
    const size_t off = ((size_t)bh * NKEY + cg * 64 + nat) * RN + F.wave * 8;
    c.r = *(const v4u*)((const bf16*)(F.ws + WS_SCAN + A_R * SCAN_ARR) + off); c.kk = *(const v4u*)((const bf16*)(F.ws + WS_SCAN + A_KK * SCAN_ARR) + off);
    c.w = *(const v4u*)((const bf16*)(F.ws + WS_SCAN + (A_W + dir) * SCAN_ARR) + off); c.k = *(const v4u*)((const bf16*)(F.ws + WS_SCAN + (A_K + dir) * SCAN_ARR) + off);
    c.be = *(const v4u*)((const bf16*)(F.ws + WS_SCAN + (A_B + dir) * SCAN_ARR) + off); c.v = *(const v4u*)((const bf16*)(F.ws + WS_SCAN + A_V * SCAN_ARR) + off);
}
#ifndef BUILD_DUP
#define BUILD_DUP 0
#endif
#define BREP(k) for (int rep_ = 0; rep_ < ((BUILD_DUP == (k)) ? 2 : 1); ++rep_)
__device__ __forceinline__ void chunk_build_item(Frame& F, int it, const ChunkRaw& cur, int it_next, int it_end, ChunkRaw& nxt) {
    const int dir = it & 1, qq = it >> 1, cg = qq % NCHUNK, bh = qq / NCHUNK;
    int lane_ = F.lane; asm volatile("" : "+v"(lane_));
    char* L = F.lds; const int lane = lane_, wave = F.wave, fr = lane & 15, fq = lane >> 4;
    const pg8::f32x4 zero4 = {0.f, 0.f, 0.f, 0.f};
    BREP(1) {
        const int tau = lane, cw = wave * 8;
        float r[8], kk[8], w[8], k[8], be[8], v[8];
        unpack8(cur.r, r); unpack8(cur.kk, kk); unpack8(cur.w, w); unpack8(cur.k, k); unpack8(cur.be, be); unpack8(cur.v, v);
        float at[8], bt[8], kt[8], rt[8], bhh[8], khh[8];
#pragma unroll
        for (int e = 0; e < 8; ++e) { const float lw = __logf(w[e]), lin = wave_incl_scan(lw);
            const float gcl = __builtin_bit_cast(float, __builtin_amdgcn_readlane(__builtin_bit_cast(int, lin), 63));
            const float ea = __expf(lin - lw), ei = __expf(-lin), eg = __expf(lin), gr = __expf(gcl - lin);
            at[e] = -kk[e] * ea; bt[e] = be[e] * ei; kt[e] = k[e] * ei; rt[e] = r[e] * eg; bhh[e] = be[e] * gr; khh[e] = k[e] * gr;
            if (lane == 63) ((float*)(L + CB_GC))[cw + e] = __expf(gcl); }
        *(v4u*)(L + CB_AT + tau * 144 + cw * 2) = pack8f(at); *(v4u*)(L + CB_BT + tau * 144 + cw * 2) = pack8f(bt);
        *(v4u*)(L + CB_KT + tau * 144 + cw * 2) = pack8f(kt); *(v4u*)(L + CB_RT + tau * 144 + cw * 2) = pack8f(rt);
#pragma unroll
        for (int e = 0; e < 8; ++e) { const int o = ((cw + e) * 72 + tau) * 2;
            *(bf16*)(L + CB_AC + o) = tobf(at[e]); *(bf16*)(L + CB_VC + o) = tobf(v[e]); *(bf16*)(L + CB_BHC + o) = tobf(bhh[e]); *(bf16*)(L + CB_KHC + o) = tobf(khh[e]); }
    }
    if (it_next < it_end) chunk_raw_load(F, it_next, nxt);
    LBAR();
    BREP(2) {
        const int m = wave >> 1, jh = wave & 1;
        const char* X = L + (m < 2 ? CB_AT : CB_RT); const char* Y = L + ((m & 1) ? CB_KT : CB_BT);
        char* dst = L + (m == 1 ? CB_AAK : (m == 2 ? CB_BRB : CB_BRK));
        pg8::f32x4 acc[8];
#pragma unroll
        for (int tI = 0; tI < 8; ++tI) { const int ib = tI >> 1, jb = 2 * jh + (tI & 1); acc[tI] = zero4;
            if (ib >= jb) { if (m == 0) acc[tI] = mm64(X, Y, ib * 16 + fr, jb * 16 + fr, fq, acc[tI]); else acc[tI] = mm64(Y, X, jb * 16 + fr, ib * 16 + fr, fq, acc[tI]); } }
        PAD8(acc);
#pragma unroll
        for (int tI = 0; tI < 8; ++tI) { const int ib = tI >> 1, jb = 2 * jh + (tI & 1);
            if (m == 0) { const int j = jb * 16 + fr, i0 = ib * 16 + 4 * fq; pg8::f32x4 o;
#pragma unroll
                for (int rr = 0; rr < 4; ++rr) o[rr] = (i0 + rr > j) ? acc[tI][rr] : 0.f;
                *(pg8::f32x4*)((float*)(L + CB_AAB) + j * 64 + i0) = o; }
            else { const int i = ib * 16 + fr, j0 = jb * 16 + 4 * fq; float o[4];
#pragma unroll
                for (int rr = 0; rr < 4; ++rr) { const bool keep = m == 1 ? (i > j0 + rr) : (i >= j0 + rr); o[rr] = keep ? acc[tI][rr] : 0.f; }
                v2u w; w.x = pk2(o[0], o[1]); w.y = pk2(o[2], o[3]); *(v2u*)(dst + (i * 72 + j0) * 2) = w; } }
    }
    LBAR();
    BREP(3) {
        const int rowid = wave * 8 + (lane >> 3), g = lane & 7, blk = rowid >> 5, n = rowid & 31;
        const float* A = (const float*)(L + CB_AAB) + (blk * 32) * 64 + blk * 32 + 4 * g;
        float t0 = 0.f, t1 = 0.f, t2 = 0.f, t3 = 0.f;
#pragma unroll
        for (int ii = 0; ii < 32; ++ii) { const int i = 31 - ii; const pg8::f32x4 a = *(const pg8::f32x4*)(A + i * 64);
            float s = (a[0] * t0 + a[1] * t1) + (a[2] * t2 + a[3] * t3);
            s = dpp_add<0xB1>(s); s = dpp_add<0x4E>(s); s = dpp_add<0x141>(s);
            s += (i == n) ? 1.f : 0.f;
            if (g == (i >> 2)) { if ((i & 3) == 0) t0 = s; else if ((i & 3) == 1) t1 = s; else if ((i & 3) == 2) t2 = s; else t3 = s; } }
        v2u w; w.x = pk2(t0, t1); w.y = pk2(t2, t3);
        *(v2u*)(L + CB_TT + ((blk * 32 + n) * 72 + blk * 32 + 4 * g) * 2) = w;
        if (blk == 0) { const v2u z = {0u, 0u}; *(v2u*)(L + CB_TT + (n * 72 + 32 + 4 * g) * 2) = z;
            *(bf16*)(L + CB_T1T + ((4 * g + 0) * 40 + n) * 2) = tobf(t0); *(bf16*)(L + CB_T1T + ((4 * g + 1) * 40 + n) * 2) = tobf(t1);
            *(bf16*)(L + CB_T1T + ((4 * g + 2) * 40 + n) * 2) = tobf(t2); *(bf16*)(L + CB_T1T + ((4 * g + 3) * 40 + n) * 2) = tobf(t3); }
    }
    LBAR();
    if (wave == 0) {
        pg8::f32x4 acc[4];
#pragma unroll
        for (int tI = 0; tI < 4; ++tI) { const int jb2 = tI >> 1, ib2 = tI & 1; const float* ar = (const float*)(L + CB_AAB) + (jb2 * 16 + fr) * 64 + 32 + 8 * fq;
            const pg8::f32x4 a0 = *(const pg8::f32x4*)ar, a1 = *(const pg8::f32x4*)(ar + 4);
            acc[tI] = __builtin_amdgcn_mfma_f32_16x16x32_bf16(__builtin_bit_cast(pg8::bf16x8, pg8::pack8(a0, a1)), *(const pg8::bf16x8*)(L + CB_TT + (32 + ib2 * 16 + fr) * 144 + (32 + 8 * fq) * 2), zero4, 0, 0, 0); }
        PAD4(acc);
#pragma unroll
        for (int tI = 0; tI < 4; ++tI) { const int jb2 = tI >> 1, ib2 = tI & 1; v2u w; w.x = pk2(acc[tI][0], acc[tI][1]); w.y = pk2(acc[tI][2], acc[tI][3]); *(v2u*)(L + CB_P1T + (ib2 * 16 + fr) * 80 + (jb2 * 16 + 4 * fq) * 2) = w; }
        LDS_WAIT();
#pragma unroll
        for (int tI = 0; tI < 4; ++tI) { const int nb = tI >> 1, ib2 = tI & 1;
            acc[tI] = __builtin_amdgcn_mfma_f32_16x16x32_bf16(*(const pg8::bf16x8*)(L + CB_T1T + (nb * 16 + fr) * 80 + fq * 16), *(const pg8::bf16x8*)(L + CB_P1T + (ib2 * 16 + fr) * 80 + fq * 16), zero4, 0, 0, 0); }
        PAD4(acc);
#pragma unroll
        for (int tI = 0; tI < 4; ++tI) { const int nb = tI >> 1, ib2 = tI & 1; v2u w; w.x = pk2(acc[tI][0], acc[tI][1]); w.y = pk2(acc[tI][2], acc[tI][3]); *(v2u*)(L + CB_TT + ((32 + ib2 * 16 + fr) * 72 + nb * 16 + 4 * fq) * 2) = w; }
    } else {
        pg8::f32x4 acc[4];
#pragma unroll
        for (int q3 = 0; q3 < 3; ++q3) { const int tt = wave - 1 + 7 * q3; acc[q3] = zero4; if (tt < 16) acc[q3] = mm64(L + CB_AAK, L + CB_VC, (tt & 3) * 16 + fr, (tt >> 2) * 16 + fr, fq, zero4); }
        acc[3] = zero4; PAD4(acc);
#pragma unroll
        for (int q3 = 0; q3 < 3; ++q3) { const int tt = wave - 1 + 7 * q3; if (tt < 16) { const int vb = tt >> 2, ib = tt & 3;
            v2u w; w.x = pk2(acc[q3][0], acc[q3][1]); w.y = pk2(acc[q3][2], acc[q3][3]); *(v2u*)(L + CB_G1T + ((vb * 16 + fr) * 72 + ib * 16 + 4 * fq) * 2) = w; } }
    }
    LBAR();
    BREP(4) {
        pg8::f32x4 acc[4];
#pragma unroll
        for (int q4 = 0; q4 < 4; ++q4) { const int tt = wave * 4 + q4, second = tt >> 4, xb = (tt >> 2) & 3, ib = tt & 3; acc[q4] = mm64(L + CB_TT, L + (second ? CB_G1T : CB_AC), ib * 16 + fr, xb * 16 + fr, fq, zero4); }
        PAD4(acc);
#pragma unroll
        for (int q4 = 0; q4 < 4; ++q4) { const int tt = wave * 4 + q4, second = tt >> 4, xb = (tt >> 2) & 3, ib = tt & 3;
            v2u w; w.x = pk2(acc[q4][0], acc[q4][1]); w.y = pk2(acc[q4][2], acc[q4][3]); *(v2u*)(L + (second ? CB_W2T : CB_W1T) + ((xb * 16 + fr) * 72 + ib * 16 + 4 * fq) * 2) = w; }
    }
    LBAR();
    BREP(5) {
        const int mat = wave >> 1, nh = wave & 1; const bool latent = cg < 128;
        bf16* mn = (bf16*)(F.ws + WS_MN) + ((size_t)(bh * NCHUNK + cg) * 2 + dir) * 8192;
        bf16* pq = (bf16*)F.out + ((size_t)(bh * 128 + (cg & 127)) * 2 + dir) * 8192;
        if (mat < 2 || latent) {
            bf16* out = mat == 0 ? mn : (mat == 1 ? mn + 4096 : (mat == 2 ? pq : pq + 4096));
            const char* A1 = L + ((mat & 1) ? CB_W2T : CB_W1T); const char* B1 = L + (mat < 2 ? CB_BHC : CB_BRB); const char* B2 = L + (mat == 1 ? CB_KHC : CB_BRK);
            pg8::f32x4 acc[8];
#pragma unroll
            for (int tI = 0; tI < 8; ++tI) { const int mb = tI >> 1, ncol = (2 * nh + (tI & 1)) * 16 + fr; acc[tI] = mm64(A1, B1, mb * 16 + fr, ncol, fq, zero4); if (mat & 1) acc[tI] = mm64(L + CB_VC, B2, mb * 16 + fr, ncol, fq, acc[tI]); }
            PAD8(acc);
#pragma unroll
            for (int tI = 0; tI < 8; ++tI) { const int mb = tI >> 1, ncol = (2 * nh + (tI & 1)) * 16 + fr, m0r = mb * 16 + 4 * fq;
                if (mat == 0) { const float g = ((const float*)(L + CB_GC))[ncol];
#pragma unroll
                    for (int rr = 0; rr < 4; ++rr) if (m0r + rr == ncol) acc[tI][rr] += g; }
                if (mat == 2) { const v2u rw = *(const v2u*)(L + CB_RT + ncol * 144 + m0r * 2); acc[tI][0] += bflo(rw.x); acc[tI][1] += bfhi(rw.x); acc[tI][2] += bflo(rw.y); acc[tI][3] += bfhi(rw.y); }
                v2u w; w.x = pk2(acc[tI][0], acc[tI][1]); w.y = pk2(acc[tI][2], acc[tI][3]); *(v2u*)(out + ncol * 64 + m0r) = w; }
        }
    }
    LBAR();
}
__device__ __forceinline__ void phase_build(Frame& F) {
    const int it_end = NB * RH * NCHUNK * 2; ChunkRaw cur, nxt;
    if (F.bid < it_end) chunk_raw_load(F, F.bid, cur);
#pragma unroll 1
    for (int it = F.bid; it < it_end; it += F.G) {
        chunk_build_item(F, it, cur, it + F.G, it_end, nxt);
        cur = nxt;
    }
}

__device__ __forceinline__ void scan2_unit(Frame& F, int sc) {
    const int dir = sc & 1, bh = sc >> 1; const bool fwd = dir == 0;
    char* L = F.lds; constexpr int SB = 4 * 9216, OFF_ZT = 2 * SB, OFF_YB = OFF_ZT + 9216; constexpr int NS = NCHUNK;
    const int lane = F.lane, wave = F.wave, fr = lane & 15, fq = lane >> 4, tid = F.tid;
    const bf16* MNb = (const bf16*)(F.ws + WS_MN); const bf16* PQb = (const bf16*)F.out;
    bf16* Yg = (bf16*)(F.ws + WS_YS) + (size_t)dir * MROWS * RW + (size_t)bh * T * RN;
    auto chunk_of = [&](int s) { return s < 4 ? (fwd ? 128 + s : 131 - s) : (fwd ? s - 4 : 131 - s); };
    const bool loader = wave < 4;
    v4u st0[8], st1[8], st2[8];
    auto gload = [&](v4u (&st)[8], int s) { const int cg = chunk_of(s); const bf16* mn = MNb + ((size_t)(bh * NCHUNK + cg) * 2 + dir) * 8192; const bf16* pq = PQb + ((size_t)(bh * 128 + (cg & 127)) * 2 + dir) * 8192;
#pragma unroll
        for (int k = 0; k < 8; ++k) { const int idx = tid + 256 * (k & 1); st[k] = *(const v4u*)(((k >> 1) < 2 ? mn + (k >> 1) * 4096 : pq + ((k >> 1) - 2) * 4096) + (idx >> 3) * 64 + (idx & 7) * 8); } };
    auto lstore = [&](const v4u (&st)[8], int buf) {
#pragma unroll
        for (int k = 0; k < 8; ++k) { const int idx = tid + 256 * (k & 1); *(v4u*)(L + buf * SB + (k >> 1) * 9216 + (idx >> 3) * 144 + (idx & 7) * 16) = st[k]; } };
    for (int i = tid; i < 9216 / 4; i += NTHR) ((unsigned*)(L + OFF_ZT))[i] = 0u;
    if (loader) { gload(st0, 0); gload(st1, 1); gload(st2, 2); lstore(st0, 0); }
    __syncthreads();
    const int vb = wave >> 1, nh = wave & 1;
    auto step = [&](int s, v4u (&stcur)[8], const v4u (&stnext)[8]) {
        const int cg = chunk_of(s); const bool latent = cg < 128; const char* B = L + (s & 1) * SB;
        if (loader && s + 3 < NS) gload(stcur, s + 3);
        pg8::bf16x8 za[2];
#pragma unroll
        for (int kb = 0; kb < 2; ++kb) za[kb] = *(const pg8::bf16x8*)(L + OFF_ZT + (vb * 16 + fr) * 144 + kb * 64 + fq * 16);
        pg8::f32x4 zn[2], yy[2];
#pragma unroll
        for (int nn = 0; nn < 2; ++nn) { const int nrow = (2 * nh + nn) * 16 + fr;
            const v2u nw = *(const v2u*)(B + 9216 + nrow * 144 + (vb * 16 + 4 * fq) * 2); zn[nn] = (pg8::f32x4){bflo(nw.x), bfhi(nw.x), bflo(nw.y), bfhi(nw.y)};
#pragma unroll
            for (int kb = 0; kb < 2; ++kb) zn[nn] = __builtin_amdgcn_mfma_f32_16x16x32_bf16(za[kb], *(const pg8::bf16x8*)(B + nrow * 144 + kb * 64 + fq * 16), zn[nn], 0, 0, 0);
            const v2u qw = *(const v2u*)(B + 3 * 9216 + nrow * 144 + (vb * 16 + 4 * fq) * 2); yy[nn] = (pg8::f32x4){bflo(qw.x), bfhi(qw.x), bflo(qw.y), bfhi(qw.y)};
#pragma unroll
            for (int kb = 0; kb < 2; ++kb) yy[nn] = __builtin_amdgcn_mfma_f32_16x16x32_bf16(za[kb], *(const pg8::bf16x8*)(B + 2 * 9216 + nrow * 144 + kb * 64 + fq * 16), yy[nn], 0, 0, 0); }
        MFMA_DRAIN(); asm volatile("s_nop 1" : "+v"(zn[0]), "+v"(zn[1]), "+v"(yy[0]), "+v"(yy[1]));
        if (latent) {
#pragma unroll
            for (int nn = 0; nn < 2; ++nn) *(pg8::f32x4*)(L + OFF_YB + (((2 * nh + nn) * 16 + fr) * 68 + vb * 16 + 4 * fq) * 4) = yy[nn];
        }
        LBAR();
#pragma unroll
        for (int nn = 0; nn < 2; ++nn)
#pragma unroll
            for (int rr = 0; rr < 4; ++rr) *(bf16*)(L + OFF_ZT + ((vb * 16 + 4 * fq + rr) * 72 + (2 * nh + nn) * 16 + fr) * 2) = tobf(zn[nn][rr]);
        if (loader) { if (s + 1 < NS) lstore(stnext, (s + 1) & 1); }
        else if (latent) {
#pragma unroll
            for (int k = 0; k < 2; ++k) { const int q = (tid - 256) + 256 * k, row = q >> 3, c8 = (q & 7) * 8, nat = fwd ? row : 63 - row;
                const pg8::f32x4 a = *(const pg8::f32x4*)(L + OFF_YB + (row * 68 + c8) * 4), c = *(const pg8::f32x4*)(L + OFF_YB + (row * 68 + c8 + 4) * 4);
                *(pg8::u32x4*)(Yg + ((size_t)(cg * 64 + nat)) * RN + c8) = pg8::pack8(a, c); } }
        LBAR();
    };
    static_assert(NS % 3 == 0, "the register ring is walked three chunks at a time");
    for (int s = 0; s < NS; s += 3) { step(s, st0, st1); step(s + 1, st1, st2); step(s + 2, st2, st0); }
    __syncthreads();
}


__device__ __forceinline__ void phase_scan(Frame& F) {
#ifdef STATIC_CONV
#ifndef CHAIN_DUP
#define CHAIN_DUP 1
#endif
    if (F.bid < 64) {
#pragma unroll 1
        for (int rep_ = 0; rep_ < CHAIN_DUP; ++rep_) scan2_unit(F, F.bid);
        return; }
#else
    if (F.bid < 64) scan2_unit(F, F.bid);
#endif
    float* scr = (float*)(F.lds + F.wave * 8448);
    constexpr int I13 = (DM / 64) * (DEXP / 32), I2 = (DEXP / 64) * (DM / 32), NITEM = NEXP * (2 * I13 + I2);
#ifdef STATIC_CONV
    for (int base = ((F.bid - 64) * NWAVES + F.wave) * 16; base < NITEM; base += (F.G - 64) * NWAVES * 16) {
#else
    for (;;) {
        int base = 0; if (F.lane == 0) base = (int)atomicAdd(F.ctl + CW_CONVQ, 16u);
        base = __builtin_amdgcn_readfirstlane(base);
        if (base >= NITEM) break;
#endif
        for (int it = base; it < base + 16 && it < NITEM; ++it) {
            const int e = it / (2 * I13 + I2); int r = it - e * (2 * I13 + I2);
            if (r < 2 * I13) { const int is3 = r >= I13; if (is3) r -= I13; const int n0 = 32 * (r % (DEXP / 32));
                transpose_item(F.in[is3 ? 30 : 29] + (size_t)e * DM * DEXP, DM, DEXP, (bf16*)(F.ws + WS_W13T), e * 1024 + (n0 / 128) * 128 + 128 * is3, nullptr, scr, r, F.lane); }
            else transpose_item(F.in[31] + (size_t)e * DEXP * DM, DEXP, DM, (bf16*)(F.ws + WS_W2T), e * DM, nullptr, scr, r - 2 * I13, F.lane);
        }
    }
}

__device__ __forceinline__ void phase_readout(Frame& F) {
    const float* lg = F.in[22]; const float* lb = F.in[23]; const bf16* Ysrc = (const bf16*)(F.ws + WS_YS); const float* bonp = (const float*)(F.ws + WS_BON);
    bf16* MIX = (bf16*)(F.ws + WS_MIX);
    const int tk = F.tid >> 3, c8 = (F.tid & 7) * 8;
    for (int it = F.bid; it < NB * RH * (T / 64); it += F.G) {
        const int bh = it >> 7, tt = (it & 127) * 64 + tk, b = bh >> 4, h = bh & 15;
        const size_t ys = ((size_t)bh * T + tt) * RN + c8, ss = ((size_t)bh * NKEY + tt) * RN + c8;
        float y[8], yb8[8];
        unpack8(*(const v4u*)(Ysrc + ys), y); unpack8(*(const v4u*)(Ysrc + (size_t)MROWS * RW + ys), yb8);
#pragma unroll
        for (int e = 0; e < 8; ++e) y[e] += yb8[e];
        float v[8], g[8];
        unpack8(*(const v4u*)((const bf16*)(F.ws + WS_SCAN + A_V * SCAN_ARR) + ss), v);
        unpack8(*(const v4u*)((const bf16*)(F.ws + WS_G) + ys), g);
        const float bon = bonp[(size_t)bh * T + tt];
        float s = 0.f;
#pragma unroll
        for (int e = 0; e < 8; ++e) s += y[e];
        s += __shfl_xor(s, 1); s += __shfl_xor(s, 2); s += __shfl_xor(s, 4);
        const float mean = s * (1.0f / 64.0f); float q = 0.f;
#pragma unroll
        for (int e = 0; e < 8; ++e) { y[e] -= mean; q += y[e] * y[e]; }
        q += __shfl_xor(q, 1); q += __shfl_xor(q, 2); q += __shfl_xor(q, 4);
        const float rstd = __builtin_amdgcn_rsqf(q * (1.0f / 64.0f) + 64e-5f);
        float o[8];
#pragma unroll
        for (int e = 0; e < 8; ++e) { const int ch = h * 64 + c8 + e; o[e] = (y[e] * rstd * lg[ch] + lb[ch] + bon * v[e]) * g[e]; }
        *(v4u*)(MIX + ((size_t)b * T + tt) * DM + RW + h * 64 + c8) = pack8f(o);
    }
}

__device__ __forceinline__ void phase_route(Frame& F) {
    const float* X1 = F.out; const float* modf = (const float*)(F.ws + WS_MODF); const float* gf = F.in[7]; const float* x1ss = (const float*)(F.ws + WS_X1SS);
    const bf16* WR = (const bf16*)(F.ws + WS_WRT); bf16* H2 = (bf16*)(F.ws + WS_H2);
    int* rte = (int*)(F.ws + WS_ROUTE + RT_E); int* rtp = (int*)(F.ws + WS_ROUTE + RT_POS); float* rtg = (float*)(F.ws + WS_ROUTE + RT_GATE);
    float* lg = (float*)(F.lds) + F.wave * (16 * 48);
    const int fr = F.lane & 15, fq = F.lane >> 4;
    const int gw = F.bid * NWAVES + F.wave, NGW = F.G * NWAVES;
    for (int it = gw; it < MROWS / 16; it += NGW) {
        const int row = it * 16 + fr, b = row >> 13; const float* xr = X1 + (size_t)row * DM + fq * 8;
        float ss; { const pg8::f32x4 s0 = *(const pg8::f32x4*)(x1ss + (size_t)row * 32 + fq * 8), s1 = *(const pg8::f32x4*)(x1ss + (size_t)row * 32 + fq * 8 + 4); ss = ((s0[0] + s0[1]) + (s0[2] + s0[3])) + ((s1[0] + s1[1]) + (s1[2] + s1[3])); }
        ss += __shfl_xor(ss, 16); ss += __shfl_xor(ss, 32);
        const float rstd = __builtin_amdgcn_rsqf(ss * (1.0f / DM) + 1e-6f);
        const float* sh2 = modf + (size_t)b * 6 * DM + 3 * DM + fq * 8; const float* sc2 = modf + (size_t)b * 6 * DM + 4 * DM + fq * 8;
        pg8::f32x4 acc[3] = {{0.f, 0.f, 0.f, 0.f}, {0.f, 0.f, 0.f, 0.f}, {0.f, 0.f, 0.f, 0.f}};
#pragma unroll 4
        for (int k = 0; k < 64; ++k) {
            const pg8::f32x4 a = *(const pg8::f32x4*)(xr + k * 32), c = *(const pg8::f32x4*)(xr + k * 32 + 4);
            const pg8::f32x4 g0 = *(const pg8::f32x4*)(gf + fq * 8 + k * 32), g1 = *(const pg8::f32x4*)(gf + fq * 8 + k * 32 + 4);
            const pg8::f32x4 s0 = *(const pg8::f32x4*)(sc2 + k * 32), s1 = *(const pg8::f32x4*)(sc2 + k * 32 + 4), h0 = *(const pg8::f32x4*)(sh2 + k * 32), h1 = *(const pg8::f32x4*)(sh2 + k * 32 + 4);
            const pg8::f32x4 o0 = a * rstd * g0 * (s0 + 1.0f) + h0, o1 = c * rstd * g1 * (s1 + 1.0f) + h1;
            const pg8::u32x4 w = pg8::pack8(o0, o1);
            *(pg8::u32x4*)(H2 + (size_t)row * DM + fq * 8 + k * 32) = w;
            const pg8::bf16x8 xb = __builtin_bit_cast(pg8::bf16x8, w);
#pragma unroll
            for (int nb = 0; nb < 3; ++nb) { const pg8::bf16x8 wf = *(const pg8::bf16x8*)(WR + (size_t)(nb * 16 + fr) * DM + k * 32 + fq * 8); acc[nb] = __builtin_amdgcn_mfma_f32_16x16x32_bf16(wf, xb, acc[nb], 0, 0, 0); }
        }
        MFMA_DRAIN(); asm volatile("s_nop 1" : "+v"(acc[0]), "+v"(acc[1]), "+v"(acc[2]));
#pragma unroll
        for (int nb = 0; nb < 3; ++nb)
#pragma unroll
            for (int j = 0; j < 4; ++j) lg[fr * 48 + nb * 16 + 4 * fq + j] = acc[nb][j];
        LDS_WAIT(); asm volatile("" ::: "memory");
        if (F.lane < 16) {
            const float* l = lg + F.lane * 48; const float* bg = F.in[26]; const float* be = F.in[28];
            int g = 0; float gm = l[0] + bg[0]; float gl[4]; gl[0] = gm;
#pragma unroll
            for (int i = 1; i < 4; ++i) { gl[i] = l[i] + bg[i]; if (gl[i] > gm) { gm = gl[i]; g = i; } }
            float gs = 0.f;
#pragma unroll
            for (int i = 0; i < 4; ++i) gs += __expf(gl[i] - gm);
            const float gval = 1.0f / gs;
            float w8[8]; int i1 = 0; float m1 = -3.0e38f;
#pragma unroll
            for (int i = 0; i < 8; ++i) { w8[i] = l[4 + 8 * g + i] + be[8 * g + i]; if (w8[i] > m1) { m1 = w8[i]; i1 = i; } }
            int i2 = 0; float m2 = -3.0e38f;
#pragma unroll
            for (int i = 0; i < 8; ++i) { if (i != i1 && w8[i] > m2) { m2 = w8[i]; i2 = i; } }
            const float e2 = __expf(m2 - m1), inv = 1.0f / (1.0f + e2);
            const int ea = 8 * g + i1, eb = 8 * g + i2; const int t = it * 16 + F.lane;
            const int pa = (int)atomicAdd(F.ctl + CW_CNT + ea, 1u), pb = (int)atomicAdd(F.ctl + CW_CNT + eb, 1u);
            rte[2 * t] = ea; rte[2 * t + 1] = eb; rtp[2 * t] = pa; rtp[2 * t + 1] = pb; rtg[2 * t] = gval * inv; rtg[2 * t + 1] = gval * e2 * inv;
        }
        LDS_WAIT(); asm volatile("" ::: "memory");
    }
}

__device__ __forceinline__ void build_tiles(Frame& F) {
    int* tab = (int*)(F.lds + EXTRA_OFF);
    if (F.tid == 0) { int tb = 0;
        for (int e = 0; e < NEXP; ++e) { const int c = (int)__hip_atomic_load(F.ctl + CW_CNT + e, __ATOMIC_RELAXED, __HIP_MEMORY_SCOPE_AGENT); const int nt = (c + 255) >> 8; tab[e] = tb * 256;
            for (int i = 0; i < nt && tb + i < MAXTILES; ++i) tab[64 + tb + i] = e; tb += nt; }
        tab[32] = tb < MAXTILES ? tb : MAXTILES; }
    __syncthreads();
}
__device__ __forceinline__ void phase_gather(Frame& F) {
    build_tiles(F);
    const int* tab = (const int*)(F.lds + EXTRA_OFF);
    const int* rte = (const int*)(F.ws + WS_ROUTE + RT_E); const int* rtp = (const int*)(F.ws + WS_ROUTE + RT_POS); const float* rtg = (const float*)(F.ws + WS_ROUTE + RT_GATE);
    int* rtr = (int*)(F.ws + WS_ROUTE + RT_ROW); float* rgate = (float*)(F.ws + WS_ROUTE + RT_RGATE); int* rowtok = (int*)(F.ctl + CW_ROWTOK);
    for (int p = F.bid * NTHR + F.tid; p < 2 * MROWS; p += F.G * NTHR) { const int row = tab[rte[p]] + rtp[p]; rtr[p] = row; rgate[row] = rtg[p]; rowtok[row] = p >> 1; }
}
__device__ __forceinline__ void phase_final(Frame& F) {
    const float* modf = (const float*)(F.ws + WS_MODF); const float* fg = F.in[32]; const bf16* Y = (const bf16*)(F.ws + WS_Y); const int* rtr = (const int*)(F.ws + WS_ROUTE + RT_ROW);
    const int gw = F.bid * NWAVES + F.wave, NGW = F.G * NWAVES;
    for (int m = gw; m < MROWS; m += NGW) {
        const int b = m >> 13, ra = rtr[2 * m], rb = rtr[2 * m + 1]; const float* g2 = modf + (size_t)b * 6 * DM + 5 * DM;
        float* xr = F.out + (size_t)m * DM; pg8::f32x4 v[8]; float s = 0.f;
#pragma unroll
        for (int q = 0; q < 8; ++q) { const int c = q * 256 + F.lane * 4; const pg8::f32x4 x = *(const pg8::f32x4*)(xr + c), g = *(const pg8::f32x4*)(g2 + c);
            const v2u ya = *(const v2u*)(Y + (size_t)ra * DM + c), yb = *(const v2u*)(Y + (size_t)rb * DM + c);
            const pg8::f32x4 ys = {bflo(ya.x) + bflo(yb.x), bfhi(ya.x) + bfhi(yb.x), bflo(ya.y) + bflo(yb.y), bfhi(ya.y) + bfhi(yb.y)};
            v[q] = x + g * ys; s += pg8::dot4(v[q]); }
        const float rstd = __builtin_amdgcn_rsqf(wave_sum(s) * (1.0f / DM) + 1e-6f);
#pragma unroll
        for (int q = 0; q < 8; ++q) { const int c = q * 256 + F.lane * 4; *(pg8::f32x4*)(xr + c) = v[q] * rstd * *(const pg8::f32x4*)(fg + c); }
    }
}

struct Args { const float* in[33]; float* out; unsigned char* ws; int ph_lo, ph_hi; };
__global__ void __launch_bounds__(NTHR, 2) fwd_kernel(Args args) {
    extern __shared__ __attribute__((aligned(16))) unsigned char lds_raw[];
    Frame F;
    F.lds = (char*)lds_raw; F.MISC = (volatile LAS unsigned*)((LAS unsigned char*)lds_raw + MISC_OFF);
    F.tid = threadIdx.x; F.lane = F.tid & 63; F.wave = __builtin_amdgcn_readfirstlane(F.tid >> 6); F.G = gridDim.x; F.bid = blockIdx.x;
    F.ws = args.ws; F.ctl = (unsigned*)(args.ws + WS_CTL); F.out = args.out;
    F.in = (const float* const __attribute__((address_space(4)))*)__builtin_amdgcn_kernarg_segment_ptr();
    if (F.tid < 128) ((LAS unsigned*)((LAS unsigned char*)lds_raw + MISC_OFF))[F.tid] = 0u;
    __syncthreads();
    XcdBarrier bar; bar.bar = F.ctl + CW_BAR; bar.x = 0; bar.st = nullptr;
    if (N_LAUNCHES == 1) bar = xcd_barrier_post(F.ctl + CW_BAR, F.MISC + 8);
    const int lo = args.ph_lo, hi = args.ph_hi;
#ifndef PH_MASK
#define PH_MASK 0xffff
#endif
#define IN(k) (((PH_MASK >> (k)) & 1) && lo <= (k) && (k) < hi)
#ifndef PROBE_DOUBLE
#define PROBE_DOUBLE -1
#endif
#define REPS(k) ((PROBE_DOUBLE == (k)) ? 2 : 1)
#define SEAM(k) do { if (IN(k) && IN((k) + 1)) xcd_barrier(bar); } while (0)
    LAS unsigned char* ring = (LAS unsigned char*)lds_raw;

    if (IN(0)) for (int rep = 0; rep < REPS(0); ++rep) { if (rep) xcd_barrier(bar); phase0(F); } SEAM(0);
    if (IN(1)) for (int rep = 0; rep < REPS(1); ++rep) { if (rep) xcd_barrier(bar); phase1(F); } SEAM(1);
    if (IN(2)) for (int rep = 0; rep < REPS(2); ++rep) { if (rep) xcd_barrier(bar);
        pg8::Gemm g{(const bf16*)(F.ws + WS_H), (const bf16*)(F.ws + WS_WTIN), MALL, NINP, DM, DM}; pg8::StaticOrder S; S.init(MALL, NINP, F.G, F.bid);
        pg8::EpiP E{(bf16*)(F.ws + WS_P), NINP, (float*)(F.ws + WS_RSS)};
        pg8::gemm_phase<pg8::EpiP, pg8::StaticOrder, true, true>(ring, g, S, E);
    } SEAM(2);
    if (IN(3)) for (int rep = 0; rep < REPS(3); ++rep) { if (rep) xcd_barrier(bar);
#ifndef PREP_DUP
#define PREP_DUP 1
#endif
#pragma unroll 1
        for (int rep_ = 0; rep_ < PREP_DUP; ++rep_) {
        for (int tl = F.bid; tl < MROWS / 64; tl += F.G) rwkv_prep_tile(F, tl, 0, RH);
        for (int j = F.G - 1 - F.bid; j < (NB * TC / 64) * RH; j += F.G) rwkv_prep_tile(F, MROWS / 64 + (j >> 4), j & 15, (j & 15) + 1);
        }
        { pg8::Gemm g{(const bf16*)(F.ws + WS_P) + C_CQ, (const bf16*)(F.ws + WS_WTUQ), MROWS, 1536, 512, NINP}; pg8::StaticOrder S; S.init(MROWS, 1536, F.G, F.bid);
          pg8::EpiQ E{(bf16*)(F.ws + WS_Q), (const float*)(F.ws + WS_RSS)};
          pg8::gemm_phase<pg8::EpiQ, pg8::StaticOrder, true, true>(ring, g, S, E); }
        { pg8::Gemm g{(const bf16*)(F.ws + WS_P) + C_CKV, (const bf16*)(F.ws + WS_WTUKV), MALL, 2048, 256, NINP}; pg8::StaticOrder S; S.init(MALL, 2048, F.G, F.bid);
          pg8::EpiKV E{(bf16*)(F.ws + WS_KN), (bf16*)(F.ws + WS_V), (const float*)(F.ws + WS_RSS)};
          pg8::gemm_phase<pg8::EpiKV, pg8::StaticOrder, true, true>(ring, g, S, E); }
    } SEAM(3);
    if (IN(4)) for (int rep = 0; rep < REPS(4); ++rep) { if (rep) xcd_barrier(bar);
        for (int u = F.bid; u < NB * 8 * (T / 256); u += F.G) {
            const int qb = u & 31, bh = u >> 5, b = bh >> 3, h = bh & 7;
            att::attn_dense_body((const bf16*)(F.ws + WS_Q) + ((size_t)(b * T + qb * 256)) * 1536 + h * 192,
                                 (const bf16*)(F.ws + WS_KN) + (size_t)bh * NKEY * 128, (const bf16*)(F.ws + WS_V) + (size_t)bh * NKEY * 128,
                                 (const bf16*)(F.ws + WS_KR) + (size_t)b * NKEY * 64,
                                 (bf16*)(F.ws + WS_MIX) + ((size_t)(b * T + qb * 256)) * DM + h * 128, NKEY, F.lds);
        }
    } SEAM(4);
    if (IN(5)) for (int rep = 0; rep < REPS(5); ++rep) { if (rep) xcd_barrier(bar); phase_build(F); } SEAM(5);
    if (IN(6)) for (int rep = 0; rep < REPS(6); ++rep) { if (rep) xcd_barrier(bar); phase_scan(F); } SEAM(6);
    if (IN(7)) for (int rep = 0; rep < REPS(7); ++rep) { if (rep) xcd_barrier(bar); phase_readout(F); } SEAM(7);
    if (IN(8)) for (int rep = 0; rep < REPS(8); ++rep) { if (rep) xcd_barrier(bar);
        pg8::Gemm g{(const bf16*)(F.ws + WS_MIX), (const bf16*)(F.ws + WS_WTOUT), MROWS, DM, DM, DM}; pg8::StaticOrder S; S.init(MROWS, DM, F.G, F.bid);
        pg8::EpiOut E{F.in[0], F.out, (const float*)(F.ws + WS_MODF) + 2 * DM, (float*)(F.ws + WS_X1SS)};
        pg8::gemm_phase<pg8::EpiOut, pg8::StaticOrder, true, true>(ring, g, S, E);
    } SEAM(8);
    if (IN(9)) for (int rep = 0; rep < REPS(9); ++rep) { if (rep) xcd_barrier(bar); phase_route(F); } SEAM(9);
    if (IN(10)) for (int rep = 0; rep < REPS(10); ++rep) { if (rep) xcd_barrier(bar); phase_gather(F); } SEAM(10);
    if (IN(11)) for (int rep = 0; rep < REPS(11); ++rep) { if (rep) xcd_barrier(bar);
        build_tiles(F); const int* tab = (const int*)(F.lds + EXTRA_OFF);
        { const int* rowtok = (const int*)(F.ctl + CW_ROWTOK); int* tk = (int*)(F.lds + EXTRA_OFF + 1024); const int nunits = tab[32] * 4;
          for (int i = F.tid; i < 3 * 256; i += NTHR) { const int L = (i >> 8) * F.G + F.bid; tk[i] = L < nunits ? rowtok[(L >> 2) * 256 + (i & 255)] : 0; }
          __syncthreads(); }
        pg8::Gemm g{(const bf16*)(F.ws + WS_H2), (const bf16*)(F.ws + WS_W13T), MAXTILES * 256, NEXP * 1024, DM, DM};
        pg8::MoeOrder S{(const LAS int*)((LAS unsigned char*)lds_raw + EXTRA_OFF) + 64, tab[32], 4, F.G, F.bid};
        pg8::EpiMoe1 E{(bf16*)(F.ws + WS_HM)};
        pg8::gemm_phase<pg8::EpiMoe1, pg8::MoeOrder, true, true, true>(ring, g, S, E, (const LAS int*)((LAS unsigned char*)lds_raw + EXTRA_OFF + 1024));
    } SEAM(11);
    if (IN(12)) for (int rep = 0; rep < REPS(12); ++rep) { if (rep) xcd_barrier(bar);
        build_tiles(F); const int* tab = (const int*)(F.lds + EXTRA_OFF);
        pg8::Gemm g{(const bf16*)(F.ws + WS_HM), (const bf16*)(F.ws + WS_W2T), MAXTILES * 256, NEXP * DM, DEXP, DEXP};
        pg8::MoeOrder S{(const LAS int*)((LAS unsigned char*)lds_raw + EXTRA_OFF) + 64, tab[32], 8, F.G, F.bid};
        pg8::EpiMoe2 E{(bf16*)(F.ws + WS_Y), (const float*)(F.ws + WS_ROUTE + RT_RGATE)};
        pg8::gemm_phase<pg8::EpiMoe2, pg8::MoeOrder, true, true>(ring, g, S, E);
    } SEAM(12);
    if (IN(13)) for (int rep = 0; rep < REPS(13); ++rep) { if (rep) xcd_barrier(bar); phase_final(F); }
#undef IN
#undef SEAM
}

extern "C" void kernel_launch(void* const* d_in, const int* in_sizes, int n_in, void* d_out, int out_size, void* d_ws, size_t ws_size, hipStream_t stream) {
    static int grid = 0;
    if (grid == 0) {
        if (n_in != 33 || in_sizes[0] != MROWS * DM || out_size != MROWS * DM || ws_size < WS_END) {
            fprintf(stderr, "kernel_launch: shape mismatch: n_in %d in0 %d out %d ws %zu (need %zu); nothing launched\n", n_in, n_in > 0 ? in_sizes[0] : -1, out_size, ws_size, (size_t)WS_END); grid = -1; return; }
        int dev = 0, cus = 0, per_cu = 0;
        if (hipGetDevice(&dev) != hipSuccess || hipDeviceGetAttribute(&cus, hipDeviceAttributeMultiprocessorCount, dev) != hipSuccess) { grid = -1; return; }
        if (hipFuncSetAttribute((const void*)fwd_kernel, hipFuncAttributeMaxDynamicSharedMemorySize, LDS_BYTES) != hipSuccess) { fprintf(stderr, "kernel_launch: hipFuncSetAttribute failed\n"); grid = -1; return; }
        if (hipOccupancyMaxActiveBlocksPerMultiprocessor(&per_cu, (const void*)fwd_kernel, NTHR, LDS_BYTES) != hipSuccess || per_cu < 1)
            fprintf(stderr, "kernel_launch: occupancy query reports %d workgroups per CU\n", per_cu);
        (void)hipGetLastError();
        grid = cus;
    }
    if (grid < 0) return;
    if (hipMemsetAsync((char*)d_ws + WS_CTL, 0, CTL_ZERO_BYTES, stream) != hipSuccess) return;
    Args a{};
    for (int i = 0; i < 33; ++i) a.in[i] = (const float*)d_in[i];
    a.out = (float*)d_out; a.ws = (unsigned char*)d_ws;
    for (int li = 0; li < N_LAUNCHES; ++li) {
        a.ph_lo = (N_LAUNCHES == 1) ? 0 : li; a.ph_hi = (N_LAUNCHES == 1) ? N_PHASES : li + 1;
        hipLaunchKernelGGL(fwd_kernel, dim3(grid), dim3(NTHR), LDS_BYTES, stream, a);
        const hipError_t le = hipPeekAtLastError();
        if (le != hipSuccess) { fprintf(stderr, "kernel_launch: launch %d failed: %s\n", li, hipGetErrorName(le)); break; }
    }
}
```
